# Optimizing an MI355X kernel written in HIP

```python
import math
import jax, jax.numpy as jnp
from jax import lax
import numpy as np


D_MODEL = 2048
BATCH = 1
SEQ = 16384
DEPTH = 1
DEC_BATCH = 32
DEC_SEQ = 4
PAST_LEN = 16384
PAGE_SIZE = 128

HK = 16
HV = 32
DK = 128
DV = 128
CONV_K = 4
CHUNK = 64
HB = 8
DH = 128
PATTERNS = ((128, 1), (512, 4), (2048, 16))
NG = len(PATTERNS)
QBLK = 128
EPS = 1e-6
NEG_INF = -1e30

QK_DIM = HK * DK
V_DIM = HV * DV
CONV_DIM = 2 * QK_DIM + V_DIM
B_DIM = NG * HB * DH
B_OUT = HB * DH
SPLIT_SIZES = (QK_DIM, QK_DIM, V_DIM, V_DIM, HV, HV, B_DIM, B_DIM, B_DIM, B_OUT, D_MODEL, D_MODEL)
IN_DIM = sum(SPLIT_SIZES)
SPLIT_IDX = tuple(int(s) for s in np.cumsum(SPLIT_SIZES)[:-1])

kernel_name = 'hybrid_gdn_dilated_swa_step'


def rmsnorm(x, w):
    xf = x.astype(jnp.float32)
    r = lax.rsqrt(jnp.mean(xf * xf, axis=-1, keepdims=True) + EPS)
    return (xf * r * w.astype(jnp.float32)).astype(x.dtype)


def l2norm(x):
    xf = x.astype(jnp.float32)
    return xf * lax.rsqrt(jnp.sum(xf * xf, axis=-1, keepdims=True) + EPS)


def gated_rmsnorm(o, z, w):
    of = o.astype(jnp.float32)
    of = of * lax.rsqrt(jnp.mean(of * of, axis=-1, keepdims=True) + EPS) * w.astype(jnp.float32)
    return (of * jax.nn.silu(z.astype(jnp.float32))).astype(z.dtype)


def causal_conv_silu(x, buf, w):
    t = x.shape[1]
    xp = jnp.concatenate([buf.astype(x.dtype), x], axis=1)
    y = xp[:, 0:t] * w[0]
    for i in range(1, w.shape[0]):
        y = y + xp[:, i:i + t] * w[i]
    return jax.nn.silu(y), xp[:, t:]


def gated_delta_chunked(q, k, v, beta, g, s0):
    bn, t, h = q.shape[:3]
    n = t // CHUNK

    def blocks(a):
        a = a.reshape((bn, n, CHUNK, h) + a.shape[3:])
        return jnp.moveaxis(a, 3, 1)

    qc, kc, vc, bc, gc = blocks(q), blocks(k), blocks(v), blocks(beta), blocks(g)
    G = jnp.cumsum(gc, axis=-1)
    causal = jnp.tril(jnp.ones((CHUNK, CHUNK), bool))
    strict = jnp.tril(jnp.ones((CHUNK, CHUNK), bool), -1)
    decay = jnp.exp(jnp.where(causal, G[..., :, None] - G[..., None, :], -jnp.inf))
    kb = kc * bc[..., None]
    L = jnp.where(strict, jnp.einsum('bhnid,bhnjd->bhnij', kb, kc) * decay, 0.0)
    A = L + jnp.eye(CHUNK, dtype=L.dtype)
    w = lax.linalg.triangular_solve(A, kb * jnp.exp(G)[..., None], left_side=True, lower=True, unit_diagonal=True)
    u = lax.linalg.triangular_solve(A, vc * bc[..., None], left_side=True, lower=True, unit_diagonal=True)
    intra = jnp.einsum('bhnid,bhnjd->bhnij', qc, kc) * decay
    qg = qc * jnp.exp(G)[..., None]
    kd = kc * jnp.exp(G[..., -1:] - G)[..., None]
    gl = jnp.exp(G[..., -1])

    def step(S, xs):
        w_c, u_c, qg_c, kd_c, a_c, gl_c = xs
        vn = u_c - jnp.einsum('bhcd,bhde->bhce', w_c, S)
        o = jnp.einsum('bhcd,bhde->bhce', qg_c, S) + jnp.einsum('bhij,bhje->bhie', a_c, vn)
        S = S * gl_c[..., None, None] + jnp.einsum('bhcd,bhce->bhde', kd_c, vn)
        return S, o

    xs = tuple(jnp.moveaxis(a, 2, 0) for a in (w, u, qg, kd, intra, gl))
    s_new, o = lax.scan(step, s0, xs)
    o = jnp.transpose(o, (1, 0, 3, 2, 4)).reshape(bn, t, h, o.shape[-1])
    return o, s_new


def gated_delta_recurrent(q, k, v, beta, g, s0):
    def step(S, xs):
        q_t, k_t, v_t, b_t, g_t = xs
        S = S * jnp.exp(g_t)[..., None, None]
        vn = b_t[..., None] * (v_t - jnp.einsum('bhd,bhde->bhe', k_t, S))
        S = S + k_t[..., :, None] * vn[..., None, :]
        return S, jnp.einsum('bhd,bhde->bhe', q_t, S)

    xs = tuple(jnp.moveaxis(a, 1, 0) for a in (q, k, v, beta, g))
    s_new, o = lax.scan(step, s0, xs)
    return jnp.moveaxis(o, 0, 1), s_new


def dilated_attn(q, k, v, q_idx, dil, win):
    n_keys = win // dil + 1
    idx = q_idx[:, None] - dil * jnp.arange(n_keys)[None, :]
    valid = idx >= 0
    idx = jnp.maximum(idx, 0)
    kg = k[:, idx]
    vg = v[:, idx]
    s = jnp.einsum('bqhd,bqjhd->bhqj', q, kg).astype(jnp.float32) * (DH ** -0.5)
    s = jnp.where(valid[None, None], s, NEG_INF)
    m = jnp.max(s, axis=-1, keepdims=True)
    p = jnp.exp(s - m)
    l = jnp.sum(p, axis=-1, keepdims=True)
    o = jnp.einsum('bhqj,bqjhd->bqhd', (p / l).astype(v.dtype), vg)
    lse = (m + jnp.log(l))[..., 0]
    return o, lse


def mix_groups(outs, lses):
    wgt = jax.nn.softmax(jnp.stack(lses, axis=0), axis=0)
    wgt = jnp.transpose(wgt, (0, 1, 3, 2))[..., None]
    return jnp.sum(wgt.astype(outs[0].dtype) * jnp.stack(outs, axis=0), axis=0)


def dilated_prompt(qb, kb, vb):
    bn, t = qb.shape[:2]
    nb = t // QBLK
    qblocks = jnp.moveaxis(qb.reshape(bn, nb, QBLK, NG, HB, DH), 1, 0)

    def one_block(args):
        i, qblk = args
        q_idx = i * QBLK + jnp.arange(QBLK)
        outs, lses = [], []
        for gi, (win, dil) in enumerate(PATTERNS):
            o, l = dilated_attn(qblk[:, :, gi], kb[:, :, gi], vb[:, :, gi], q_idx, dil, win)
            outs.append(o)
            lses.append(l)
        return mix_groups(outs, lses)

    ob = lax.map(one_block, (jnp.arange(nb), qblocks))
    return jnp.moveaxis(ob, 0, 1).reshape(bn, t, HB, DH)


def dilated_sample(qb, kb, vb, bufs):
    t = qb.shape[1]
    outs, lses, new_bufs = [], [], []
    for gi, (win, dil) in enumerate(PATTERNS):
        buf = bufs[gi]
        n_buf = buf.shape[1]
        kv_new = jnp.stack([kb[:, :, gi], vb[:, :, gi]], axis=2)
        kv_all = jnp.concatenate([buf.astype(kv_new.dtype), kv_new], axis=1)
        q_idx = n_buf + jnp.arange(t)
        o, l = dilated_attn(qb[:, :, gi], kv_all[:, :, 0], kv_all[:, :, 1], q_idx, dil, win)
        outs.append(o)
        lses.append(l)
        new_bufs.append(kv_all[:, t:])
    return mix_groups(outs, lses), tuple(new_bufs)


def hybrid_layer(x, conv_buf, s0, kv_bufs, is_prompt, ln_in, w_in, conv_w, a_log, dt_bias, norm_a,
                 w_proj_a, w_proj_b, w_out):
    bn, t = x.shape[:2]
    xn = rmsnorm(x, ln_in)
    proj = jnp.einsum('btd,de->bte', xn, w_in)
    (q_a, k_a, v_a, z_a, b_a, a_a, q_b, k_b, v_b, z_b, gate_a, gate_b) = jnp.split(proj, SPLIT_IDX, axis=-1)

    mixed, conv_new = causal_conv_silu(jnp.concatenate([q_a, k_a, v_a], axis=-1), conv_buf, conv_w)
    q_a, k_a, v_a = jnp.split(mixed, (QK_DIM, 2 * QK_DIM), axis=-1)
    q_a = jnp.repeat(l2norm(q_a.reshape(bn, t, HK, DK)), HV // HK, axis=2) * (DK ** -0.5)
    k_a = jnp.repeat(l2norm(k_a.reshape(bn, t, HK, DK)), HV // HK, axis=2)
    v_a = v_a.reshape(bn, t, HV, DV).astype(jnp.float32)
    beta = jax.nn.sigmoid(b_a.astype(jnp.float32))
    g = -jnp.exp(a_log.astype(jnp.float32)) * jax.nn.softplus(a_a.astype(jnp.float32) + dt_bias.astype(jnp.float32))
    s0 = s0.astype(jnp.float32)
    if is_prompt:
        o_a, s_new = gated_delta_chunked(q_a, k_a, v_a, beta, g, s0)
    else:
        o_a, s_new = gated_delta_recurrent(q_a, k_a, v_a, beta, g, s0)
    o_a = gated_rmsnorm(o_a, z_a.reshape(bn, t, HV, DV), norm_a).reshape(bn, t, V_DIM)
    y_a = jnp.einsum('bte,ed->btd', o_a, w_proj_a)

    q_b = q_b.reshape(bn, t, NG, HB, DH)
    k_b = k_b.reshape(bn, t, NG, HB, DH)
    v_b = v_b.reshape(bn, t, NG, HB, DH)
    if is_prompt:
        o_b = dilated_prompt(q_b, k_b, v_b)
        new_bufs = tuple(jnp.stack([k_b[:, :, gi], v_b[:, :, gi]], axis=2)[:, t - min(win, t):]
                         for gi, (win, _) in enumerate(PATTERNS))
    else:
        o_b, new_bufs = dilated_sample(q_b, k_b, v_b, kv_bufs)
    o_b = o_b.reshape(bn, t, B_OUT) * jax.nn.silu(z_b)
    y_b = jnp.einsum('bte,ed->btd', o_b, w_proj_b)

    merged = jax.nn.sigmoid(gate_a) * y_a + jax.nn.sigmoid(gate_b) * y_b
    h = x + jnp.einsum('btd,de->bte', merged, w_out)
    return h, new_bufs, s_new, conv_new


def setup_inputs(seed: int = 0) -> dict:
    key = jax.random.key(seed)
    ks = jax.random.split(key, 20)

    def nrm(k, shape, scale):
        return jax.random.normal(k, shape, jnp.float32) * scale

    x_prompt = nrm(ks[0], (BATCH, SEQ, D_MODEL), 1.0)
    x_sample = nrm(ks[1], (DEC_BATCH, DEC_SEQ, D_MODEL), 1.0)
    cache_kv_w128 = nrm(ks[2], (DEPTH, DEC_BATCH, min(PATTERNS[0][0], PAST_LEN), 2, HB, DH), 1.0)
    cache_kv_w512 = nrm(ks[3], (DEPTH, DEC_BATCH, min(PATTERNS[1][0], PAST_LEN), 2, HB, DH), 1.0)
    cache_kv_w2048 = nrm(ks[4], (DEPTH, DEC_BATCH, min(PATTERNS[2][0], PAST_LEN), 2, HB, DH), 1.0)
    state_delta = nrm(ks[5], (DEPTH, DEC_BATCH, HV, DK, DV), 0.1)
    state_conv = nrm(ks[6], (DEPTH, DEC_BATCH, CONV_K - 1, CONV_DIM), 1.0)
    ln_in = 1.0 + nrm(ks[7], (DEPTH, D_MODEL), 0.02)
    w_in = nrm(ks[8], (DEPTH, D_MODEL, IN_DIM), D_MODEL ** -0.5)
    conv_w = nrm(ks[9], (DEPTH, CONV_K, CONV_DIM), CONV_K ** -0.5)
    a_log = jnp.log(jax.random.uniform(ks[10], (DEPTH, HV), jnp.float32, minval=1.0, maxval=16.0))
    dt = jnp.exp(jax.random.uniform(ks[11], (DEPTH, HV), jnp.float32, minval=math.log(1e-3), maxval=math.log(1e-1)))
    dt_bias = dt + jnp.log(-jnp.expm1(-dt))
    norm_a = 1.0 + nrm(ks[12], (DEPTH, DV), 0.02)
    w_proj_a = nrm(ks[13], (DEPTH, V_DIM, D_MODEL), V_DIM ** -0.5)
    w_proj_b = nrm(ks[14], (DEPTH, B_OUT, D_MODEL), B_OUT ** -0.5)
    w_out = nrm(ks[15], (DEPTH, D_MODEL, D_MODEL), D_MODEL ** -0.5)
    ln_f = 1.0 + nrm(ks[16], (D_MODEL,), 0.02)
    return {'x_prompt': x_prompt, 'x_sample': x_sample,
            'cache_kv_w128': cache_kv_w128, 'cache_kv_w512': cache_kv_w512, 'cache_kv_w2048': cache_kv_w2048,
            'state_delta': state_delta, 'state_conv': state_conv,
            'ln_in': ln_in, 'w_in': w_in, 'conv_w': conv_w, 'a_log': a_log, 'dt_bias': dt_bias,
            'norm_a': norm_a, 'w_proj_a': w_proj_a, 'w_proj_b': w_proj_b, 'w_out': w_out, 'ln_f': ln_f}


def reference(x_prompt, x_sample, cache_kv_w128, cache_kv_w512, cache_kv_w2048, state_delta, state_conv,
              ln_in, w_in, conv_w, a_log, dt_bias, norm_a, w_proj_a, w_proj_b, w_out, ln_f):
    h_p, h_s = x_prompt, x_sample
    p_kv128, p_kv512, p_kv2048, p_delta, p_conv = [], [], [], [], []
    s_kv128, s_kv512, s_kv2048, s_delta, s_conv = [], [], [], [], []
    for layer in range(DEPTH):
        weights = (ln_in[layer], w_in[layer], conv_w[layer], a_log[layer], dt_bias[layer], norm_a[layer],
                   w_proj_a[layer], w_proj_b[layer], w_out[layer])
        bp = h_p.shape[0]
        conv0 = jnp.zeros((bp, CONV_K - 1, CONV_DIM), h_p.dtype)
        s0 = jnp.zeros((bp, HV, DK, DV), jnp.float32)
        h_p, kv_p, d_p, c_p = hybrid_layer(h_p, conv0, s0, None, True, *weights)
        bufs = (cache_kv_w128[layer], cache_kv_w512[layer], cache_kv_w2048[layer])
        h_s, kv_s, d_s, c_s = hybrid_layer(h_s, state_conv[layer], state_delta[layer], bufs, False, *weights)
        p_kv128.append(kv_p[0]); p_kv512.append(kv_p[1]); p_kv2048.append(kv_p[2])
        p_delta.append(d_p); p_conv.append(c_p)
        s_kv128.append(kv_s[0]); s_kv512.append(kv_s[1]); s_kv2048.append(kv_s[2])
        s_delta.append(d_s); s_conv.append(c_s)
    y_prompt = rmsnorm(h_p, ln_f)
    y_sample = rmsnorm(h_s, ln_f)
    return (y_prompt, y_sample,
            jnp.stack(p_kv128), jnp.stack(p_kv512), jnp.stack(p_kv2048), jnp.stack(p_delta), jnp.stack(p_conv),
            jnp.stack(s_kv128), jnp.stack(s_kv512), jnp.stack(s_kv2048), jnp.stack(s_delta), jnp.stack(s_conv))
```

```cpp
#include <hip/hip_runtime.h>
#include <stdint.h>
#include <stdio.h>

#define LAS __attribute__((address_space(3)))
typedef unsigned short bf16_t;
typedef short bf16x8 __attribute__((ext_vector_type(8)));
typedef float f32x4 __attribute__((ext_vector_type(4)));
typedef float f32x2 __attribute__((ext_vector_type(2)));
typedef unsigned u32x4 __attribute__((ext_vector_type(4)));
typedef unsigned u32x2 __attribute__((ext_vector_type(2)));

constexpr int DM = 2048, SEQ = 16384, NSAMP = 128, MR = SEQ + NSAMP  , MP = 16640  ;
constexpr int NP = 26880;
constexpr int C_QA = 0, C_KA = 2048, C_VA = 4096, C_ZA = 8192, C_QB = 12288, C_KB = 15360, C_VB = 18432, C_ZB = 21504, C_GA = 22528, C_GB = 24576, C_BA = 26624;
constexpr float EPS = 1e-6f;
constexpr size_t O_Y = 0, O_YS = 33554432, O_KV128P = O_YS + 262144, O_KV512P = O_KV128P + 262144, O_KV2048P = O_KV512P + 1048576, O_DELTAP = O_KV2048P + 4194304,
                 O_CONVP = O_DELTAP + 524288, O_KV128S = O_CONVP + 24576, O_KV512S = O_KV128S + 8388608, O_KV2048S = O_KV512S + 33554432, O_DELTAS = O_KV2048S + 134217728,
                 O_CONVS = O_DELTAS + 16777216, O_END = O_CONVS + 786432;
constexpr size_t WS_BAR = 0, WS_XN = 16384, WS_BT1 = WS_XN + (size_t)MP * 2048 * 2, WS_BT2A = WS_BT1 + (size_t)NP * 2048 * 2, WS_BT2B = WS_BT2A + (size_t)2048 * 4096 * 2,
                 WS_BT3 = WS_BT2B + (size_t)2048 * 1024 * 2, WS_P = WS_BT3 + (size_t)2048 * 2048 * 2, WS_BA = WS_P + (size_t)MP * NP * 2, WS_BG = WS_BA + (size_t)MP * 64 * 4,
                 WS_CV = WS_BG + (size_t)MP * 64 * 4, WS_OA = WS_CV + (size_t)MP * 8192 * 2, WS_OB = WS_OA + (size_t)MP * 4096 * 2, WS_T = WS_OB + (size_t)MP * 1024 * 2,
                 WS_MG = WS_T + (size_t)MP * 2048 * 2, WS_END = WS_MG + (size_t)MP * 2048 * 2;

struct Params {
    const float *x_prompt, *x_sample, *c128, *c512, *c2048, *state_delta, *state_conv, *ln_in, *w_in, *conv_w, *a_log, *dt_bias, *norm_a, *w_proj_a, *w_proj_b, *w_out, *ln_f;
    float* out;
    unsigned char* ws;
};

__device__ __forceinline__ float bf2f(bf16_t b) { return __uint_as_float(((unsigned)b) << 16); }
__device__ __forceinline__ float bflo(unsigned u) { return __uint_as_float(u << 16); }
__device__ __forceinline__ float bfhi(unsigned u) { return __uint_as_float(u & 0xffff0000u); }
__device__ __forceinline__ bf16_t f2bf(float f) { unsigned u = __float_as_uint(f); u += 0x7FFFu + ((u >> 16) & 1u); return (bf16_t)(u >> 16); }
__device__ __forceinline__ unsigned pk2(float lo, float hi) { return (unsigned)f2bf(lo) | ((unsigned)f2bf(hi) << 16); }
__device__ __forceinline__ float sigmoidf_(float x) { return 1.f / (1.f + __expf(-x)); }
__device__ __forceinline__ float siluf_(float x) { return x / (1.f + __expf(-x)); }
__device__ __forceinline__ float wave_sum(float v) {
#pragma unroll
    for (int o = 32; o >= 1; o >>= 1) v += __shfl_xor(v, o);
    return v;
}
__device__ __forceinline__ float wave_max(float v) {
#pragma unroll
    for (int o = 32; o >= 1; o >>= 1) v = fmaxf(v, __shfl_xor(v, o));
    return v;
}

namespace pg8 {
constexpr int BM = 256, BK = 64, HALF = 128, HTB = HALF * BK * 2, STAGE_BYTES = 8 * HTB, NXCD = 8, WGM = 8;
__host__ __device__ __forceinline__ int lds_byte(int r, int c) { const int st = (r >> 4) * 2 + (c >> 5), rr = r & 15, cc = c & 31, ob = rr * 64 + cc * 2; return st * 1024 + (ob ^ (((ob >> 9) & 1) << 5)); }
__host__ __device__ __forceinline__ void stage_rc(int b, int& R, int& C) { const int st = b / 1024, sb = b % 1024, swz = sb ^ (((sb >> 9) & 1) << 5); R = (st >> 1) * 16 + swz / 64; C = (st & 1) * 32 + (swz % 64) / 2; }
__host__ __device__ __forceinline__ int perm32(int rho) { const int n = rho >> 4, i = rho & 15; return 8 * (i >> 2) + 4 * n + (i & 3); }
struct Unit { int pm, pn; };
struct Gemm { const bf16_t* A; const bf16_t* Bt; int M, N, K; };
struct StaticOrder {
    int nM, nN, nwg, G, c;
    __host__ __device__ void init(int M, int N, int G_, int c_) { nM = M / BM; nN = N / BM; nwg = nM * nN; G = G_; c = c_; }
    __host__ __device__ bool next(int i, Unit& u) const {
        const long L = (long)i * G + c; if (L >= nwg) return false;
        int wgid = (int)L; { const int q = nwg / NXCD, r = nwg % NXCD, xcd = wgid % NXCD, off = wgid / NXCD; wgid = (xcd < r ? xcd * (q + 1) : r * (q + 1) + (xcd - r) * q) + off; }
        const int nig = WGM * nN, gid = wgid / nig, fm = gid * WGM, gsz = (nM - fm) < WGM ? (nM - fm) : WGM;
        u.pm = fm + ((wgid % nig) % gsz); u.pn = (wgid % nig) / gsz; return true;
    }
    __device__ __forceinline__ void a_ready(const Unit&) const {}
    __device__ __forceinline__ void done(const Unit&) const {}
};
__device__ __forceinline__ unsigned cvt_pk_bf16(float lo, float hi) { unsigned r; asm volatile("v_cvt_pk_bf16_f32 %0, %1, %2" : "=v"(r) : "v"(lo), "v"(hi)); return r; }

template <class Epi, class Sched>
__device__ __forceinline__ void gemm_phase(LAS unsigned char* lds, const Gemm g, const Sched& S, const Epi& E) {
    const int tid = threadIdx.x, wid = __builtin_amdgcn_readfirstlane(tid >> 6), lane = tid & 63, wr = wid >> 2, wc = wid & 3, fr = lane & 15, fq = lane >> 4;
    const int K = g.K, nt = K / BK;
    unsigned voffA[2], voffB[2];
#pragma unroll
    for (int i = 0; i < 2; ++i) { int R, C; stage_rc(tid * 16 + i * 8192, R, C); const int Rb = Epi::PERM ? ((R & ~31) + perm32(R & 31)) : R;
        voffA[i] = (unsigned)(R * K + C) * 2u; voffB[i] = (unsigned)(Rb * K + C) * 2u; }
    const size_t kstep = (size_t)(BK * 2);
    const size_t hstep = (size_t)HALF * K * 2;
    const size_t tstep = 2 * hstep;
    const unsigned ldsw = (unsigned)wid * 1024u;
    const int aoff = lds_byte(wr * 64 + fr, fq * 8), boff = lds_byte(wc * 32 + fr, fq * 8);
#define PG8_SA(b, h) (((b) * 2 + (h)) * HTB)
#define PG8_SB(b, h) ((4 + (b) * 2 + (h)) * HTB)
#define PG8_STAGE(bufoff, gbase, voff) do { _Pragma("unroll") for (int _i = 0; _i < 2; ++_i) \
        __builtin_amdgcn_global_load_lds((const unsigned*)((const char*)(gbase) + (voff)[_i]), (LAS unsigned*)(lds + (bufoff) + ldsw + _i * 8192), 16, 0, 0); } while (0)
#define PG8_LDA(dst, b, h) do { _Pragma("unroll") for (int m = 0; m < 4; ++m) _Pragma("unroll") for (int k = 0; k < 2; ++k) dst[m][k] = *(const LAS bf16x8*)(lds + PG8_SA(b, h) + aoff + m * 2048 + k * 1024); } while (0)
#define PG8_LDB(dst, b, h) do { _Pragma("unroll") for (int n = 0; n < 2; ++n) _Pragma("unroll") for (int k = 0; k < 2; ++k) dst[n][k] = *(const LAS bf16x8*)(lds + PG8_SB(b, h) + boff + n * 2048 + k * 1024); } while (0)
#define PG8_MMA(ai, bj, At, Bt) do { __builtin_amdgcn_s_setprio(1); _Pragma("unroll") for (int m = 0; m < 4; ++m) _Pragma("unroll") for (int n = 0; n < 2; ++n) _Pragma("unroll") for (int k = 0; k < 2; ++k) \
        acc[ai][bj][m][n] = __builtin_amdgcn_mfma_f32_16x16x32_bf16(Bt[n][k], At[m][k], acc[ai][bj][m][n], 0, 0, 0); __builtin_amdgcn_s_setprio(0); } while (0)
#define PG8_WAIT_V(n) asm volatile("s_waitcnt vmcnt(" #n ")" ::: "memory")
#define PG8_WAIT_L(n) asm volatile("s_waitcnt lgkmcnt(" #n ")" ::: "memory")
#define PG8_BAR __builtin_amdgcn_s_barrier()
#define PG8_SCHED __builtin_amdgcn_sched_barrier(0)
    Unit cur, nxt; int ui = 0;
    if (!S.next(0, cur)) return;
    f32x4 acc[2][2][4][2];
#pragma unroll
    for (int a = 0; a < 2; ++a)
#pragma unroll
        for (int b = 0; b < 2; ++b)
#pragma unroll
            for (int m = 0; m < 4; ++m)
#pragma unroll
                for (int n = 0; n < 2; ++n) acc[a][b][m][n] = (f32x4){0.f, 0.f, 0.f, 0.f};
    bf16x8 At[4][2], B0[2][2], B1[2][2];
    const char* cA = (const char*)g.A + (size_t)cur.pm * tstep; const char* cB = (const char*)g.Bt + (size_t)cur.pn * tstep;
    S.a_ready(cur);
    PG8_STAGE(PG8_SB(0, 0), cB, voffB); PG8_STAGE(PG8_SA(0, 0), cA, voffA); PG8_STAGE(PG8_SB(0, 1), cB + hstep, voffB); PG8_STAGE(PG8_SA(0, 1), cA + hstep, voffA);
    if (wr == 1) PG8_BAR;
    PG8_WAIT_V(4); PG8_BAR;
    PG8_STAGE(PG8_SB(1, 0), cB + kstep, voffB); PG8_STAGE(PG8_SA(1, 0), cA + kstep, voffA); PG8_STAGE(PG8_SB(1, 1), cB + hstep + kstep, voffB);
    PG8_WAIT_V(6); PG8_BAR;
    for (;;) {
        const bool has_next = S.next(ui + 1, nxt);
        const char* nA = has_next ? (const char*)g.A + (size_t)nxt.pm * tstep : cA; const char* nB = has_next ? (const char*)g.Bt + (size_t)nxt.pn * tstep : cB;
        for (int t = 0; t < nt; t += 2) {
            const bool last = (t == nt - 2);
            const char* a1 = cA + (size_t)(t + 1) * kstep;
            const char* a2 = last ? nA : cA + (size_t)(t + 2) * kstep; const char* b2 = last ? nB : cB + (size_t)(t + 2) * kstep;
            const char* a3 = a2 + kstep; const char* b3 = b2 + kstep;
            if (last && has_next) S.a_ready(nxt);
            PG8_LDB(B0, 0, 0); PG8_SCHED; PG8_LDA(At, 0, 0); PG8_STAGE(PG8_SA(1, 1), a1 + hstep, voffA);
            PG8_WAIT_L(8); PG8_BAR; PG8_WAIT_L(0); PG8_MMA(0, 0, At, B0); PG8_BAR; PG8_SCHED;
            PG8_LDB(B1, 0, 1); PG8_STAGE(PG8_SB(0, 0), b2, voffB);
            PG8_BAR; PG8_WAIT_L(0); PG8_MMA(0, 1, At, B1); PG8_BAR;
            PG8_LDA(At, 0, 1); PG8_STAGE(PG8_SA(0, 0), a2, voffA);
            PG8_BAR; PG8_WAIT_L(0); PG8_MMA(1, 0, At, B0); PG8_BAR; PG8_SCHED;
            PG8_STAGE(PG8_SB(0, 1), b2 + hstep, voffB);
            PG8_WAIT_V(6); PG8_BAR; PG8_MMA(1, 1, At, B1); PG8_BAR;
            PG8_LDB(B0, 1, 0); PG8_SCHED; PG8_LDA(At, 1, 0); PG8_STAGE(PG8_SA(0, 1), a2 + hstep, voffA);
            PG8_WAIT_L(8); PG8_BAR; PG8_WAIT_L(0); PG8_MMA(0, 0, At, B0); PG8_BAR; PG8_SCHED;
            PG8_LDB(B1, 1, 1); PG8_STAGE(PG8_SB(1, 0), b3, voffB);
            PG8_BAR; PG8_WAIT_L(0); PG8_MMA(0, 1, At, B1); PG8_BAR;
            PG8_LDA(At, 1, 1); PG8_STAGE(PG8_SA(1, 0), a3, voffA);
            PG8_BAR; PG8_WAIT_L(0); PG8_MMA(1, 0, At, B0); PG8_BAR; PG8_SCHED;
            PG8_STAGE(PG8_SB(1, 1), b3 + hstep, voffB);
            PG8_WAIT_V(6); PG8_BAR; PG8_MMA(1, 1, At, B1); PG8_BAR;
        }
        E(acc, cur, wr, wc, fr, fq); S.done(cur);
        if (!has_next) break;
#pragma unroll
        for (int a = 0; a < 2; ++a)
#pragma unroll
            for (int b = 0; b < 2; ++b)
#pragma unroll
                for (int m = 0; m < 4; ++m)
#pragma unroll
                    for (int n = 0; n < 2; ++n) acc[a][b][m][n] = (f32x4){0.f, 0.f, 0.f, 0.f};
        cur = nxt; cA = nA; cB = nB; ++ui;
    }
    PG8_WAIT_V(0);
    if (wr == 0) PG8_BAR;
    PG8_BAR;
#undef PG8_SA
#undef PG8_SB
#undef PG8_STAGE
#undef PG8_LDA
#undef PG8_LDB
#undef PG8_MMA
#undef PG8_WAIT_V
#undef PG8_WAIT_L
#undef PG8_BAR
#undef PG8_SCHED
}

struct EpiProj {
    static constexpr bool PERM = true;
    bf16_t* P; float* BA;
    __device__ __forceinline__ void operator()(const f32x4 (&acc)[2][2][4][2], const Unit& u, int wr, int wc, int fr, int fq) const {
        const int row0 = u.pm * BM + wr * 64 + fr;
        if (u.pn < 104) {
            const int col0 = u.pn * BM + wc * 32 + 8 * fq;
#pragma unroll
            for (int ai = 0; ai < 2; ++ai)
#pragma unroll
                for (int m = 0; m < 4; ++m) { bf16_t* rowp = P + (size_t)(row0 + ai * HALF + m * 16) * NP + col0;
#pragma unroll
                    for (int bj = 0; bj < 2; ++bj) { const f32x4 v0 = acc[ai][bj][m][0], v1 = acc[ai][bj][m][1];
                        *(u32x4*)(rowp + bj * HALF) = (u32x4){cvt_pk_bf16(v0[0], v0[1]), cvt_pk_bf16(v0[2], v0[3]), cvt_pk_bf16(v1[0], v1[1]), cvt_pk_bf16(v1[2], v1[3])}; } }
        } else if (wc < 2) {
#pragma unroll
            for (int ai = 0; ai < 2; ++ai)
#pragma unroll
                for (int m = 0; m < 4; ++m) { float* rp = BA + (size_t)(row0 + ai * HALF + m * 16) * 64 + wc * 32 + 8 * fq;
                    *(f32x4*)rp = acc[ai][0][m][0]; *(f32x4*)(rp + 4) = acc[ai][0][m][1]; }
        }
    }
};
__device__ __forceinline__ void sig8(const bf16_t* p, float (&s)[8]) {
    const u32x4 g = *(const u32x4*)p;
#pragma unroll
    for (int i = 0; i < 4; ++i) { s[2 * i] = sigmoidf_(bflo(g[i])); s[2 * i + 1] = sigmoidf_(bfhi(g[i])); }
}
struct EpiGateB {
    static constexpr bool PERM = true;
    const bf16_t* P; bf16_t* T;
    __device__ __forceinline__ void operator()(const f32x4 (&acc)[2][2][4][2], const Unit& u, int wr, int wc, int fr, int fq) const {
        const int row0 = u.pm * BM + wr * 64 + fr, col0 = u.pn * BM + wc * 32 + 8 * fq;
#pragma unroll
        for (int ai = 0; ai < 2; ++ai)
#pragma unroll
            for (int m = 0; m < 4; ++m) { const size_t row = (size_t)(row0 + ai * HALF + m * 16);
#pragma unroll
                for (int bj = 0; bj < 2; ++bj) { const f32x4 v0 = acc[ai][bj][m][0], v1 = acc[ai][bj][m][1]; const int c = col0 + bj * HALF;
                    float s[8]; sig8(P + row * NP + C_GB + c, s);
                    *(u32x4*)(T + row * DM + c) = (u32x4){cvt_pk_bf16(v0[0] * s[0], v0[1] * s[1]), cvt_pk_bf16(v0[2] * s[2], v0[3] * s[3]), cvt_pk_bf16(v1[0] * s[4], v1[1] * s[5]), cvt_pk_bf16(v1[2] * s[6], v1[3] * s[7])}; } }
    }
};
struct EpiMerge {
    static constexpr bool PERM = true;
    const bf16_t* P; const bf16_t* T; bf16_t* MG;
    __device__ __forceinline__ void operator()(const f32x4 (&acc)[2][2][4][2], const Unit& u, int wr, int wc, int fr, int fq) const {
        const int row0 = u.pm * BM + wr * 64 + fr, col0 = u.pn * BM + wc * 32 + 8 * fq;
#pragma unroll
        for (int ai = 0; ai < 2; ++ai)
#pragma unroll
            for (int m = 0; m < 4; ++m) { const size_t row = (size_t)(row0 + ai * HALF + m * 16);
#pragma unroll
                for (int bj = 0; bj < 2; ++bj) { const f32x4 v0 = acc[ai][bj][m][0], v1 = acc[ai][bj][m][1]; const int c = col0 + bj * HALF;
                    float s[8]; sig8(P + row * NP + C_GA + c, s);
                    const u32x4 t = *(const u32x4*)(T + row * DM + c);
                    *(u32x4*)(MG + row * DM + c) = (u32x4){cvt_pk_bf16(v0[0] * s[0] + bflo(t[0]), v0[1] * s[1] + bfhi(t[0])), cvt_pk_bf16(v0[2] * s[2] + bflo(t[1]), v0[3] * s[3] + bfhi(t[1])),
                                                           cvt_pk_bf16(v1[0] * s[4] + bflo(t[2]), v1[1] * s[5] + bfhi(t[2])), cvt_pk_bf16(v1[2] * s[6] + bflo(t[3]), v1[3] * s[7] + bfhi(t[3]))}; } }
    }
};
struct EpiOut {
    static constexpr bool PERM = false;
    const float* xp; const float* xs; float* out;
    __device__ __forceinline__ void operator()(const f32x4 (&acc)[2][2][4][2], const Unit& u, int wr, int wc, int fr, int fq) const {
        const int row0 = u.pm * BM + wr * 64 + fr, col0 = u.pn * BM + wc * 32 + 4 * fq;
#pragma unroll
        for (int ai = 0; ai < 2; ++ai)
#pragma unroll
            for (int m = 0; m < 4; ++m) { const int row = row0 + ai * HALF + m * 16;
                if (row < MR) { const float* xr = row < SEQ ? xp + (size_t)row * DM : xs + (size_t)(row - SEQ) * DM; float* orow = out + (size_t)row * DM;
#pragma unroll
                    for (int bj = 0; bj < 2; ++bj)
#pragma unroll
                        for (int n = 0; n < 2; ++n) { const int c = col0 + bj * HALF + n * 16; *(f32x4*)(orow + c) = acc[ai][bj][m][n] + *(const f32x4*)(xr + c); } } }
    }
};
}

__device__ __forceinline__ void transpose_tile(LAS float* tile, const float* src, int ld_src, int k0, int n0src, bool zero, bf16_t* dst, int ld_dst, int n0dst) {
    const int tid = threadIdx.x, r = tid >> 4, c4 = tid & 15;
#pragma unroll
    for (int h = 0; h < 2; ++h) { const int rr = r + 32 * h; f32x4 v = (f32x4){0.f, 0.f, 0.f, 0.f};
        if (!zero) v = *(const f32x4*)(src + (size_t)(k0 + rr) * ld_src + n0src + 4 * c4);
#pragma unroll
        for (int i = 0; i < 4; ++i) tile[rr * 65 + 4 * c4 + i] = v[i]; }
    __syncthreads();
    const int n = tid >> 3, k8 = tid & 7; float f[8];
#pragma unroll
    for (int i = 0; i < 8; ++i) f[i] = tile[(8 * k8 + i) * 65 + n];
    *(u32x4*)(dst + (size_t)(n0dst + n) * ld_dst + k0 + 8 * k8) = (u32x4){pk2(f[0], f[1]), pk2(f[2], f[3]), pk2(f[4], f[5]), pk2(f[6], f[7])};
    __syncthreads();
}
__device__ __forceinline__ void ph_prologue(const Params& p, LAS unsigned char* lds, int bid, int nb) {
    LAS float* tile = (LAS float*)lds;
    bf16_t* BT1 = (bf16_t*)(p.ws + WS_BT1); bf16_t* BT2A = (bf16_t*)(p.ws + WS_BT2A); bf16_t* BT2B = (bf16_t*)(p.ws + WS_BT2B); bf16_t* BT3 = (bf16_t*)(p.ws + WS_BT3);
    constexpr int U0 = 32 * 420, U1 = U0 + 64 * 32, U2 = U1 + 16 * 32, U3 = U2 + 32 * 32, U4 = U3 + MP / 8;
    for (int u = bid; u < U4; u += nb) {
        if (u < U0) { const int kt = u & 31, nt = u >> 5, n0 = nt * 64; int ns; bool zero = false;
            if (n0 < 12288) ns = n0; else if (n0 < 26624) ns = n0 + 64; else if (n0 < 26688) ns = 12288 + (n0 - 26624); else { ns = 0; zero = true; }
            transpose_tile(tile, p.w_in, 26688, kt * 64, ns, zero, BT1, 2048, n0);
        } else if (u < U1) { const int v = u - U0, kt = v & 63, nt = v >> 6; transpose_tile(tile, p.w_proj_a, 2048, kt * 64, nt * 64, false, BT2A, 4096, nt * 64);
        } else if (u < U2) { const int v = u - U1, kt = v & 15, nt = v >> 4; transpose_tile(tile, p.w_proj_b, 2048, kt * 64, nt * 64, false, BT2B, 1024, nt * 64);
        } else if (u < U3) { const int v = u - U2, kt = v & 31, nt = v >> 5; transpose_tile(tile, p.w_out, 2048, kt * 64, nt * 64, false, BT3, 2048, nt * 64);
        } else { const int row = (u - U3) * 8 + __builtin_amdgcn_readfirstlane(threadIdx.x >> 6), lane = threadIdx.x & 63;
            bf16_t* xn = (bf16_t*)(p.ws + WS_XN) + (size_t)row * DM;
            if (row < MR) { const float* xr = row < SEQ ? p.x_prompt + (size_t)row * DM : p.x_sample + (size_t)(row - SEQ) * DM;
                f32x4 v[8]; float ss = 0.f;
#pragma unroll
                for (int i = 0; i < 8; ++i) { v[i] = *(const f32x4*)(xr + i * 256 + lane * 4); ss += v[i][0] * v[i][0] + v[i][1] * v[i][1] + v[i][2] * v[i][2] + v[i][3] * v[i][3]; }
                ss = wave_sum(ss); const float r = rsqrtf(ss * (1.f / DM) + EPS);
#pragma unroll
                for (int i = 0; i < 8; ++i) { const f32x4 w = *(const f32x4*)(p.ln_in + i * 256 + lane * 4);
                    *(u32x2*)(xn + i * 256 + lane * 4) = (u32x2){pk2(v[i][0] * r * w[0], v[i][1] * r * w[1]), pk2(v[i][2] * r * w[2], v[i][3] * r * w[3])}; }
            } else {
#pragma unroll
                for (int i = 0; i < 8; ++i) *(u32x2*)(xn + i * 256 + lane * 4) = (u32x2){0u, 0u};
                bf16_t* oa = (bf16_t*)(p.ws + WS_OA) + (size_t)row * 4096; bf16_t* ob = (bf16_t*)(p.ws + WS_OB) + (size_t)row * 1024;
#pragma unroll
                for (int i = 0; i < 16; ++i) *(u32x2*)(oa + i * 256 + lane * 4) = (u32x2){0u, 0u};
#pragma unroll
                for (int i = 0; i < 4; ++i) *(u32x2*)(ob + i * 256 + lane * 4) = (u32x2){0u, 0u};
            }
        }
    }
}

__device__ __forceinline__ void ph_prep(const Params& p, int bid, int nb) {
    const bf16_t* P = (const bf16_t*)(p.ws + WS_P); bf16_t* CV = (bf16_t*)(p.ws + WS_CV);
    const float* BA = (const float*)(p.ws + WS_BA); float* BG = (float*)(p.ws + WS_BG);
    const int lane = threadIdx.x & 63, gw = __builtin_amdgcn_readfirstlane(threadIdx.x >> 6) * nb + bid, nw = nb * 8;
    const float *pc128 = p.c128, *pc512 = p.c512, *pc2048 = p.c2048;
    asm volatile("" : "+s"(pc128), "+s"(pc512), "+s"(pc2048));
    for (int task = gw; task < MR * 64; task += nw) {
        const int row = task >> 6, seg = task & 63, c = seg * 128 + 2 * lane;
        float y0 = 0.f, y1 = 0.f;
#pragma unroll
        for (int i = 0; i < 4; ++i) {
            const f32x2 w = *(const f32x2*)(p.conv_w + i * 8192 + c); float x0 = 0.f, x1 = 0.f;
            if (row < SEQ) { const int r = row - 3 + i; if (r >= 0) { const unsigned u = *(const unsigned*)(P + (size_t)r * NP + c); x0 = bflo(u); x1 = bfhi(u); } }
            else { const int b = (row - SEQ) >> 2, t = (row - SEQ) & 3, j = t + i;
                if (j < 3) { const f32x2 s = *(const f32x2*)(p.state_conv + ((size_t)b * 3 + j) * 8192 + c); x0 = s[0]; x1 = s[1]; }
                else { const unsigned u = *(const unsigned*)(P + (size_t)(SEQ + 4 * b + j - 3) * NP + c); x0 = bflo(u); x1 = bfhi(u); } }
            y0 += x0 * w[0]; y1 += x1 * w[1];
        }
        y0 = siluf_(y0); y1 = siluf_(y1);
        if (seg < 32) { const float ss = wave_sum(y0 * y0 + y1 * y1); float r = rsqrtf(ss + EPS); if (seg < 16) r *= 0.08838834764831845f; y0 *= r; y1 *= r; }
        *(unsigned*)(CV + (size_t)row * 8192 + c) = pk2(y0, y1);
    }
    for (int i = bid * 512 + threadIdx.x; i < MR * 32; i += nb * 512) { const int row = i >> 5, h = i & 31;
        const float b = BA[(size_t)row * 64 + h], a = BA[(size_t)row * 64 + 32 + h] + p.dt_bias[h];
        const float sp = a > 20.f ? a : log1pf(expf(a));
        BG[(size_t)row * 64 + h] = 1.f / (1.f + expf(-b)); BG[(size_t)row * 64 + 32 + h] = -expf(p.a_log[h]) * sp; }
    for (int i = bid * 512 + threadIdx.x; i < 3 * 8192; i += nb * 512) { const int r = i >> 13, c = i & 8191; p.out[O_CONVP + i] = bf2f(P[(size_t)(SEQ - 3 + r) * NP + c]); }
    for (int i = bid * 512 + threadIdx.x; i < 32 * 3 * 8192; i += nb * 512) { const int c = i & 8191, r = (i >> 13) % 3, b = i / (3 * 8192); p.out[O_CONVS + i] = bf2f(P[(size_t)(SEQ + 4 * b + 1 + r) * NP + c]); }
    constexpr int RP = 128 + 512 + 2048, NT = 2 * RP + 2 * 32 * RP;
    for (int task = gw; task < NT; task += nw) {
        const int half = task & 1; int r = task >> 1; float* dst; const float* srcf = nullptr; const bf16_t* srcb = nullptr;
        if (r < RP) { int g, win, j; size_t ob; if (r < 128) { g = 0; win = 128; j = r; ob = O_KV128P; } else if (r < 640) { g = 1; win = 512; j = r - 128; ob = O_KV512P; } else { g = 2; win = 2048; j = r - 640; ob = O_KV2048P; }
            dst = p.out + ob + (size_t)j * 2048 + half * 1024; srcb = P + (size_t)(SEQ - win + j) * NP + (half ? C_VB : C_KB) + g * 1024;
        } else { r -= RP; const int b = r / RP; int q = r % RP; int g, win, j; size_t ob; const float* cache;
            if (q < 128) { g = 0; win = 128; j = q; ob = O_KV128S; cache = pc128; } else if (q < 640) { g = 1; win = 512; j = q - 128; ob = O_KV512S; cache = pc512; } else { g = 2; win = 2048; j = q - 640; ob = O_KV2048S; cache = pc2048; }
            dst = p.out + ob + ((size_t)b * win + j) * 2048 + half * 1024;
            if (j < win - 4) srcf = cache + ((size_t)b * win + j + 4) * 2048 + half * 1024;
            else srcb = P + (size_t)(SEQ + 4 * b + (j - (win - 4))) * NP + (half ? C_VB : C_KB) + g * 1024; }
        if (srcf) {
#pragma unroll
            for (int i = 0; i < 4; ++i) *(f32x4*)(dst + i * 256 + lane * 4) = *(const f32x4*)(srcf + i * 256 + lane * 4);
        } else {
#pragma unroll
            for (int i = 0; i < 4; ++i) { const u32x2 u = *(const u32x2*)(srcb + i * 256 + lane * 4); *(f32x4*)(dst + i * 256 + lane * 4) = (f32x4){bflo(u[0]), bfhi(u[0]), bflo(u[1]), bfhi(u[1])}; }
        }
    }
}

__device__ __forceinline__ float quad_sum(float v) { v += __shfl_xor(v, 1); v += __shfl_xor(v, 2); return v; }
__device__ __forceinline__ void delta_rec_task(const Params& p, int task, int lane) {
    const bf16_t* CV = (const bf16_t*)(p.ws + WS_CV); const float* BG = (const float*)(p.ws + WS_BG); bf16_t* OA = (bf16_t*)(p.ws + WS_OA);
    int hv, cb, T, row0; float* sout; const float* sin = nullptr;
    if (task < 256) { hv = task >> 3; cb = task & 7; T = SEQ; row0 = 0; sout = p.out + O_DELTAP + (size_t)hv * 16384; }
    else { const int v = task - 256, b = v >> 8; hv = (v >> 3) & 31; cb = v & 7; T = 4; row0 = SEQ + 4 * b; sin = p.state_delta + ((size_t)b * 32 + hv) * 16384; sout = p.out + O_DELTAS + ((size_t)b * 32 + hv) * 16384; }
    const int ce = lane >> 2, dq = lane & 3, e = cb * 16 + ce, hk = hv >> 1;
    float s[32];
#pragma unroll
    for (int i = 0; i < 32; ++i) s[i] = sin ? sin[(size_t)(dq * 32 + i) * 128 + e] : 0.f;
    for (int t = 0; t < T; ++t) {
        const size_t row = (size_t)(row0 + t);
        const bf16_t* kp = CV + row * 8192 + C_KA + hk * 128 + dq * 32; const bf16_t* qp = CV + row * 8192 + C_QA + hk * 128 + dq * 32;
        u32x4 kk[4], qq[4];
#pragma unroll
        for (int i = 0; i < 4; ++i) { kk[i] = *(const u32x4*)(kp + 8 * i); qq[i] = *(const u32x4*)(qp + 8 * i); }
        const float v = bf2f(CV[row * 8192 + C_VA + hv * 128 + e]);
        const float beta = BG[row * 64 + hv], eg = expf(BG[row * 64 + 32 + hv]);
        float dot = 0.f;
#pragma unroll
        for (int i = 0; i < 16; ++i) { s[2 * i] *= eg; s[2 * i + 1] *= eg; dot += bflo(kk[i >> 2][i & 3]) * s[2 * i] + bfhi(kk[i >> 2][i & 3]) * s[2 * i + 1]; }
        dot = quad_sum(dot);
        const float vn = beta * (v - dot); float o = 0.f;
#pragma unroll
        for (int i = 0; i < 16; ++i) { s[2 * i] += bflo(kk[i >> 2][i & 3]) * vn; s[2 * i + 1] += bfhi(kk[i >> 2][i & 3]) * vn; o += bflo(qq[i >> 2][i & 3]) * s[2 * i] + bfhi(qq[i >> 2][i & 3]) * s[2 * i + 1]; }
        o = quad_sum(o);
        if (dq == 0) OA[row * 4096 + hv * 128 + e] = f2bf(o);
    }
#pragma unroll
    for (int i = 0; i < 32; ++i) sout[(size_t)(dq * 32 + i) * 128 + e] = s[i];
}
__device__ __forceinline__ void ph_delta_rec(const Params& p, int bid, int nb, int t0, int t1) {
    const int lane = threadIdx.x & 63, gw = __builtin_amdgcn_readfirstlane(threadIdx.x >> 6) * nb + bid, nw = nb * 8;
    for (int task = t0 + gw; task < t1; task += nw) delta_rec_task(p, task, lane);
}

__device__ __forceinline__ void attn_naive_task(const Params& p, int row, int h, int lane) {
    const bf16_t* P = (const bf16_t*)(p.ws + WS_P); bf16_t* OB = (bf16_t*)(p.ws + WS_OB);
    const bool samp = row >= SEQ; const int sb = (row - SEQ) >> 2, st = (row - SEQ) & 3;
    float sc[3][3];
#pragma unroll
    for (int g = 0; g < 3; ++g) {
        const int dil = g == 0 ? 1 : (g == 1 ? 4 : 16), win = g == 0 ? 128 : (g == 1 ? 512 : 2048);
        const float* cache = g == 0 ? p.c128 : (g == 1 ? p.c512 : p.c2048);
        u32x4 q[16];
#pragma unroll
        for (int i = 0; i < 16; ++i) q[i] = *(const u32x4*)(P + (size_t)row * NP + C_QB + g * 1024 + h * 128 + 8 * i);
#pragma unroll
        for (int sl = 0; sl < 3; ++sl) {
            const int j = lane + 64 * sl; float s = -1e30f;
            if (j <= 128) {
                const bf16_t* kb = nullptr; const float* kf = nullptr; bool valid = true;
                if (!samp) { int tok = row - j * dil; valid = tok >= 0; if (tok < 0) tok = 0; kb = P + (size_t)tok * NP + C_KB + g * 1024 + h * 128; }
                else { const int idx = win + st - j * dil; if (idx >= win) kb = P + (size_t)(SEQ + 4 * sb + idx - win) * NP + C_KB + g * 1024 + h * 128; else kf = cache + (((size_t)sb * win + idx) * 2 + 0) * 1024 + h * 128; }
                float d = 0.f;
                if (kb) {
#pragma unroll
                    for (int i = 0; i < 16; ++i) { const u32x4 k = *(const u32x4*)(kb + 8 * i);
#pragma unroll
                        for (int w = 0; w < 4; ++w) d += bflo(q[i][w]) * bflo(k[w]) + bfhi(q[i][w]) * bfhi(k[w]); }
                } else {
#pragma unroll
                    for (int i = 0; i < 16; ++i) { const f32x4 k0 = *(const f32x4*)(kf + 8 * i), k1 = *(const f32x4*)(kf + 8 * i + 4);
                        d += bflo(q[i][0]) * k0[0] + bfhi(q[i][0]) * k0[1] + bflo(q[i][1]) * k0[2] + bfhi(q[i][1]) * k0[3] + bflo(q[i][2]) * k1[0] + bfhi(q[i][2]) * k1[1] + bflo(q[i][3]) * k1[2] + bfhi(q[i][3]) * k1[3]; }
                }
                s = valid ? d * 0.08838834764831845f : -1e30f;
            }
            sc[g][sl] = s;
        }
    }
    float mx = -1e30f;
#pragma unroll
    for (int g = 0; g < 3; ++g)
#pragma unroll
        for (int sl = 0; sl < 3; ++sl) mx = fmaxf(mx, sc[g][sl]);
    mx = wave_max(mx);
    float ls = 0.f;
#pragma unroll
    for (int g = 0; g < 3; ++g)
#pragma unroll
        for (int sl = 0; sl < 3; ++sl) { const float pj = (sc[g][sl] > -1e29f) ? __expf(sc[g][sl] - mx) : 0.f; sc[g][sl] = pj; ls += pj; }
    ls = wave_sum(ls);
    float a0 = 0.f, a1 = 0.f;
#pragma unroll
    for (int g = 0; g < 3; ++g) {
        const int dil = g == 0 ? 1 : (g == 1 ? 4 : 16), win = g == 0 ? 128 : (g == 1 ? 512 : 2048);
        const float* cache = g == 0 ? p.c128 : (g == 1 ? p.c512 : p.c2048);
#pragma unroll
        for (int sl = 0; sl < 3; ++sl) {
            const int jn = sl < 2 ? 64 : 1;
            for (int jl = 0; jl < jn; ++jl) {
                const int j = jl + 64 * sl; const float pj = __shfl(sc[g][sl], jl);
                if (!samp) { int tok = row - j * dil; if (tok < 0) continue; const unsigned u = *(const unsigned*)(P + (size_t)tok * NP + C_VB + g * 1024 + h * 128 + 2 * lane); a0 += pj * bflo(u); a1 += pj * bfhi(u); }
                else { const int idx = win + st - j * dil;
                    if (idx >= win) { const unsigned u = *(const unsigned*)(P + (size_t)(SEQ + 4 * sb + idx - win) * NP + C_VB + g * 1024 + h * 128 + 2 * lane); a0 += pj * bflo(u); a1 += pj * bfhi(u); }
                    else { const f32x2 v = *(const f32x2*)(cache + (((size_t)sb * win + idx) * 2 + 1) * 1024 + h * 128 + 2 * lane); a0 += pj * v[0]; a1 += pj * v[1]; } }
            }
        }
    }
    const float inv = 1.f / ls; const unsigned z = *(const unsigned*)(P + (size_t)row * NP + C_ZB + h * 128 + 2 * lane);
    *(unsigned*)(OB + (size_t)row * 1024 + h * 128 + 2 * lane) = pk2(a0 * inv * siluf_(bflo(z)), a1 * inv * siluf_(bfhi(z)));
}
__device__ __forceinline__ void ph_attn_naive(const Params& p, int bid, int nb) {
    const int lane = threadIdx.x & 63, gw = __builtin_amdgcn_readfirstlane(threadIdx.x >> 6) * nb + bid, nw = nb * 8;
    for (int task = gw; task < MR * 8; task += nw) attn_naive_task(p, task >> 3, task & 7, lane);
}

__device__ __forceinline__ void ph_gnorm(const Params& p, int bid, int nb) {
    const bf16_t* P = (const bf16_t*)(p.ws + WS_P); bf16_t* OA = (bf16_t*)(p.ws + WS_OA);
    const int lane = threadIdx.x & 63, gw = __builtin_amdgcn_readfirstlane(threadIdx.x >> 6) * nb + bid, nw = nb * 8;
    const f32x2 nw2 = *(const f32x2*)(p.norm_a + 2 * lane);
    for (int task = gw; task < MR * 32; task += nw) { const int row = task >> 5, hv = task & 31;
        bf16_t* op = OA + (size_t)row * 4096 + hv * 128 + 2 * lane; const unsigned u = *(const unsigned*)op, z = *(const unsigned*)(P + (size_t)row * NP + C_ZA + hv * 128 + 2 * lane);
        const float o0 = bflo(u), o1 = bfhi(u); const float r = rsqrtf(wave_sum(o0 * o0 + o1 * o1) * (1.f / 128.f) + EPS);
        *(unsigned*)op = pk2(o0 * r * nw2[0] * siluf_(bflo(z)), o1 * r * nw2[1] * siluf_(bfhi(z))); }
}

__device__ __forceinline__ void ph_final(const Params& p, int bid, int nb) {
    const int lane = threadIdx.x & 63, gw = __builtin_amdgcn_readfirstlane(threadIdx.x >> 6) * nb + bid, nw = nb * 8;
    for (int row = gw; row < MR; row += nw) { float* hr = p.out + (size_t)row * DM; f32x4 v[8]; float ss = 0.f;
#pragma unroll
        for (int i = 0; i < 8; ++i) { v[i] = *(const f32x4*)(hr + i * 256 + lane * 4); ss += v[i][0] * v[i][0] + v[i][1] * v[i][1] + v[i][2] * v[i][2] + v[i][3] * v[i][3]; }
        ss = wave_sum(ss); const float r = rsqrtf(ss * (1.f / DM) + EPS);
#pragma unroll
        for (int i = 0; i < 8; ++i) { const f32x4 w = *(const f32x4*)(p.ln_f + i * 256 + lane * 4); *(f32x4*)(hr + i * 256 + lane * 4) = (f32x4){v[i][0] * r * w[0], v[i][1] * r * w[1], v[i][2] * r * w[2], v[i][3] * r * w[3]}; } }
}

__device__ __forceinline__ void ph_gemm1(const Params& p, LAS unsigned char* lds, int bid, int nb) {
    pg8::StaticOrder S; S.init(MP, NP, nb, bid);
    pg8::gemm_phase(lds, pg8::Gemm{(const bf16_t*)(p.ws + WS_XN), (const bf16_t*)(p.ws + WS_BT1), MP, NP, 2048}, S, pg8::EpiProj{(bf16_t*)(p.ws + WS_P), (float*)(p.ws + WS_BA)});
}
__device__ __forceinline__ void ph_gemm2a(const Params& p, LAS unsigned char* lds, int bid, int nb) {
    pg8::StaticOrder S; S.init(MP, DM, nb, bid);
    pg8::gemm_phase(lds, pg8::Gemm{(const bf16_t*)(p.ws + WS_OB), (const bf16_t*)(p.ws + WS_BT2B), MP, DM, 1024}, S, pg8::EpiGateB{(const bf16_t*)(p.ws + WS_P), (bf16_t*)(p.ws + WS_T)});
}
__device__ __forceinline__ void ph_gemm2b(const Params& p, LAS unsigned char* lds, int bid, int nb) {
    pg8::StaticOrder S; S.init(MP, DM, nb, bid);
    pg8::gemm_phase(lds, pg8::Gemm{(const bf16_t*)(p.ws + WS_OA), (const bf16_t*)(p.ws + WS_BT2A), MP, DM, 4096}, S, pg8::EpiMerge{(const bf16_t*)(p.ws + WS_P), (const bf16_t*)(p.ws + WS_T), (bf16_t*)(p.ws + WS_MG)});
}
__device__ __forceinline__ void ph_gemm3(const Params& p, LAS unsigned char* lds, int bid, int nb) {
    pg8::StaticOrder S; S.init(MP, DM, nb, bid);
    pg8::gemm_phase(lds, pg8::Gemm{(const bf16_t*)(p.ws + WS_MG), (const bf16_t*)(p.ws + WS_BT3), MP, DM, 2048}, S, pg8::EpiOut{p.x_prompt, p.x_sample, p.out});
}

constexpr int LDS_BYTES = pg8::STAGE_BYTES;
template <int PH> __global__ __launch_bounds__(512, 2) void k_phase(Params p) {
    extern __shared__ __attribute__((aligned(16))) unsigned char shm[];
    LAS unsigned char* lds = (LAS unsigned char*)shm;
    const int bid = blockIdx.x, nb = gridDim.x;
    if constexpr (PH == 0) ph_prologue(p, lds, bid, nb);
    if constexpr (PH == 1) ph_gemm1(p, lds, bid, nb);
    if constexpr (PH == 2) ph_prep(p, bid, nb);
    if constexpr (PH == 3) ph_delta_rec(p, bid, nb, 0, 256 + 8192);
    if constexpr (PH == 4) ph_attn_naive(p, bid, nb);
    if constexpr (PH == 5) ph_gnorm(p, bid, nb);
    if constexpr (PH == 6) ph_gemm2a(p, lds, bid, nb);
    if constexpr (PH == 7) ph_gemm2b(p, lds, bid, nb);
    if constexpr (PH == 8) ph_gemm3(p, lds, bid, nb);
    if constexpr (PH == 9) ph_final(p, bid, nb);
}

template <int PH> static void launch_phase(const Params& p, int grid, hipStream_t stream) {
    static bool attr = false;
    if (!attr) { (void)hipFuncSetAttribute((const void*)k_phase<PH>, hipFuncAttributeMaxDynamicSharedMemorySize, LDS_BYTES); attr = true; }
    hipLaunchKernelGGL((k_phase<PH>), dim3(grid), dim3(512), LDS_BYTES, stream, p);
}

extern "C" void kernel_launch(void* const* d_in, const int* in_sizes, int n_in, void* d_out, int out_size, void* d_ws, size_t ws_size, hipStream_t stream) {
    if (n_in != 17 || (size_t)out_size != O_END || ws_size < WS_END) { fprintf(stderr, "kernel_launch: unexpected sizes n_in %d out %d ws %zu (need %zu)\n", n_in, out_size, ws_size, (size_t)WS_END); return; }
    Params p{};
    p.x_prompt = (const float*)d_in[0]; p.x_sample = (const float*)d_in[1]; p.c128 = (const float*)d_in[2]; p.c512 = (const float*)d_in[3]; p.c2048 = (const float*)d_in[4];
    p.state_delta = (const float*)d_in[5]; p.state_conv = (const float*)d_in[6]; p.ln_in = (const float*)d_in[7]; p.w_in = (const float*)d_in[8]; p.conv_w = (const float*)d_in[9];
    p.a_log = (const float*)d_in[10]; p.dt_bias = (const float*)d_in[11]; p.norm_a = (const float*)d_in[12]; p.w_proj_a = (const float*)d_in[13]; p.w_proj_b = (const float*)d_in[14];
    p.w_out = (const float*)d_in[15]; p.ln_f = (const float*)d_in[16]; p.out = (float*)d_out; p.ws = (unsigned char*)d_ws;
    const int grid = 256;
    launch_phase<0>(p, grid, stream); launch_phase<1>(p, grid, stream); launch_phase<2>(p, grid, stream); launch_phase<3>(p, grid, stream); launch_phase<4>(p, grid, stream);
    launch_phase<5>(p, grid, stream); launch_phase<6>(p, grid, stream); launch_phase<7>(p, grid, stream); launch_phase<8>(p, grid, stream); launch_phase<9>(p, grid, stream);
}
```

```cpp
#include <hip/hip_runtime.h>
#include <stdint.h>
#include <stdio.h>

#define LAS __attribute__((address_space(3)))
typedef unsigned short bf16_t;
typedef short bf16x8 __attribute__((ext_vector_type(8)));
typedef float f32x4 __attribute__((ext_vector_type(4)));
typedef float f32x2 __attribute__((ext_vector_type(2)));
typedef unsigned u32x4 __attribute__((ext_vector_type(4)));
typedef unsigned u32x2 __attribute__((ext_vector_type(2)));

constexpr int DM = 2048, SEQ = 16384, NSAMP = 128, MR = SEQ + NSAMP  , MP = 16640  ;
constexpr int NPAD = 26880;
constexpr int NP = 17408;
constexpr int C_QA = 0, C_KA = 2048, C_VA = 4096, C_ZA = 8192, C_ZB = 12288, C_GA = 13312, C_GB = 15360;
constexpr float EPS = 1e-6f;
constexpr size_t O_Y = 0, O_YS = 33554432, O_KV128P = O_YS + 262144, O_KV512P = O_KV128P + 262144, O_KV2048P = O_KV512P + 1048576, O_DELTAP = O_KV2048P + 4194304,
                 O_CONVP = O_DELTAP + 524288, O_KV128S = O_CONVP + 24576, O_KV512S = O_KV128S + 8388608, O_KV2048S = O_KV512S + 33554432, O_DELTAS = O_KV2048S + 134217728,
                 O_CONVS = O_DELTAS + 16777216, O_END = O_CONVS + 786432;
constexpr int CH = 32, NCHUNK = SEQ / CH;
constexpr int REC_W = 0, REC_QG = 8192, REC_IN = 16384, REC_KD = 18432, REC_U = 26624, REC_GL = 34816, RECB = 35072, REC_DMA = 36864;
constexpr size_t WS_BAR = 0, WS_REC = 16384, REC_BYTES = (size_t)NCHUNK * 32 * RECB + 4096,
                 WS_XN = WS_REC, WS_BT1 = WS_XN + (size_t)MP * 2048 * 2, WS_T = WS_REC + ((size_t)200 << 20), WS_MG = WS_REC + ((size_t)300 << 20),
                 WS_BT2A = WS_REC + ((REC_BYTES + 255) & ~(size_t)255), WS_BT2B = WS_BT2A + (size_t)2048 * 4096 * 2,
                 WS_BT3 = WS_BT2B + (size_t)2048 * 1024 * 2, WS_P = WS_BT3 + (size_t)2048 * 2048 * 2, WS_BA = WS_P + (size_t)MP * NP * 2, WS_BG = WS_BA + (size_t)MP * 64 * 4,
                 WS_CV = WS_BG + (size_t)MP * 64 * 4, WS_OA = WS_CV + (size_t)MP * 8192 * 2, WS_OB = WS_OA + (size_t)MP * 4096 * 2, WS_QKVC = WS_OB + (size_t)MP * 1024 * 2, WS_PS = WS_QKVC + (size_t)3 * 3 * 8 * SEQ * 128 * 2, WS_END = WS_PS + (size_t)256 * 9216 * 2,
                 WS_OG = WS_CV  , WS_LSE = WS_CV + (size_t)3 * SEQ * 1024 * 2;
static_assert(WS_LSE + (size_t)3 * SEQ * 8 * 4 <= WS_OA, "OG/LSE inside CV");
static_assert(WS_BT1 + (size_t)NPAD * 2048 * 2 <= WS_T && WS_T + (size_t)MP * 2048 * 2 <= WS_MG && WS_MG + (size_t)MP * 2048 * 2 <= WS_BT2A, "aliases inside REC");

__host__ __device__ __forceinline__ size_t qkvc_row(int which, int g, int h, int tok) { const int sh = 2 * g, pos = (tok & ((1 << sh) - 1)) * (SEQ >> sh) + (tok >> sh); return ((size_t)((which * 3 + g) * 8 + h) * SEQ + pos) * 128; }
struct Params {
    const float *x_prompt, *x_sample, *c128, *c512, *c2048, *state_delta, *state_conv, *ln_in, *w_in, *conv_w, *a_log, *dt_bias, *norm_a, *w_proj_a, *w_proj_b, *w_out, *ln_f;
    float* out;
    unsigned char* ws;
};

__device__ __forceinline__ int tidx() { int t = threadIdx.x; asm volatile("" : "+v"(t)); return t; }
__device__ __forceinline__ float bf2f(bf16_t b) { return __uint_as_float(((unsigned)b) << 16); }
__device__ __forceinline__ float bflo(unsigned u) { return __uint_as_float(u << 16); }
__device__ __forceinline__ float bfhi(unsigned u) { return __uint_as_float(u & 0xffff0000u); }
__device__ __forceinline__ bf16_t f2bf(float f) { unsigned u = __float_as_uint(f); u += 0x7FFFu + ((u >> 16) & 1u); return (bf16_t)(u >> 16); }
typedef __bf16 bf16x2_t __attribute__((ext_vector_type(2)));
__device__ __forceinline__ unsigned pk2(float lo, float hi) { const f32x2 v = {lo, hi}; return __builtin_bit_cast(unsigned, __builtin_convertvector(v, bf16x2_t)); }
__device__ __forceinline__ float sigmoidf_(float x) { return __builtin_amdgcn_rcpf(1.f + __builtin_amdgcn_exp2f(-1.4426950408889634f * x)); }
__device__ __forceinline__ float siluf_(float x) { return x * __builtin_amdgcn_rcpf(1.f + __builtin_amdgcn_exp2f(-1.4426950408889634f * x)); }
__device__ __forceinline__ float wave_sum(float v) {
#pragma unroll
    for (int o = 32; o >= 1; o >>= 1) v += __shfl_xor(v, o);
    return v;
}
__device__ __forceinline__ float wave_max(float v) {
#pragma unroll
    for (int o = 32; o >= 1; o >>= 1) v = fmaxf(v, __shfl_xor(v, o));
    return v;
}


#define XB_TMO      128
#define XB_XCNT(j)  (256  + 64 * (j))
#define XB_XSUB(j)  (1280 + 64 * (j))
#define XB_XGEN(j)  (2304 + 64 * (j))
#define XB_TOP      3328
#define XB_TOPGEN   3392
#define XCD_BAR_WORDS 3456
#define XB_SPIN_CAP (1u << 18)
__device__ __forceinline__ unsigned xb_ld(unsigned* p)              { return __hip_atomic_load(p, __ATOMIC_RELAXED, __HIP_MEMORY_SCOPE_AGENT); }
__device__ __forceinline__ unsigned xb_add(unsigned* p, unsigned v) { return __hip_atomic_fetch_add(p, v, __ATOMIC_RELAXED, __HIP_MEMORY_SCOPE_AGENT); }
__device__ __forceinline__ unsigned xb_xcc_id() { return (unsigned)__builtin_amdgcn_s_getreg((3 << 11) | 20) & 0xFu; }
#define XB_SPIN(cond, bar) do { unsigned _sp = 0; while (cond) { __builtin_amdgcn_s_sleep(1); \
    if ((++_sp & 255u) == 0u) { if (xb_ld(&(bar)[XB_TMO])) break; if (_sp > XB_SPIN_CAP) { atomicAdd(&(bar)[XB_TMO], 1u); break; } } } } while (0)
struct XcdBarrier { unsigned* bar; unsigned x; volatile LAS unsigned* st; };
__device__ __forceinline__ XcdBarrier xcd_barrier_post(unsigned* bar, volatile LAS unsigned* st) {
    XcdBarrier b; b.bar = bar; b.x = xb_xcc_id(); b.st = st;
    if (threadIdx.x == 0) (void)xb_add(&bar[XB_XCNT(b.x)], 1u);
    return b;
}
__device__ __forceinline__ void xcd_barrier_complete(unsigned* bar, unsigned x, unsigned& nloc, unsigned& nx) {
    const unsigned G = gridDim.x * gridDim.y * gridDim.z;
    unsigned sum, cnt, mine, sp = 0u;
    for (;;) {
        sum = 0u; cnt = 0u; mine = 0u;
#pragma unroll
        for (unsigned j = 0; j < 16; ++j) { const unsigned c = xb_ld(&bar[XB_XCNT(j)]); sum += c; cnt += (c > 0u) ? 1u : 0u; mine = (j == x) ? c : mine; }
        if (sum == G) break;
        __builtin_amdgcn_s_sleep(1);
        if ((++sp & 255u) == 0u) { if (xb_ld(&bar[XB_TMO])) break; if (sp > XB_SPIN_CAP) { atomicAdd(&bar[XB_TMO], 1u); break; } }
    }
    nloc = mine > 0u ? mine : 1u; nx = cnt > 0u ? cnt : 1u;
}
__device__ __forceinline__ void xcd_barrier(const XcdBarrier& b) {
    asm volatile("s_waitcnt vmcnt(0)" ::: "memory");
    __syncthreads();
    if (threadIdx.x == 0) {
        unsigned* bar = b.bar;
        __builtin_amdgcn_s_waitcnt(0);
        unsigned nloc = b.st[0], nx = b.st[1];
        if (nloc == 0u) { xcd_barrier_complete(bar, b.x, nloc, nx); b.st[0] = nloc; b.st[1] = nx; }
        const unsigned old = xb_add(&bar[XB_XSUB(b.x)], 1u);
        const unsigned gen = old / nloc;
        if (old + 1u == (gen + 1u) * nloc) {
            __builtin_amdgcn_fence(__ATOMIC_RELEASE, "agent");
            asm volatile("s_waitcnt vmcnt(0)" ::: "memory");
            const unsigned og = xb_add(&bar[XB_TOP], 1u);
            const unsigned tg = og / nx;
            if (og + 1u == (tg + 1u) * nx) xb_add(&bar[XB_TOPGEN], 1u);
            else XB_SPIN(xb_ld(&bar[XB_TOPGEN]) == tg, bar);
            __builtin_amdgcn_fence(__ATOMIC_ACQUIRE, "agent");
            xb_add(&bar[XB_XGEN(b.x)], 1u);
            asm volatile("s_waitcnt vmcnt(0)" ::: "memory");
        } else {
            XB_SPIN(xb_ld(&bar[XB_XGEN(b.x)]) == gen, bar);
            __builtin_amdgcn_fence(__ATOMIC_ACQUIRE, "agent");
            asm volatile("s_waitcnt vmcnt(0)" ::: "memory");
        }
    }
    __syncthreads();
}

namespace pg8 {
constexpr int BM = 256, BK = 64, HALF = 128, HTB = HALF * BK * 2, STAGE_BYTES = 8 * HTB, NXCD = 8, WGM = 8;
__host__ __device__ __forceinline__ int lds_byte(int r, int c) { const int st = (r >> 4) * 2 + (c >> 5), rr = r & 15, cc = c & 31, ob = rr * 64 + cc * 2; return st * 1024 + (ob ^ (((ob >> 9) & 1) << 5)); }
__host__ __device__ __forceinline__ void stage_rc(int b, int& R, int& C) { const int st = b / 1024, sb = b % 1024, swz = sb ^ (((sb >> 9) & 1) << 5); R = (st >> 1) * 16 + swz / 64; C = (st & 1) * 32 + (swz % 64) / 2; }
__host__ __device__ __forceinline__ int perm32(int rho) { const int n = rho >> 4, i = rho & 15; return 8 * (i >> 2) + 4 * n + (i & 3); }
struct Unit { int pm, pn; };
struct Gemm { const bf16_t* A; const bf16_t* Bt; int M, N, K; };
struct StaticOrder {
    int nM, nN, nwg, G, c;
    __host__ __device__ void init(int M, int N, int G_, int c_) { nM = M / BM; nN = N / BM; nwg = nM * nN; G = G_; c = c_; }
    __host__ __device__ bool next(int i, Unit& u) const {
        const long L = (long)i * G + c; if (L >= nwg) return false;
        int wgid = (int)L; { const int q = nwg / NXCD, r = nwg % NXCD, xcd = wgid % NXCD, off = wgid / NXCD; wgid = (xcd < r ? xcd * (q + 1) : r * (q + 1) + (xcd - r) * q) + off; }
        const int nig = WGM * nN, gid = wgid / nig, fm = gid * WGM, gsz = (nM - fm) < WGM ? (nM - fm) : WGM;
        u.pm = fm + ((wgid % nig) % gsz); u.pn = (wgid % nig) / gsz; return true;
    }
    __device__ __forceinline__ void a_ready(const Unit&) const {}
    __device__ __forceinline__ void done(const Unit&) const {}
};
__device__ __forceinline__ unsigned cvt_pk_bf16(float lo, float hi) { return pk2(lo, hi); }

template <class Epi, class Sched>
__device__ __forceinline__ void gemm_phase(LAS unsigned char* lds, const Gemm g, const Sched& S, const Epi& E) {
    const int tid = tidx(), wid = __builtin_amdgcn_readfirstlane(tid >> 6), lane = tid & 63, wr = wid >> 2, wc = wid & 3, fr = lane & 15, fq = lane >> 4;
    const int K = g.K, nt = K / BK;
    unsigned voffA[2], voffB[2];
#pragma unroll
    for (int i = 0; i < 2; ++i) { int R, C; stage_rc(tid * 16 + i * 8192, R, C); const int Rb = Epi::PERM ? ((R & ~31) + perm32(R & 31)) : R;
        voffA[i] = (unsigned)(R * K + C) * 2u; voffB[i] = (unsigned)(Rb * K + C) * 2u; }
    const size_t kstep = (size_t)(BK * 2);
    const size_t hstep = (size_t)HALF * K * 2;
    const size_t tstep = 2 * hstep;
    const unsigned ldsw = (unsigned)wid * 1024u;
    const int aoff = lds_byte(wr * 64 + fr, fq * 8), boff = lds_byte(wc * 32 + fr, fq * 8);
#define PG8_SA(b, h) (((b) * 2 + (h)) * HTB)
#define PG8_SB(b, h) ((4 + (b) * 2 + (h)) * HTB)
#define PG8_STAGE(bufoff, gbase, voff) do { _Pragma("unroll") for (int _i = 0; _i < 2; ++_i) \
        __builtin_amdgcn_global_load_lds((const unsigned*)((const char*)(gbase) + (voff)[_i]), (LAS unsigned*)(lds + (bufoff) + ldsw + _i * 8192), 16, 0, 0); } while (0)
#define PG8_LDA(dst, b, h) do { _Pragma("unroll") for (int m = 0; m < 4; ++m) _Pragma("unroll") for (int k = 0; k < 2; ++k) dst[m][k] = *(const LAS bf16x8*)(lds + PG8_SA(b, h) + aoff + m * 2048 + k * 1024); } while (0)
#define PG8_LDB(dst, b, h) do { _Pragma("unroll") for (int n = 0; n < 2; ++n) _Pragma("unroll") for (int k = 0; k < 2; ++k) dst[n][k] = *(const LAS bf16x8*)(lds + PG8_SB(b, h) + boff + n * 2048 + k * 1024); } while (0)
#define PG8_MMA(ai, bj, At, Bt) do { __builtin_amdgcn_s_setprio(1); _Pragma("unroll") for (int m = 0; m < 4; ++m) _Pragma("unroll") for (int n = 0; n < 2; ++n) _Pragma("unroll") for (int k = 0; k < 2; ++k) \
        acc[ai][bj][m][n] = __builtin_amdgcn_mfma_f32_16x16x32_bf16(Bt[n][k], At[m][k], acc[ai][bj][m][n], 0, 0, 0); __builtin_amdgcn_s_setprio(0); } while (0)
#define PG8_WAIT_V(n) asm volatile("s_waitcnt vmcnt(" #n ")" ::: "memory")
#define PG8_WAIT_L(n) asm volatile("s_waitcnt lgkmcnt(" #n ")" ::: "memory")
#define PG8_BAR __builtin_amdgcn_s_barrier()
#define PG8_SCHED __builtin_amdgcn_sched_barrier(0)
    Unit cur, nxt; int ui = 0;
    if (!S.next(0, cur)) return;
    f32x4 acc[2][2][4][2];
#pragma unroll
    for (int a = 0; a < 2; ++a)
#pragma unroll
        for (int b = 0; b < 2; ++b)
#pragma unroll
            for (int m = 0; m < 4; ++m)
#pragma unroll
                for (int n = 0; n < 2; ++n) acc[a][b][m][n] = (f32x4){0.f, 0.f, 0.f, 0.f};
    bf16x8 At[4][2], B0[2][2], B1[2][2];
    const char* cA = (const char*)g.A + (size_t)cur.pm * tstep; const char* cB = (const char*)g.Bt + (size_t)cur.pn * tstep;
    S.a_ready(cur);
    PG8_STAGE(PG8_SB(0, 0), cB, voffB); PG8_STAGE(PG8_SA(0, 0), cA, voffA); PG8_STAGE(PG8_SB(0, 1), cB + hstep, voffB); PG8_STAGE(PG8_SA(0, 1), cA + hstep, voffA);
    if (wr == 1) PG8_BAR;
    PG8_WAIT_V(4); PG8_BAR;
    PG8_STAGE(PG8_SB(1, 0), cB + kstep, voffB); PG8_STAGE(PG8_SA(1, 0), cA + kstep, voffA); PG8_STAGE(PG8_SB(1, 1), cB + hstep + kstep, voffB);
    PG8_WAIT_V(6); PG8_BAR;
    for (;;) {
        const bool has_next = S.next(ui + 1, nxt);
        const char* nA = has_next ? (const char*)g.A + (size_t)nxt.pm * tstep : cA; const char* nB = has_next ? (const char*)g.Bt + (size_t)nxt.pn * tstep : cB;
        for (int t = 0; t < nt; t += 2) {
            const bool last = (t == nt - 2);
            const char* a1 = cA + (size_t)(t + 1) * kstep;
            const char* a2 = last ? nA : cA + (size_t)(t + 2) * kstep; const char* b2 = last ? nB : cB + (size_t)(t + 2) * kstep;
            const char* a3 = a2 + kstep; const char* b3 = b2 + kstep;
            if (last && has_next) S.a_ready(nxt);
            PG8_LDB(B0, 0, 0); PG8_SCHED; PG8_LDA(At, 0, 0); PG8_STAGE(PG8_SA(1, 1), a1 + hstep, voffA);
            PG8_WAIT_L(8); PG8_BAR; PG8_WAIT_L(0); PG8_MMA(0, 0, At, B0); PG8_BAR; PG8_SCHED;
            PG8_LDB(B1, 0, 1); PG8_STAGE(PG8_SB(0, 0), b2, voffB);
            PG8_BAR; PG8_WAIT_L(0); PG8_MMA(0, 1, At, B1); PG8_BAR;
            PG8_LDA(At, 0, 1); PG8_STAGE(PG8_SA(0, 0), a2, voffA);
            PG8_BAR; PG8_WAIT_L(0); PG8_MMA(1, 0, At, B0); PG8_BAR; PG8_SCHED;
            PG8_STAGE(PG8_SB(0, 1), b2 + hstep, voffB);
            PG8_WAIT_V(6); PG8_BAR; PG8_MMA(1, 1, At, B1); PG8_BAR;
            PG8_LDB(B0, 1, 0); PG8_SCHED; PG8_LDA(At, 1, 0); PG8_STAGE(PG8_SA(0, 1), a2 + hstep, voffA);
            PG8_WAIT_L(8); PG8_BAR; PG8_WAIT_L(0); PG8_MMA(0, 0, At, B0); PG8_BAR; PG8_SCHED;
            PG8_LDB(B1, 1, 1); PG8_STAGE(PG8_SB(1, 0), b3, voffB);
            PG8_BAR; PG8_WAIT_L(0); PG8_MMA(0, 1, At, B1); PG8_BAR;
            PG8_LDA(At, 1, 1); PG8_STAGE(PG8_SA(1, 0), a3, voffA);
            PG8_BAR; PG8_WAIT_L(0); PG8_MMA(1, 0, At, B0); PG8_BAR; PG8_SCHED;
            PG8_STAGE(PG8_SB(1, 1), b3 + hstep, voffB);
            PG8_WAIT_V(6); PG8_BAR; PG8_MMA(1, 1, At, B1); PG8_BAR;
        }
        E(acc, cur, wr, wc, fr, fq); S.done(cur);
        if (!has_next) break;
#pragma unroll
        for (int a = 0; a < 2; ++a)
#pragma unroll
            for (int b = 0; b < 2; ++b)
#pragma unroll
                for (int m = 0; m < 4; ++m)
#pragma unroll
                    for (int n = 0; n < 2; ++n) acc[a][b][m][n] = (f32x4){0.f, 0.f, 0.f, 0.f};
        cur = nxt; cA = nA; cB = nB; ++ui;
    }
    PG8_WAIT_V(0);
    if (wr == 0) PG8_BAR;
    PG8_BAR;
#undef PG8_SA
#undef PG8_SB
#undef PG8_STAGE
#undef PG8_LDA
#undef PG8_LDB
#undef PG8_MMA
#undef PG8_WAIT_V
#undef PG8_WAIT_L
#undef PG8_BAR
#undef PG8_SCHED
}

struct EpiProj {
    static constexpr bool PERM = true;
    bf16_t* P; float* BA; bf16_t* QKVC; bf16_t* PS;
    __device__ __forceinline__ void operator()(const f32x4 (&acc)[2][2][4][2], const Unit& u, int wr, int wc, int fr, int fq) const {
        const int row0 = u.pm * BM + wr * 64 + fr;
        if (u.pn >= 48 && u.pn < 84) {
#pragma unroll
            for (int bj = 0; bj < 2; ++bj) { const int hh = (u.pn - 48) * 2 + bj, which = hh / 24, g = (hh % 24) >> 3, h = hh & 7, d0 = wc * 32 + 8 * fq;
#pragma unroll
                for (int ai = 0; ai < 2; ++ai)
#pragma unroll
                    for (int m = 0; m < 4; ++m) { const int row = row0 + ai * HALF + m * 16; const f32x4 v0 = acc[ai][bj][m][0], v1 = acc[ai][bj][m][1];
                        bf16_t* dst = row < SEQ ? QKVC + qkvc_row(which, g, h, row) + d0 : PS + (size_t)(row - SEQ) * 9216 + hh * 128 + d0;
                        *(u32x4*)dst = (u32x4){cvt_pk_bf16(v0[0], v0[1]), cvt_pk_bf16(v0[2], v0[3]), cvt_pk_bf16(v1[0], v1[1]), cvt_pk_bf16(v1[2], v1[3])}; } }
        } else if (u.pn < 104) {
            const int col0 = (u.pn < 48 ? u.pn : u.pn - 36) * BM + wc * 32 + 8 * fq;
#pragma unroll
            for (int ai = 0; ai < 2; ++ai)
#pragma unroll
                for (int m = 0; m < 4; ++m) { bf16_t* rowp = P + (size_t)(row0 + ai * HALF + m * 16) * NP + col0;
#pragma unroll
                    for (int bj = 0; bj < 2; ++bj) { const f32x4 v0 = acc[ai][bj][m][0], v1 = acc[ai][bj][m][1];
                        *(u32x4*)(rowp + bj * HALF) = (u32x4){cvt_pk_bf16(v0[0], v0[1]), cvt_pk_bf16(v0[2], v0[3]), cvt_pk_bf16(v1[0], v1[1]), cvt_pk_bf16(v1[2], v1[3])}; } }
        } else if (wc < 2) {
#pragma unroll
            for (int ai = 0; ai < 2; ++ai)
#pragma unroll
                for (int m = 0; m < 4; ++m) { float* rp = BA + (size_t)(row0 + ai * HALF + m * 16) * 64 + wc * 32 + 8 * fq;
                    *(f32x4*)rp = acc[ai][0][m][0]; *(f32x4*)(rp + 4) = acc[ai][0][m][1]; }
        }
    }
};
__device__ __forceinline__ void sig8(const bf16_t* p, float (&s)[8]) {
    const u32x4 g = *(const u32x4*)p;
#pragma unroll
    for (int i = 0; i < 4; ++i) { s[2 * i] = sigmoidf_(bflo(g[i])); s[2 * i + 1] = sigmoidf_(bfhi(g[i])); }
}
struct EpiGateB {
    static constexpr bool PERM = true;
    const bf16_t* P; bf16_t* T;
    __device__ __forceinline__ void operator()(const f32x4 (&acc)[2][2][4][2], const Unit& u, int wr, int wc, int fr, int fq) const {
        const int row0 = u.pm * BM + wr * 64 + fr, col0 = u.pn * BM + wc * 32 + 8 * fq;
#pragma unroll
        for (int ai = 0; ai < 2; ++ai)
#pragma unroll
            for (int m = 0; m < 4; ++m) { const size_t row = (size_t)(row0 + ai * HALF + m * 16);
#pragma unroll
                for (int bj = 0; bj < 2; ++bj) { const f32x4 v0 = acc[ai][bj][m][0], v1 = acc[ai][bj][m][1]; const int c = col0 + bj * HALF;
                    float s[8]; sig8(P + row * NP + C_GB + c, s);
                    *(u32x4*)(T + row * DM + c) = (u32x4){cvt_pk_bf16(v0[0] * s[0], v0[1] * s[1]), cvt_pk_bf16(v0[2] * s[2], v0[3] * s[3]), cvt_pk_bf16(v1[0] * s[4], v1[1] * s[5]), cvt_pk_bf16(v1[2] * s[6], v1[3] * s[7])}; } }
    }
};
struct EpiMerge {
    static constexpr bool PERM = true;
    const bf16_t* P; const bf16_t* T; bf16_t* MG;
    __device__ __forceinline__ void operator()(const f32x4 (&acc)[2][2][4][2], const Unit& u, int wr, int wc, int fr, int fq) const {
        const int row0 = u.pm * BM + wr * 64 + fr, col0 = u.pn * BM + wc * 32 + 8 * fq;
#pragma unroll
        for (int ai = 0; ai < 2; ++ai)
#pragma unroll
            for (int m = 0; m < 4; ++m) { const size_t row = (size_t)(row0 + ai * HALF + m * 16);
#pragma unroll
                for (int bj = 0; bj < 2; ++bj) { const f32x4 v0 = acc[ai][bj][m][0], v1 = acc[ai][bj][m][1]; const int c = col0 + bj * HALF;
                    float s[8]; sig8(P + row * NP + C_GA + c, s);
                    const u32x4 t = *(const u32x4*)(T + row * DM + c);
                    *(u32x4*)(MG + row * DM + c) = (u32x4){cvt_pk_bf16(v0[0] * s[0] + bflo(t[0]), v0[1] * s[1] + bfhi(t[0])), cvt_pk_bf16(v0[2] * s[2] + bflo(t[1]), v0[3] * s[3] + bfhi(t[1])),
                                                           cvt_pk_bf16(v1[0] * s[4] + bflo(t[2]), v1[1] * s[5] + bfhi(t[2])), cvt_pk_bf16(v1[2] * s[6] + bflo(t[3]), v1[3] * s[7] + bfhi(t[3]))}; } }
    }
};
struct EpiOut {
    static constexpr bool PERM = true;
    const float* xp; bf16_t* H;
    __device__ __forceinline__ void operator()(const f32x4 (&acc)[2][2][4][2], const Unit& u, int wr, int wc, int fr, int fq) const {
        const int row0 = u.pm * BM + wr * 64 + fr, col0 = u.pn * BM + wc * 32 + 8 * fq;
#pragma unroll
        for (int ai = 0; ai < 2; ++ai)
#pragma unroll
            for (int m = 0; m < 4; ++m) { const int row = row0 + ai * HALF + m * 16;
                if (row < SEQ) { const float* xr = xp + (size_t)row * DM; bf16_t* hr = H + (size_t)row * DM;
#pragma unroll
                    for (int bj = 0; bj < 2; ++bj) { const int c = col0 + bj * HALF; const f32x4 v0 = acc[ai][bj][m][0] + *(const f32x4*)(xr + c), v1 = acc[ai][bj][m][1] + *(const f32x4*)(xr + c + 4);
                        *(u32x4*)(hr + c) = (u32x4){cvt_pk_bf16(v0[0], v0[1]), cvt_pk_bf16(v0[2], v0[3]), cvt_pk_bf16(v1[0], v1[1]), cvt_pk_bf16(v1[2], v1[3])}; } } }
    }
};
}

struct TileDesc { const float* src; bf16_t* dst; int ld_src, ld_dst, k0, n0src, n0dst; bool zero; };
__device__ __forceinline__ TileDesc tile_desc(const Params& p, const float* w_in, const float* w_pa, const float* w_pb, const float* w_o, int u) {
    constexpr int U0 = 32 * 420, U1 = U0 + 64 * 32, U2 = U1 + 16 * 32;
    TileDesc t; t.zero = false;
    if (u < U0) { const int kt = u & 31, nt = u >> 5, n0 = nt * 64; int ns;
        if (n0 < 12288) ns = n0; else if (n0 < 26624) ns = n0 + 64; else if (n0 < 26688) ns = 12288 + (n0 - 26624); else { ns = 0; t.zero = true; }
        t.src = w_in; t.ld_src = 26688; t.k0 = kt * 64; t.n0src = ns; t.dst = (bf16_t*)(p.ws + WS_BT1); t.ld_dst = 2048; t.n0dst = n0;
    } else if (u < U1) { const int v = u - U0, kt = v & 63, nt = v >> 6; t.src = w_pa; t.ld_src = 2048; t.k0 = kt * 64; t.n0src = nt * 64; t.dst = (bf16_t*)(p.ws + WS_BT2A); t.ld_dst = 4096; t.n0dst = nt * 64;
    } else if (u < U2) { const int v = u - U1, kt = v & 15, nt = v >> 4; t.src = w_pb; t.ld_src = 2048; t.k0 = kt * 64; t.n0src = nt * 64; t.dst = (bf16_t*)(p.ws + WS_BT2B); t.ld_dst = 1024; t.n0dst = nt * 64;
    } else { const int v = u - U2, kt = v & 31, nt = v >> 5; t.src = w_o; t.ld_src = 2048; t.k0 = kt * 64; t.n0src = nt * 64; t.dst = (bf16_t*)(p.ws + WS_BT3); t.ld_dst = 2048; t.n0dst = nt * 64; }
    return t;
}
constexpr int PRO_TILES = 32 * 420 + 64 * 32 + 16 * 32 + 32 * 32;
constexpr int PRO_TILES1 = 32 * 420;
static_assert(PRO_TILES1 % 4 == 0 && PRO_TILES % 4 == 0, "tile batches");
__device__ __forceinline__ void pro_tiles4(const Params& p, LAS unsigned char* lds, int u0, int tid, const float* w_in, const float* w_pa, const float* w_pb, const float* w_o) {
    const int r = tid >> 4, c4 = tid & 15, n = tid >> 3, k8 = tid & 7;
        f32x4 v[4][2];
#pragma unroll
        for (int j = 0; j < 4; ++j) { const int u = u0 + j;
#pragma unroll
            for (int h = 0; h < 2; ++h) v[j][h] = (f32x4){0.f, 0.f, 0.f, 0.f};
            if (u < PRO_TILES) { const TileDesc t = tile_desc(p, w_in, w_pa, w_pb, w_o, u);
                if (!t.zero) {
#pragma unroll
                    for (int h = 0; h < 2; ++h) v[j][h] = *(const f32x4*)(t.src + (size_t)(t.k0 + r + 32 * h) * t.ld_src + t.n0src + 4 * c4); } } }
#pragma unroll
        for (int j = 0; j < 4; ++j) { LAS float* tile = (LAS float*)(lds + j * 16640);
#pragma unroll
            for (int h = 0; h < 2; ++h)
#pragma unroll
                for (int i = 0; i < 4; ++i) tile[(r + 32 * h) * 65 + 4 * c4 + i] = v[j][h][i]; }
        __syncthreads();
#pragma unroll
        for (int j = 0; j < 4; ++j) { const int u = u0 + j;
            if (u < PRO_TILES) { const TileDesc t = tile_desc(p, w_in, w_pa, w_pb, w_o, u); const LAS float* tile = (const LAS float*)(lds + j * 16640); float f[8];
#pragma unroll
                for (int i = 0; i < 8; ++i) f[i] = tile[(8 * k8 + i) * 65 + n];
                *(u32x4*)(t.dst + (size_t)(t.n0dst + n) * t.ld_dst + t.k0 + 8 * k8) = (u32x4){pk2(f[0], f[1]), pk2(f[2], f[3]), pk2(f[4], f[5]), pk2(f[6], f[7])}; } }
        __syncthreads();
}
__device__ __forceinline__ void pro_load4(const Params& p, int u0, int tid, const float* w_in, const float* w_pa, const float* w_pb, const float* w_o, f32x4 (&v)[4][2]) {
    const int r = tid >> 4, c4 = tid & 15;
#pragma unroll
    for (int j = 0; j < 4; ++j) { const int u = u0 + j;
#pragma unroll
        for (int h = 0; h < 2; ++h) v[j][h] = (f32x4){0.f, 0.f, 0.f, 0.f};
        if (u < PRO_TILES) { const TileDesc t = tile_desc(p, w_in, w_pa, w_pb, w_o, u);
            if (!t.zero) {
#pragma unroll
                for (int h = 0; h < 2; ++h) v[j][h] = *(const f32x4*)(t.src + (size_t)(t.k0 + r + 32 * h) * t.ld_src + t.n0src + 4 * c4); } } }
}
__device__ __forceinline__ void pro_store4(const Params& p, LAS unsigned char* lds, int u0, int tid, const float* w_in, const float* w_pa, const float* w_pb, const float* w_o, const f32x4 (&v)[4][2]) {
    const int r = tid >> 4, c4 = tid & 15, n = tid >> 3, k8 = tid & 7;
#pragma unroll
    for (int j = 0; j < 4; ++j) { LAS float* tile = (LAS float*)(lds + j * 16640);
#pragma unroll
        for (int h = 0; h < 2; ++h)
#pragma unroll
            for (int i = 0; i < 4; ++i) tile[(r + 32 * h) * 65 + 4 * c4 + i] = v[j][h][i]; }
    __syncthreads();
#pragma unroll
    for (int j = 0; j < 4; ++j) { const int u = u0 + j;
        if (u < PRO_TILES) { const TileDesc t = tile_desc(p, w_in, w_pa, w_pb, w_o, u); const LAS float* tile = (const LAS float*)(lds + j * 16640); float f[8];
#pragma unroll
            for (int i = 0; i < 8; ++i) f[i] = tile[(8 * k8 + i) * 65 + n];
            *(u32x4*)(t.dst + (size_t)(t.n0dst + n) * t.ld_dst + t.k0 + 8 * k8) = (u32x4){pk2(f[0], f[1]), pk2(f[2], f[3]), pk2(f[4], f[5]), pk2(f[6], f[7])}; } }
    __syncthreads();
}
__device__ __forceinline__ void ph_prologue(const Params& p, LAS unsigned char* lds, int bid, int nb) {
    const int tid = tidx(), r = tid >> 4, c4 = tid & 15, n = tid >> 3, k8 = tid & 7;
    const float *w_in = p.w_in, *w_pa = p.w_proj_a, *w_pb = p.w_proj_b, *w_o = p.w_out;
    asm volatile("" : "+s"(w_in), "+s"(w_pa), "+s"(w_pb), "+s"(w_o));
    const int ulim = nb == 256 ? PRO_TILES1 : PRO_TILES;
    { const int step = nb * 4; f32x4 va[4][2], vb[4][2];
      int u0 = bid * 4;
      if (u0 < ulim) pro_load4(p, u0, tid, w_in, w_pa, w_pb, w_o, va);
      for (; u0 < ulim; u0 += 2 * step) {
          if (u0 + step < ulim) pro_load4(p, u0 + step, tid, w_in, w_pa, w_pb, w_o, vb);
          pro_store4(p, lds, u0, tid, w_in, w_pa, w_pb, w_o, va);
          if (u0 + 2 * step < ulim) pro_load4(p, u0 + 2 * step, tid, w_in, w_pa, w_pb, w_o, va);
          if (u0 + step < ulim) pro_store4(p, lds, u0 + step, tid, w_in, w_pa, w_pb, w_o, vb);
      } }
    const int lane = tid & 63, gw = __builtin_amdgcn_readfirstlane(tid >> 6) * nb + bid, nw = nb * 8;
    for (int row = gw; row < MP; row += nw) {
        bf16_t* xn = (bf16_t*)(p.ws + WS_XN) + (size_t)row * DM;
        if (row < MR) { const float* xr = row < SEQ ? p.x_prompt + (size_t)row * DM : p.x_sample + (size_t)(row - SEQ) * DM;
            f32x4 v[8]; float ss = 0.f;
#pragma unroll
            for (int i = 0; i < 8; ++i) { v[i] = *(const f32x4*)(xr + i * 256 + lane * 4); ss += v[i][0] * v[i][0] + v[i][1] * v[i][1] + v[i][2] * v[i][2] + v[i][3] * v[i][3]; }
            ss = wave_sum(ss); const float rr = rsqrtf(ss * (1.f / DM) + EPS);
#pragma unroll
            for (int i = 0; i < 8; ++i) { const f32x4 w = *(const f32x4*)(p.ln_in + i * 256 + lane * 4);
                *(u32x2*)(xn + i * 256 + lane * 4) = (u32x2){pk2(v[i][0] * rr * w[0], v[i][1] * rr * w[1]), pk2(v[i][2] * rr * w[2], v[i][3] * rr * w[3])}; }
        } else {
#pragma unroll
            for (int i = 0; i < 8; ++i) *(u32x2*)(xn + i * 256 + lane * 4) = (u32x2){0u, 0u};
            bf16_t* oa = (bf16_t*)(p.ws + WS_OA) + (size_t)row * 4096; bf16_t* ob = (bf16_t*)(p.ws + WS_OB) + (size_t)row * 1024;
#pragma unroll
            for (int i = 0; i < 16; ++i) *(u32x2*)(oa + i * 256 + lane * 4) = (u32x2){0u, 0u};
#pragma unroll
            for (int i = 0; i < 4; ++i) *(u32x2*)(ob + i * 256 + lane * 4) = (u32x2){0u, 0u};
        }
    }
}

template <int WIN> __device__ __forceinline__ void kvcopy_one(const float* cache, float* dst, int cb, int ncb, int tid) {
    constexpr int NR = 32 * (WIN - 4);
    f32x4 va[12], vb[12];
#define KV_ROWS(R0_, src_, dst_) do { _Pragma("unroll") for (int k = 0; k < 12; ++k) { int R = (R0_) + k * ncb; R = R < NR ? R : NR - 1; const int b = R / (WIN - 4), j = R - b * (WIN - 4); \
        src_[k] = cache + ((size_t)(b * WIN + j + 4) * 512 + tid) * 4; dst_[k] = dst + ((size_t)(b * WIN + j) * 512 + tid) * 4; } } while (0)
    const float* sa[12]; float* da[12]; const float* sb[12]; float* db[12];
    int R0 = cb;
    KV_ROWS(R0, sa, da);
#pragma unroll
    for (int k = 0; k < 12; ++k) va[k] = *(const f32x4*)sa[k];
    for (; R0 < NR; R0 += 24 * ncb) {
        KV_ROWS(R0 + 12 * ncb, sb, db);
#pragma unroll
        for (int k = 0; k < 12; ++k) vb[k] = *(const f32x4*)sb[k];
#pragma unroll
        for (int k = 0; k < 12; ++k) *(f32x4*)da[k] = va[k];
        KV_ROWS(R0 + 24 * ncb, sa, da);
#pragma unroll
        for (int k = 0; k < 12; ++k) va[k] = *(const f32x4*)sa[k];
#pragma unroll
        for (int k = 0; k < 12; ++k) *(f32x4*)db[k] = vb[k];
    }
#undef KV_ROWS
}
__device__ __forceinline__ void ph_kvcopy(const Params& p, int cb, int ncb) {
    const int tid = tidx();
    kvcopy_one<128>(p.c128, p.out + O_KV128S, cb, ncb, tid);
    kvcopy_one<512>(p.c512, p.out + O_KV512S, cb, ncb, tid);
    kvcopy_one<2048>(p.c2048, p.out + O_KV2048S, cb, ncb, tid);
}

__device__ __forceinline__ void ph_prep(const Params& p, int bid, int nb) {
    const bf16_t* P = (const bf16_t*)(p.ws + WS_P); bf16_t* CV = (bf16_t*)(p.ws + WS_CV);
    const float* BA = (const float*)(p.ws + WS_BA); float* BG = (float*)(p.ws + WS_BG);
    const int tid = tidx(), lane = tid & 63, gw = __builtin_amdgcn_readfirstlane(tid >> 6) * nb + bid, nw = nb * 8;
    const float *pc128 = p.c128, *pc512 = p.c512, *pc2048 = p.c2048;
    asm volatile("" : "+s"(pc128), "+s"(pc512), "+s"(pc2048));
    for (int task0 = gw; task0 < NSAMP * 64; task0 += 4 * nw) {
        float x0[4][4], x1[4][4]; f32x2 w[4][4];
#pragma unroll
        for (int u = 0; u < 4; ++u) { const int task = task0 + u * nw;
            if (task < NSAMP * 64) { const int row = SEQ + (task >> 6), seg = task & 63, c = seg * 128 + 2 * lane, b = (row - SEQ) >> 2, t = (row - SEQ) & 3;
#pragma unroll
                for (int i = 0; i < 4; ++i) { w[u][i] = *(const f32x2*)(p.conv_w + i * 8192 + c); const int j = t + i;
                    if (j < 3) { const f32x2 sv = *(const f32x2*)(p.state_conv + ((size_t)b * 3 + j) * 8192 + c); x0[u][i] = sv[0]; x1[u][i] = sv[1]; }
                    else { const unsigned q = *(const unsigned*)(P + (size_t)(SEQ + 4 * b + j - 3) * NP + c); x0[u][i] = bflo(q); x1[u][i] = bfhi(q); } } } }
#pragma unroll
        for (int u = 0; u < 4; ++u) { const int task = task0 + u * nw;
            if (task < NSAMP * 64) { const int row = SEQ + (task >> 6), seg = task & 63, c = seg * 128 + 2 * lane;
                float y0 = 0.f, y1 = 0.f;
#pragma unroll
                for (int i = 0; i < 4; ++i) { y0 += x0[u][i] * w[u][i][0]; y1 += x1[u][i] * w[u][i][1]; }
                y0 = siluf_(y0); y1 = siluf_(y1);
                if (seg < 32) { const float ss = wave_sum(y0 * y0 + y1 * y1); float r = rsqrtf(ss + EPS); if (seg < 16) r *= 0.08838834764831845f; y0 *= r; y1 *= r; }
                *(unsigned*)(CV + (size_t)row * 8192 + c) = pk2(y0, y1); } }
    }
    for (int i = SEQ * 32 + bid * 512 + tid; i < MR * 32; i += nb * 512) { const int row = i >> 5, h = i & 31;
        const float b = BA[(size_t)row * 64 + h], a = BA[(size_t)row * 64 + 32 + h] + p.dt_bias[h];
        const float sp = a > 20.f ? a : log1pf(expf(a));
        BG[(size_t)row * 64 + h] = 1.f / (1.f + expf(-b)); BG[(size_t)row * 64 + 32 + h] = -expf(p.a_log[h]) * sp; }
    for (int i = bid * 512 + tid; i < 3 * 8192; i += nb * 512) { const int r = i >> 13, c = i & 8191; p.out[O_CONVP + i] = bf2f(P[(size_t)(SEQ - 3 + r) * NP + c]); }
    for (int i = bid * 512 + tid; i < 32 * 3 * 8192; i += nb * 512) { const int c = i & 8191, r = (i >> 13) % 3, b = i / (3 * 8192); p.out[O_CONVS + i] = bf2f(P[(size_t)(SEQ + 4 * b + 1 + r) * NP + c]); }
    { const bf16_t* QKVC = (const bf16_t*)(p.ws + WS_QKVC); const bf16_t* PS = (const bf16_t*)(p.ws + WS_PS);
      constexpr int RP = 128 + 512 + 2048, NT = 2 * RP + 2 * 32 * 12;
      for (int task = gw; task < NT; task += nw) {
        const int half = task & 1; int r = task >> 1; float* dst;
        if (r < RP) { int g, win, j; size_t ob; if (r < 128) { g = 0; win = 128; j = r; ob = O_KV128P; } else if (r < 640) { g = 1; win = 512; j = r - 128; ob = O_KV512P; } else { g = 2; win = 2048; j = r - 640; ob = O_KV2048P; }
            dst = p.out + ob + (size_t)j * 2048 + half * 1024; const int tok = SEQ - win + j;
#pragma unroll
            for (int i = 0; i < 4; ++i) { const int e = i * 256 + lane * 4, h = e >> 7; const u32x2 u = *(const u32x2*)(QKVC + qkvc_row(1 + half, g, h, tok) + (e & 127)); *(f32x4*)(dst + e) = (f32x4){bflo(u[0]), bfhi(u[0]), bflo(u[1]), bfhi(u[1])}; }
        } else { r -= RP; const int b = r / 12, q = r % 12, g = q >> 2, t = q & 3, win = g == 0 ? 128 : (g == 1 ? 512 : 2048); const size_t ob = g == 0 ? O_KV128S : (g == 1 ? O_KV512S : O_KV2048S);
            dst = p.out + ob + ((size_t)b * win + (win - 4 + t)) * 2048 + half * 1024; const bf16_t* srcb = PS + (size_t)(4 * b + t) * 9216 + (1 + half) * 3072 + g * 1024;
#pragma unroll
            for (int i = 0; i < 4; ++i) { const u32x2 u = *(const u32x2*)(srcb + i * 256 + lane * 4); *(f32x4*)(dst + i * 256 + lane * 4) = (f32x4){bflo(u[0]), bfhi(u[0]), bflo(u[1]), bfhi(u[1])}; }
        }
      } }
}

__device__ __forceinline__ float dq_sum(float v) { v += __shfl_xor(v, 16); v += __shfl_xor(v, 32); return v; }
__device__ __forceinline__ void delta_rec_sample_task(const Params& p, int task, int lane) {
    asm volatile("" : "+v"(lane));
    const bf16_t* CV = (const bf16_t*)(p.ws + WS_CV); const float* BG = (const float*)(p.ws + WS_BG); bf16_t* OA = (bf16_t*)(p.ws + WS_OA);
    const int b = task >> 6, hv = (task >> 1) & 31, half = task & 1, cg = lane & 15, dq = lane >> 4, hk = hv >> 1, e0 = 64 * half + 4 * cg;
    const float* sin = p.state_delta + ((size_t)b * 32 + hv) * 16384 + (size_t)(dq * 32) * 128 + e0;
    float* sout = p.out + O_DELTAS + ((size_t)b * 32 + hv) * 16384 + (size_t)(dq * 32) * 128 + e0;
    f32x4 s[32];
#pragma unroll
    for (int i = 0; i < 32; ++i) s[i] = *(const f32x4*)(sin + (size_t)i * 128);
#pragma unroll 1
    for (int t = 0; t < 4; ++t) {
        const size_t row = (size_t)(SEQ + 4 * b + t);
        const bf16_t* kp = CV + row * 8192 + C_KA + hk * 128 + dq * 32; const bf16_t* qp = CV + row * 8192 + C_QA + hk * 128 + dq * 32;
        u32x4 kk[4], qq[4];
#pragma unroll
        for (int i = 0; i < 4; ++i) { kk[i] = *(const u32x4*)(kp + 8 * i); qq[i] = *(const u32x4*)(qp + 8 * i); }
        const u32x2 vv = *(const u32x2*)(CV + row * 8192 + C_VA + hv * 128 + e0);
        const float beta = BG[row * 64 + hv], eg = expf(BG[row * 64 + 32 + hv]);
        f32x4 dot = (f32x4){0.f, 0.f, 0.f, 0.f};
#pragma unroll
        for (int i = 0; i < 16; ++i) { const float k0 = bflo(kk[i >> 2][i & 3]), k1 = bfhi(kk[i >> 2][i & 3]); s[2 * i] *= eg; s[2 * i + 1] *= eg; dot += s[2 * i] * k0 + s[2 * i + 1] * k1; }
#pragma unroll
        for (int c = 0; c < 4; ++c) dot[c] = dq_sum(dot[c]);
        const f32x4 vn = ((f32x4){bflo(vv[0]), bfhi(vv[0]), bflo(vv[1]), bfhi(vv[1])} - dot) * beta;
        f32x4 o = (f32x4){0.f, 0.f, 0.f, 0.f};
#pragma unroll
        for (int i = 0; i < 16; ++i) { const float k0 = bflo(kk[i >> 2][i & 3]), k1 = bfhi(kk[i >> 2][i & 3]), q0 = bflo(qq[i >> 2][i & 3]), q1 = bfhi(qq[i >> 2][i & 3]);
            s[2 * i] += vn * k0; s[2 * i + 1] += vn * k1; o += s[2 * i] * q0 + s[2 * i + 1] * q1; }
#pragma unroll
        for (int c = 0; c < 4; ++c) o[c] = dq_sum(o[c]);
        if (dq == 0) *(u32x2*)(OA + row * 4096 + hv * 128 + e0) = (u32x2){pk2(o[0], o[1]), pk2(o[2], o[3])};
    }
#pragma unroll
    for (int i = 0; i < 32; ++i) *(f32x4*)(sout + (size_t)i * 128) = s[i];
}
__device__ __forceinline__ void ph_delta_rec_sample(const Params& p, int bid, int nb) {
    const int tid = tidx(), lane = tid & 63, gw = __builtin_amdgcn_readfirstlane(tid >> 6) * nb + bid, nw = nb * 8;
    for (int task = gw; task < 32 * 32 * 2; task += nw) delta_rec_sample_task(p, task, lane);
}

typedef short s16x4 __attribute__((ext_vector_type(4)));
typedef float f32x16 __attribute__((ext_vector_type(16)));
__device__ __forceinline__ unsigned off_b(unsigned row, unsigned ch) { return 256u * row + 16u * (ch ^ (((row & 3) << 2) | ((row >> 2) & 3))); }
__device__ __forceinline__ unsigned tr_read_addr(unsigned lane, unsigned c, unsigned ks, unsigned t) {
    const unsigned h = lane >> 5, blk = (lane >> 4) & 1, q = (lane & 15) >> 2, p = lane & 3;
    return off_b(16 * ks + 8 * h + 4 * t + q, 4 * c + 2 * blk + (p >> 1)) + 8 * (p & 1);
}
__device__ __forceinline__ s16x4 lds_tr(LAS unsigned char* p) { return __builtin_bit_cast(s16x4, __builtin_amdgcn_ds_read_tr16_b64_v4i16((LAS s16x4*)p)); }
__device__ __forceinline__ bf16x8 cat8(s16x4 a, s16x4 b) { return (bf16x8){a[0], a[1], a[2], a[3], b[0], b[1], b[2], b[3]}; }
__device__ __forceinline__ unsigned cvtpk(float lo, float hi) { return pk2(lo, hi); }
__device__ __forceinline__ int afrag_off(int row, int col, int nkb) { return ((row >> 4) * nkb + (col >> 5)) * 512 + (16 * ((col >> 2) & 3) + (row & 15)) * 8 + 4 * ((col >> 4) & 1) + (col & 3); }
__device__ __forceinline__ int u_off(int c, int e) { return ((e >> 4) * 64 + 16 * ((c >> 2) & 3) + (e & 15)) * 8 + (c >> 4) * 4 + (c & 3); }
__device__ __forceinline__ float rdlane(float v, int l) { return __int_as_float(__builtin_amdgcn_readlane(__float_as_int(v), l)); }
#define LDS_WAIT() asm volatile("s_waitcnt lgkmcnt(0)" ::: "memory")

#define DPPF(v, ctrl) __int_as_float(__builtin_amdgcn_update_dpp(0, __float_as_int(v), (ctrl), 0xF, 0xF, true))
__device__ __forceinline__ float row16_sum(float v) {
    v += DPPF(v, 0xB1);
    v += DPPF(v, 0x4E);
    v += DPPF(v, 0x141);
    v += DPPF(v, 0x140);
    return v;
}
__device__ __forceinline__ float scan32_incl(float v) {
    v += DPPF(v, 0x111); v += DPPF(v, 0x112); v += DPPF(v, 0x114); v += DPPF(v, 0x118);
    v += __int_as_float(__builtin_amdgcn_update_dpp(0, __float_as_int(v), 0x142, 0xA, 0xF, true));
    return v;
}
__device__ __forceinline__ void conv_load(const Params& p, size_t row0, int col0, int lane, u32x4 (&x)[11]) {
    asm volatile("" : "+v"(lane));
    const bf16_t* P = (const bf16_t*)(p.ws + WS_P); const int cg = lane & 15, rg = lane >> 4, cv = col0 + 8 * cg;
#pragma unroll
    for (int i = 0; i < 11; ++i) { const long r = (long)row0 + 8 * rg - 3 + i; x[i] = r >= 0 ? *(const u32x4*)(P + (size_t)r * NP + cv) : (u32x4){0u, 0u, 0u, 0u}; }
}
template <int MODE> __device__ __forceinline__ void conv_comp(const Params& p, int col0, const u32x4 (&x)[11], LAS unsigned char* ldst, int lane) {
    asm volatile("" : "+v"(lane));
    const int cg = lane & 15, rg = lane >> 4, cv = col0 + 8 * cg;
    f32x4 w[4][2];
#pragma unroll
    for (int i = 0; i < 4; ++i) { w[i][0] = *(const f32x4*)(p.conv_w + i * 8192 + cv); w[i][1] = *(const f32x4*)(p.conv_w + i * 8192 + cv + 4); }
#pragma unroll
    for (int r = 0; r < 8; ++r) { float y[8];
#pragma unroll
        for (int e = 0; e < 8; ++e) y[e] = 0.f;
#pragma unroll
        for (int t = 0; t < 4; ++t)
#pragma unroll
            for (int q = 0; q < 4; ++q) { y[2 * q] += bflo(x[r + t][q]) * w[t][q >> 1][(2 * q) & 3]; y[2 * q + 1] += bfhi(x[r + t][q]) * w[t][q >> 1][(2 * q + 1) & 3]; }
        float ss = 0.f;
#pragma unroll
        for (int e = 0; e < 8; ++e) { y[e] = siluf_(y[e]); ss += y[e] * y[e]; }
        if (MODE != 0) { ss = row16_sum(ss);
            const float rs = rsqrtf(ss + EPS) * (MODE == 2 ? 0.08838834764831845f : 1.f);
#pragma unroll
            for (int e = 0; e < 8; ++e) y[e] *= rs; }
        *(LAS u32x4*)(ldst + off_b(8 * rg + r, cg)) = (u32x4){pk2(y[0], y[1]), pk2(y[2], y[3]), pk2(y[4], y[5]), pk2(y[6], y[7])}; }
}
struct HeadSc { float beta, G, eG, ekd; };
__device__ __forceinline__ void sa_head1(const Params& p, int n, int hv, float braw, float araw0, const LAS unsigned char* ldq, LAS float* sc, const f32x16& KKr, const f32x16& QKr, f32x16& L, HeadSc& hs, int lane) {
    asm volatile("" : "+v"(lane));
    unsigned char* rec = p.ws + WS_REC + ((size_t)hv * NCHUNK + n) * RECB;
    const int t = lane & 31, hi = lane >> 5;
    const float araw = araw0 + p.dt_bias[hv];
    const float beta = 1.f / (1.f + expf(-braw)); float G = -expf(p.a_log[hv]) * (araw > 20.f ? araw : log1pf(expf(araw)));
    G = scan32_incl(G);
    const float Glast = rdlane(G, 31), eG = expf(G), ekd = expf(Glast - G);
    if (lane < 32) { sc[t] = G; sc[32 + t] = beta; sc[64 + t] = eG; sc[96 + t] = ekd;
        *(float*)(rec + REC_GL + 4 * t) = eG; *(float*)(rec + REC_GL + 128 + 4 * t) = ekd; }
    hs.beta = beta; hs.G = G; hs.eG = eG; hs.ekd = ekd;
    {
        bf16_t* INf = (bf16_t*)(rec + REC_IN);
        unsigned ipk[4][2];
#pragma unroll
        for (int xg = 0; xg < 4; ++xg) { const f32x4 Gr = *(const LAS f32x4*)(sc + 8 * xg + 4 * hi), Br = *(const LAS f32x4*)(sc + 32 + 8 * xg + 4 * hi); float iv[4];
#pragma unroll
            for (int b = 0; b < 4; ++b) { const int r = 8 * xg + 4 * hi + b;
                L[4 * xg + b] = (t < r) ? Br[b] * KKr[4 * xg + b] * __expf(Gr[b] - G) : 0.f;
                iv[b] = (r <= t) ? QKr[4 * xg + b] * __expf(G - Gr[b]) : 0.f; }
            ipk[xg][0] = cvtpk(iv[0], iv[1]); ipk[xg][1] = cvtpk(iv[2], iv[3]); }
#pragma unroll
        for (int xg = 0; xg < 2; ++xg) *(u32x4*)(INf + afrag_off(t, 8 * xg + 4 * hi, 1)) = (u32x4){ipk[xg][0], ipk[xg][1], ipk[xg + 2][0], ipk[xg + 2][1]};
    }
}
__device__ __forceinline__ void sa_head2(const Params& p, int n, int hv, LAS unsigned char* ldk, LAS unsigned char* lds2, const LAS float* sc, const f32x16& Lacc, const HeadSc& hs, int lane) {
    asm volatile("" : "+v"(lane));
    unsigned char* rec = p.ws + WS_REC + ((size_t)hv * NCHUNK + n) * RECB;
    const int t = lane & 31, hi = lane >> 5; const size_t row0 = (size_t)n * CH;
    u32x4 xv[11]; conv_load(p, row0, C_VA + hv * 128, lane, xv);
    __builtin_amdgcn_sched_barrier(0);
    float T[32];
#pragma unroll
    for (int j = 31; j >= 0; --j) { float a = (t == j) ? 1.f : 0.f;
#pragma unroll
        for (int kk = j + 1; kk < 32; ++kk) a -= T[kk] * rdlane(Lacc[(kk & 3) + 4 * (kk >> 3)], j + 32 * ((kk >> 2) & 1));
        T[j] = a; }
    unsigned P2[16], P3[16];
#pragma unroll
    for (int m = 0; m < 16; ++m) { const float b0 = rdlane(hs.beta, 2 * m), b1 = rdlane(hs.beta, 2 * m + 1), e0 = rdlane(hs.eG, 2 * m), e1 = rdlane(hs.eG, 2 * m + 1);
        P3[m] = cvtpk(T[2 * m] * b0, T[2 * m + 1] * b1); P2[m] = cvtpk(T[2 * m] * b0 * e0, T[2 * m + 1] * b1 * e1); }
    bf16x8 F2[2], F3[2];
#pragma unroll
    for (int ks = 0; ks < 2; ++ks) { u32x4 a, b;
#pragma unroll
        for (int i = 0; i < 4; ++i) { a[i] = hi ? P2[8 * ks + 4 + i] : P2[8 * ks + i]; b[i] = hi ? P3[8 * ks + 4 + i] : P3[8 * ks + i]; }
        F2[ks] = __builtin_bit_cast(bf16x8, a); F3[ks] = __builtin_bit_cast(bf16x8, b); }
    { bf16_t* Wf = (bf16_t*)(rec + REC_W);
#pragma unroll
      for (int mt = 0; mt < 4; ++mt) { f32x16 acc;
#pragma unroll
          for (int x = 0; x < 16; ++x) acc[x] = 0.f;
#pragma unroll
          for (int ks = 0; ks < 2; ++ks) acc = __builtin_amdgcn_mfma_f32_32x32x16_bf16(cat8(lds_tr(ldk + tr_read_addr(lane, mt, ks, 0)), lds_tr(ldk + tr_read_addr(lane, mt, ks, 1))), F2[ks], acc, 0, 0, 0);
#pragma unroll
          for (int xg = 0; xg < 2; ++xg) *(u32x4*)(Wf + afrag_off(t, 32 * mt + 8 * xg + 4 * hi, 4)) = (u32x4){cvtpk(-acc[4 * xg], -acc[4 * xg + 1]), cvtpk(-acc[4 * xg + 2], -acc[4 * xg + 3]), cvtpk(-acc[4 * xg + 8], -acc[4 * xg + 9]), cvtpk(-acc[4 * xg + 10], -acc[4 * xg + 11])}; } }
    LDS_WAIT();
    conv_comp<0>(p, C_VA + hv * 128, xv, lds2, lane);
    LDS_WAIT();
    { bf16_t* Uf = (bf16_t*)(rec + REC_U);
#pragma unroll
      for (int nt = 0; nt < 4; ++nt) { f32x16 acc;
#pragma unroll
          for (int x = 0; x < 16; ++x) acc[x] = 0.f;
#pragma unroll
          for (int ks = 0; ks < 2; ++ks) acc = __builtin_amdgcn_mfma_f32_32x32x16_bf16(F3[ks], cat8(lds_tr(lds2 + tr_read_addr(lane, nt, ks, 0)), lds_tr(lds2 + tr_read_addr(lane, nt, ks, 1))), acc, 0, 0, 0);
#pragma unroll
          for (int xg = 0; xg < 2; ++xg) *(u32x4*)(Uf + u_off(8 * xg + 4 * hi, 32 * nt + t)) = (u32x4){cvtpk(acc[4 * xg], acc[4 * xg + 1]), cvtpk(acc[4 * xg + 2], acc[4 * xg + 3]), cvtpk(acc[4 * xg + 8], acc[4 * xg + 9]), cvtpk(acc[4 * xg + 10], acc[4 * xg + 11])}; } }
    LDS_WAIT();
}
__device__ __forceinline__ void stage_a_unit(const Params& p, int n, int hk, LAS unsigned char* ldsw, int lane) {
    asm volatile("" : "+v"(lane));
    LAS unsigned char* ldk = ldsw; LAS float* sc0 = (LAS float*)(ldsw + 8192); LAS float* sc1 = (LAS float*)(ldsw + 8704); LAS unsigned char* ldq = ldsw + 9216;
    const int t = lane & 31, hi = lane >> 5; const size_t row0 = (size_t)n * CH;
    float braw[2], araw[2];
    { u32x4 xk[11], xq[11]; conv_load(p, row0, C_KA + hk * 128, lane, xk); conv_load(p, row0, C_QA + hk * 128, lane, xq);
      const float* BA = (const float*)(p.ws + WS_BA) + (row0 + t) * 64 + 2 * hk;
      braw[0] = BA[0]; braw[1] = BA[1]; araw[0] = BA[32]; araw[1] = BA[33];
      __builtin_amdgcn_sched_barrier(0);
      conv_comp<1>(p, C_KA + hk * 128, xk, ldk, lane);
      conv_comp<2>(p, C_QA + hk * 128, xq, ldq, lane); }
    LDS_WAIT();
    f32x16 KKr, QKr;
#pragma unroll
    for (int x = 0; x < 16; ++x) { KKr[x] = 0.f; QKr[x] = 0.f; }
#pragma unroll
    for (int s = 0; s < 8; ++s) { const bf16x8 kf = *(const LAS bf16x8*)(ldk + off_b(t, 2 * s + hi)), qf = *(const LAS bf16x8*)(ldq + off_b(t, 2 * s + hi));
        KKr = __builtin_amdgcn_mfma_f32_32x32x16_bf16(kf, kf, KKr, 0, 0, 0); QKr = __builtin_amdgcn_mfma_f32_32x32x16_bf16(kf, qf, QKr, 0, 0, 0); }
    { unsigned char* reck = p.ws + WS_REC + ((size_t)(2 * hk) * NCHUNK + n) * RECB;
      { const int rr = lane & 15, qq = lane >> 4;
#pragma unroll
        for (int ct = 0; ct < 2; ++ct) { const int c = 16 * ct + rr;
#pragma unroll
            for (int kb = 0; kb < 4; ++kb) { const u32x2 a = *(const LAS u32x2*)(ldq + off_b(c, 4 * kb + (qq >> 1)) + 8 * (qq & 1)), b = *(const LAS u32x2*)(ldq + off_b(c, 4 * kb + 2 + (qq >> 1)) + 8 * (qq & 1));
                *(u32x4*)(reck + REC_QG + (ct * 4 + kb) * 1024 + lane * 16) = (u32x4){a[0], a[1], b[0], b[1]}; } } }
      { const unsigned qg = lane >> 4, qq = (lane & 15) >> 2, pp = lane & 3;
#pragma unroll
        for (int dt = 0; dt < 8; ++dt) { const s16x4 a0 = lds_tr(ldk + off_b(4 * qg + qq, 2 * dt + (pp >> 1)) + 8 * (pp & 1)), a1 = lds_tr(ldk + off_b(16 + 4 * qg + qq, 2 * dt + (pp >> 1)) + 8 * (pp & 1));
            *(bf16x8*)(reck + REC_KD + dt * 1024 + lane * 16) = cat8(a0, a1); } } }
    f32x16 L0, L1; HeadSc h0, h1;
    sa_head1(p, n, 2 * hk, braw[0], araw[0], ldq, sc0, KKr, QKr, L0, h0, lane);
    sa_head1(p, n, 2 * hk + 1, braw[1], araw[1], ldq, sc1, KKr, QKr, L1, h1, lane);
    sa_head2(p, n, 2 * hk, ldk, ldq, sc0, L0, h0, lane);
    sa_head2(p, n, 2 * hk + 1, ldk, ldq, sc1, L1, h1, lane);
}
__device__ __forceinline__ void ph_stage_a(const Params& p, LAS unsigned char* lds, int bid, int nb) {
    const int lane = tidx() & 63, wid = __builtin_amdgcn_readfirstlane(tidx() >> 6), gw = wid * nb + bid, nw = nb * 8;
    LAS unsigned char* ldsw = lds + wid * 17408;
    for (int task = gw; task < NCHUNK * 16; task += nw) stage_a_unit(p, NCHUNK - 1 - (task >> 4), task & 15, ldsw, lane);
}

constexpr int SCAN_WGS = 64, SCAN_OST = 4 * REC_DMA;
__device__ __forceinline__ void ph_scan(const Params& p, LAS unsigned char* lds, int bid) {
    const int tid = tidx(), lane = tid & 63, wid = __builtin_amdgcn_readfirstlane(tid >> 6), hv = 4 * (bid & 7) + ((bid >> 4) & 2) + ((bid >> 4) & 1), half = (bid >> 3) & 1;
    const unsigned char* rec0 = p.ws + WS_REC + (size_t)hv * NCHUNK * RECB; constexpr size_t RSTR = (size_t)RECB;
    if (wid >= 4) {
        const int lw = wid - 4;
        bf16_t* OA = (bf16_t*)(p.ws + WS_OA) + (size_t)(8 * lw + (lane >> 3)) * 4096 + hv * 128 + half * 64 + (lane & 7) * 8;
        const LAS unsigned char* ost = lds + SCAN_OST + (8 * lw + (lane >> 3)) * 128 + (lane & 7) * 16;
        int poff[8], loff[8];
        const int kdelta = -(hv & 1) * (int)(NCHUNK * RECB);
#pragma unroll
        for (int i = 0; i < 8; ++i) { const int idx = lw * 8 + i; loff[i] = idx < 26 ? idx * 1024 : (idx < 30 ? REC_U + (4 * half + idx - 26) * 1024 : REC_GL);
            poff[i] = loff[i] + (((idx >= 8 && idx < 16) || (idx >= 18 && idx < 26)) ? kdelta : 0); }
#define SCAN_DMA(n_) do { const int nn_ = (n_) < NCHUNK ? (n_) : NCHUNK - 1; const unsigned char* src_ = rec0 + (size_t)nn_ * RSTR + lane * 16; LAS unsigned char* dst_ = lds + ((n_) & 3) * REC_DMA; \
        _Pragma("unroll") for (int i_ = 0; i_ < 8; ++i_) __builtin_amdgcn_global_load_lds((const unsigned*)(src_ + poff[i_]), (LAS unsigned*)(dst_ + loff[i_]), 16, 0, 0); } while (0)
        SCAN_DMA(0); SCAN_DMA(1); SCAN_DMA(2);
        asm volatile("s_waitcnt vmcnt(16)" ::: "memory");
        __builtin_amdgcn_s_barrier();
        asm volatile("" ::: "memory");
        SCAN_DMA(3);
#define SCAN_STEP(n_, W_) do { asm volatile("s_waitcnt vmcnt(" #W_ ")" ::: "memory"); __builtin_amdgcn_s_barrier(); asm volatile("" ::: "memory"); \
        const u32x4 ov_ = *(const LAS u32x4*)(ost + (((n_) - 1) & 1) * 4096); *(u32x4*)(OA + (size_t)((n_) - 1) * CH * 4096) = ov_; SCAN_DMA((n_) + 3); } while (0)
        SCAN_STEP(1, 16); SCAN_STEP(2, 17);
        for (int n = 3; n < NCHUNK; ++n) SCAN_STEP(n, 18);
#undef SCAN_STEP
        asm volatile("" ::: "memory"); __builtin_amdgcn_s_barrier(); asm volatile("" ::: "memory");
        { const u32x4 ov = *(const LAS u32x4*)(ost + ((NCHUNK - 1) & 1) * 4096); *(u32x4*)(OA + (size_t)(NCHUNK - 1) * CH * 4096) = ov; }
        asm volatile("s_waitcnt vmcnt(0)" ::: "memory");
#undef SCAN_DMA
    } else {
        const int sl = half * 4 + wid, el = lane & 15, q4 = lane >> 4;
        LAS bf16_t* ost = (LAS bf16_t*)(lds + SCAN_OST) + (4 * q4) * 64 + wid * 16 + el;
        f32x4 S[8];
#pragma unroll
        for (int dt = 0; dt < 8; ++dt) S[dt] = (f32x4){0.f, 0.f, 0.f, 0.f};
        for (int n = 0; n < NCHUNK; ++n) {
            asm volatile("s_waitcnt lgkmcnt(0)" ::: "memory"); __builtin_amdgcn_s_barrier(); asm volatile("" ::: "memory");
            LAS unsigned char* buf = lds + (n & 3) * REC_DMA;
            const LAS unsigned char* fl = buf + lane * 16;
            bf16x8 Wf[8], QGf[8], KDf[8], INf[2];
#pragma unroll
            for (int f = 0; f < 8; ++f) { Wf[f] = *(const LAS bf16x8*)(fl + REC_W + f * 1024); QGf[f] = *(const LAS bf16x8*)(fl + REC_QG + f * 1024); }
            const u32x4 uu = *(const LAS u32x4*)(buf + REC_U + sl * 1024 + lane * 16);
            const float gl = *(const LAS float*)(buf + REC_GL + 124);
            f32x4 eGv[2], ekv[2];
#pragma unroll
            for (int ct = 0; ct < 2; ++ct) { eGv[ct] = *(const LAS f32x4*)(buf + REC_GL + (16 * ct + 4 * q4) * 4); ekv[ct] = *(const LAS f32x4*)(buf + REC_GL + 128 + (16 * ct + 4 * q4) * 4); }
#pragma unroll
            for (int f = 0; f < 8; ++f) KDf[f] = *(const LAS bf16x8*)(fl + REC_KD + f * 1024);
#pragma unroll
            for (int f = 0; f < 2; ++f) INf[f] = *(const LAS bf16x8*)(fl + REC_IN + f * 1024);
            bf16x8 Sf[4];
#pragma unroll
            for (int kb = 0; kb < 4; ++kb) { const u32x4 w = (u32x4){cvtpk(S[2 * kb][0], S[2 * kb][1]), cvtpk(S[2 * kb][2], S[2 * kb][3]), cvtpk(S[2 * kb + 1][0], S[2 * kb + 1][1]), cvtpk(S[2 * kb + 1][2], S[2 * kb + 1][3])}; Sf[kb] = __builtin_bit_cast(bf16x8, w); }
            __builtin_amdgcn_sched_barrier(0);
#pragma unroll
            for (int dt = 0; dt < 8; ++dt) S[dt] *= gl;
            f32x4 vn[2] = {(f32x4){bflo(uu[0]), bfhi(uu[0]), bflo(uu[1]), bfhi(uu[1])}, (f32x4){bflo(uu[2]), bfhi(uu[2]), bflo(uu[3]), bfhi(uu[3])}};
            f32x4 o[2] = {(f32x4){0.f, 0.f, 0.f, 0.f}, (f32x4){0.f, 0.f, 0.f, 0.f}};
#pragma unroll
            for (int ct = 0; ct < 2; ++ct)
#pragma unroll
                for (int kb = 0; kb < 4; ++kb) { vn[ct] = __builtin_amdgcn_mfma_f32_16x16x32_bf16(Wf[ct * 4 + kb], Sf[kb], vn[ct], 0, 0, 0);
                                                 o[ct] = __builtin_amdgcn_mfma_f32_16x16x32_bf16(QGf[ct * 4 + kb], Sf[kb], o[ct], 0, 0, 0); }
            const f32x4 vs0 = vn[0] * ekv[0], vs1 = vn[1] * ekv[1];
            const u32x4 vsw = (u32x4){cvtpk(vs0[0], vs0[1]), cvtpk(vs0[2], vs0[3]), cvtpk(vs1[0], vs1[1]), cvtpk(vs1[2], vs1[3])}; const bf16x8 VNsf = __builtin_bit_cast(bf16x8, vsw);
#pragma unroll
            for (int dt = 0; dt < 8; ++dt) S[dt] = __builtin_amdgcn_mfma_f32_16x16x32_bf16(KDf[dt], VNsf, S[dt], 0, 0, 0);
            const u32x4 vw = (u32x4){cvtpk(vn[0][0], vn[0][1]), cvtpk(vn[0][2], vn[0][3]), cvtpk(vn[1][0], vn[1][1]), cvtpk(vn[1][2], vn[1][3])}; const bf16x8 VNf = __builtin_bit_cast(bf16x8, vw);
            LAS bf16_t* os = ost + (n & 1) * 2048;
#pragma unroll
            for (int ct = 0; ct < 2; ++ct) { o[ct] = __builtin_amdgcn_mfma_f32_16x16x32_bf16(INf[ct], VNf, o[ct] * eGv[ct]  , 0, 0, 0);
#pragma unroll
                for (int r = 0; r < 4; r += 2) { const unsigned w = pk2(o[ct][r], o[ct][r + 1]); os[(16 * ct + r) * 64] = (bf16_t)w; os[(16 * ct + r + 1) * 64] = (bf16_t)(w >> 16); } }
        }
        asm volatile("s_waitcnt lgkmcnt(0)" ::: "memory"); __builtin_amdgcn_s_barrier(); asm volatile("" ::: "memory");
        float* so = p.out + O_DELTAP + (size_t)hv * 16384 + sl * 16 + el;
#pragma unroll
        for (int dt = 0; dt < 8; ++dt)
#pragma unroll
            for (int r = 0; r < 4; ++r) so[(size_t)(16 * dt + 4 * q4 + r) * 128] = S[dt][r];
    }
    __syncthreads();
}

__device__ __forceinline__ void attn_sample_task(const Params& p, int row, int h, int lane) {
    asm volatile("" : "+v"(lane));
    const bf16_t* P = (const bf16_t*)(p.ws + WS_P); const bf16_t* PS = (const bf16_t*)(p.ws + WS_PS); bf16_t* OB = (bf16_t*)(p.ws + WS_OB);
    const int sb = (row - SEQ) >> 2, st = (row - SEQ) & 3;
    float sc[3][3];
#pragma unroll
    for (int g = 0; g < 3; ++g) {
        const int dil = g == 0 ? 1 : (g == 1 ? 4 : 16), win = g == 0 ? 128 : (g == 1 ? 512 : 2048);
        const float* cache = g == 0 ? p.c128 : (g == 1 ? p.c512 : p.c2048);
        const bf16_t* qp = PS + (size_t)(row - SEQ) * 9216 + g * 1024 + h * 128;
#pragma unroll
        for (int sl = 0; sl < 3; ++sl) {
            const int j = lane + 64 * sl; float s = -1e30f;
            if (j <= 128) {
                const int idx = win + st - j * dil; float d = 0.f;
                if (idx >= win) { const bf16_t* kb = PS + (size_t)(4 * sb + idx - win) * 9216 + 3072 + g * 1024 + h * 128;
#pragma unroll 1
                    for (int i0 = 0; i0 < 16; i0 += 4) {
#pragma unroll
                        for (int i = i0; i < i0 + 4; ++i) { const u32x4 k = *(const u32x4*)(kb + 8 * i), q = *(const u32x4*)(qp + 8 * i);
#pragma unroll
                            for (int w = 0; w < 4; ++w) d += bflo(q[w]) * bflo(k[w]) + bfhi(q[w]) * bfhi(k[w]); } }
                } else { const float* kf = cache + (((size_t)sb * win + idx) * 2 + 0) * 1024 + h * 128;
#pragma unroll 1
                    for (int i0 = 0; i0 < 16; i0 += 8) {
#pragma unroll
                        for (int i = i0; i < i0 + 8; ++i) { const f32x4 k0 = *(const f32x4*)(kf + 8 * i), k1 = *(const f32x4*)(kf + 8 * i + 4); const u32x4 q = *(const u32x4*)(qp + 8 * i);
                            d += bflo(q[0]) * k0[0] + bfhi(q[0]) * k0[1] + bflo(q[1]) * k0[2] + bfhi(q[1]) * k0[3] + bflo(q[2]) * k1[0] + bfhi(q[2]) * k1[1] + bflo(q[3]) * k1[2] + bfhi(q[3]) * k1[3]; } }
                }
                s = d * 0.08838834764831845f;
            }
            sc[g][sl] = s;
        }
        __builtin_amdgcn_sched_barrier(0);
    }
    float mx = -1e30f;
#pragma unroll
    for (int g = 0; g < 3; ++g)
#pragma unroll
        for (int sl = 0; sl < 3; ++sl) mx = fmaxf(mx, sc[g][sl]);
    mx = wave_max(mx);
    float ls = 0.f;
#pragma unroll
    for (int g = 0; g < 3; ++g)
#pragma unroll
        for (int sl = 0; sl < 3; ++sl) { const float pj = (sc[g][sl] > -1e29f) ? __expf(sc[g][sl] - mx) : 0.f; sc[g][sl] = pj; ls += pj; }
    ls = wave_sum(ls);
    float a0 = 0.f, a1 = 0.f;
#pragma unroll
    for (int g = 0; g < 3; ++g) {
        const int dil = g == 0 ? 1 : (g == 1 ? 4 : 16), win = g == 0 ? 128 : (g == 1 ? 512 : 2048);
        const float* cache = g == 0 ? p.c128 : (g == 1 ? p.c512 : p.c2048);
#pragma unroll
        for (int hf = 0; hf < 2; ++hf) { const float scv = sc[g][hf];
#pragma unroll 1
            for (int j0 = 64 * hf; j0 < 64 * hf + 64; j0 += 32) {
                f32x2 v[32];
#pragma unroll
                for (int k = 0; k < 32; ++k) { const int j = j0 + k, idx = win + st - j * dil;
                    if (idx >= win) { const unsigned u = *(const unsigned*)(PS + (size_t)(4 * sb + idx - win) * 9216 + 6144 + g * 1024 + h * 128 + 2 * lane); v[k] = (f32x2){bflo(u), bfhi(u)}; }
                    else v[k] = *(const f32x2*)(cache + (((size_t)sb * win + idx) * 2 + 1) * 1024 + h * 128 + 2 * lane); }
#pragma unroll
                for (int k = 0; k < 32; ++k) { const float pj = __shfl(scv, (j0 + k) & 63); a0 += pj * v[k][0]; a1 += pj * v[k][1]; }
            } }
        { const int idx = win + st - 128 * dil; const f32x2 v = *(const f32x2*)(cache + (((size_t)sb * win + idx) * 2 + 1) * 1024 + h * 128 + 2 * lane); const float pj = __shfl(sc[g][2], 0); a0 += pj * v[0]; a1 += pj * v[1]; }
        __builtin_amdgcn_sched_barrier(0);
    }
    const float inv = 1.f / ls; const unsigned z = *(const unsigned*)(P + (size_t)row * NP + C_ZB + h * 128 + 2 * lane);
    *(unsigned*)(OB + (size_t)row * 1024 + h * 128 + 2 * lane) = pk2(a0 * inv * siluf_(bflo(z)), a1 * inv * siluf_(bfhi(z)));
}

constexpr int KVC_NR0 = 32 * 124, KVC_NR1 = 32 * 508, KVC_NR2 = 32 * 2044, KVC_ROWS = KVC_NR0 + KVC_NR1 + KVC_NR2, KVC_TASKS = KVC_ROWS / 2;
static_assert(KVC_ROWS % 16 == 0, "copy tasks come in groups of 8");
template <int WIN> __device__ __forceinline__ void kvc_rp(const float* c, float* o, int r, const float*& src, float*& dst) { const int b = r / (WIN - 4), j = r - b * (WIN - 4); src = c + (size_t)(b * WIN + j + 4) * 2048; dst = o + (size_t)(b * WIN + j) * 2048; }
__device__ __forceinline__ void kvcopy_task(const Params& p, int t, int lane) {
    asm volatile("" : "+v"(lane));
    const float *c128 = p.c128, *c512 = p.c512, *c2048 = p.c2048;
    asm volatile("" : "+s"(c128), "+s"(c512), "+s"(c2048));
    f32x4 v[16]; float* d[2];
#pragma unroll
    for (int r = 0; r < 2; ++r) { const int R = 2 * t + r; const float* s;
        if (R < KVC_NR0) kvc_rp<128>(c128, p.out + O_KV128S, R, s, d[r]); else if (R < KVC_NR0 + KVC_NR1) kvc_rp<512>(c512, p.out + O_KV512S, R - KVC_NR0, s, d[r]); else kvc_rp<2048>(c2048, p.out + O_KV2048S, R - KVC_NR0 - KVC_NR1, s, d[r]);
#pragma unroll
        for (int k = 0; k < 8; ++k) v[r * 8 + k] = *(const f32x4*)(s + k * 256 + lane * 4); }
#pragma unroll
    for (int r = 0; r < 2; ++r)
#pragma unroll
        for (int k = 0; k < 8; ++k) *(f32x4*)(d[r] + k * 256 + lane * 4) = v[r * 8 + k];
}
__device__ __forceinline__ void kvcopy_companion(const Params& p, int pullA, int cw, int lane) {
    asm volatile("" : "+v"(lane));
    const float *c128 = p.c128, *c512 = p.c512, *c2048 = p.c2048;
    asm volatile("" : "+s"(c128), "+s"(c512), "+s"(c2048));
#pragma unroll 1
    for (int k = 0; k < 4; ++k) {
        const int t = (pullA * 4 + cw) * 4 + k; const bool on = t < KVC_TASKS;
        f32x4 v[16]; float* d[2];
        asm volatile("s_waitcnt lgkmcnt(0)" ::: "memory"); __builtin_amdgcn_s_barrier(); asm volatile("" ::: "memory");
        if (on) {
#pragma unroll
            for (int r = 0; r < 2; ++r) { const int R = 2 * t + r; const float* s;
                if (R < KVC_NR0) kvc_rp<128>(c128, p.out + O_KV128S, R, s, d[r]); else if (R < KVC_NR0 + KVC_NR1) kvc_rp<512>(c512, p.out + O_KV512S, R - KVC_NR0, s, d[r]); else kvc_rp<2048>(c2048, p.out + O_KV2048S, R - KVC_NR0 - KVC_NR1, s, d[r]);
#pragma unroll
                for (int q = 0; q < 8; ++q) v[r * 8 + q] = *(const f32x4*)(s + q * 256 + lane * 4); } }
        asm volatile("s_waitcnt lgkmcnt(0)" ::: "memory"); __builtin_amdgcn_s_barrier(); asm volatile("" ::: "memory");
        if (on) {
#pragma unroll
            for (int r = 0; r < 2; ++r)
#pragma unroll
                for (int q = 0; q < 8; ++q) *(f32x4*)(d[r] + q * 256 + lane * 4) = v[r * 8 + q]; }
    }
}
constexpr int ATT_PULL_R = 32 * 32 * 2 / 8  , ATT_PULL_S = NSAMP * 8 / 8, ATT_PULL_A = 3 * 8 * (SEQ / 128)  , ATT_PULL_C = 0,
              ATT_PULLS = ATT_PULL_R + ATT_PULL_S + ATT_PULL_A + ATT_PULL_C, WQ_ATT = 3600;
static_assert(KVC_TASKS <= 3 * 8 * (SEQ / 128) * 16, "every copy task has a companion slot");
constexpr int ATT_LDS_PULL = 98304;
__device__ __forceinline__ void attn_quad_task(const Params& p, int qt, LAS unsigned char* ldsq, int wq, int lane) {
    asm volatile("" : "+v"(lane));
    const int g = qt >> 10, rem = qt & 1023, h = rem >> 7, rem2 = rem & 127, nq = 128 >> (2 * g), r = rem2 / nq, qq = rem2 % nq;
    const int ql = lane & 31, hi = lane >> 5, m0 = 128 * qq + 32 * wq, dil = 1 << (2 * g), jstart = qq == 0 ? 4 : 0;
    const size_t tokq = (size_t)r + (size_t)dil * (m0 + ql);
    const bf16_t* Qs = (const bf16_t*)(p.ws + WS_QKVC) + qkvc_row(0, g, h, r); const bf16_t* Ks = (const bf16_t*)(p.ws + WS_QKVC) + qkvc_row(1, g, h, r); const bf16_t* Vs = (const bf16_t*)(p.ws + WS_QKVC) + qkvc_row(2, g, h, r);
    const int kb0 = 128 * qq - 128;
    const bf16_t* tsrc[4];
#pragma unroll
    for (int i = 0; i < 4; ++i) { const int c = i * 256 + wq * 64 + lane, cc = c & 511, row = cc >> 4, ch = (cc & 15) ^ (((row & 3) << 2) | ((row >> 2) & 3));
        tsrc[i] = (i < 2 ? Ks : Vs) + (size_t)(kb0 + row) * 128 + ch * 8; }
#define ATT_DMA(j_, b_) do { _Pragma("unroll") for (int i = 0; i < 4; ++i) __builtin_amdgcn_global_load_lds((const unsigned*)(tsrc[i] + (size_t)(j_) * 32 * 128), (LAS unsigned*)(ldsq + (b_) * 16384 + i * 4096 + wq * 1024), 16, 0, 0); } while (0)
    ATT_DMA(jstart, jstart % 3); ATT_DMA(jstart + 1, (jstart + 1) % 3);
    bf16x8 qf[8];
    { const bf16_t* qp = Qs + (size_t)(m0 + ql) * 128 + 8 * hi;
#pragma unroll
      for (int s = 0; s < 8; ++s) qf[s] = *(const bf16x8*)(qp + 16 * s); }
    f32x16 O[4];
#pragma unroll
    for (int dm = 0; dm < 4; ++dm)
#pragma unroll
        for (int x = 0; x < 16; ++x) O[dm][x] = 0.f;
    float mrun = -1e30f, lrun = 0.f;
    constexpr float C2 = 0.08838834764831845f * 1.4426950408889634f;
    const unsigned qq4 = (lane & 15) >> 2, pp = lane & 3, blk = (lane >> 4) & 1;
    int bj = 0, bn = 2;
#pragma unroll 1
    for (int j = 0; j < 8; ++j) {
        if (j == 7) asm volatile("s_waitcnt vmcnt(0) lgkmcnt(0)" ::: "memory"); else asm volatile("s_waitcnt vmcnt(4) lgkmcnt(0)" ::: "memory");
        __builtin_amdgcn_s_barrier(); asm volatile("" ::: "memory");
        if (j + 2 <= 7 && j + 2 > jstart + 1) ATT_DMA(j + 2, bn);
        const int kt = j - wq;
        if (j >= jstart && kt >= 0 && kt <= 4) {
            const LAS unsigned char* kb = ldsq + bj * 16384; const LAS unsigned char* vb = kb + 8192;
            f32x16 S;
#pragma unroll
            for (int x = 0; x < 16; ++x) S[x] = 0.f;
#pragma unroll
            for (int s = 0; s < 8; ++s) S = __builtin_amdgcn_mfma_f32_32x32x16_bf16(*(const LAS bf16x8*)(kb + off_b(ql, 2 * s + hi)), qf[s], S, 0, 0, 0);
            const float NEG = -__builtin_inff();
            if (kt == 0) {
#pragma unroll
                for (int x = 0; x < 16; ++x) { const int kl = (x & 3) + 8 * (x >> 2) + 4 * hi; if (kl < ql) S[x] = NEG; }
            } else if (kt == 4) {
#pragma unroll
                for (int x = 0; x < 16; ++x) { const int kl = (x & 3) + 8 * (x >> 2) + 4 * hi; if (kl > ql) S[x] = NEG; }
            }
            float tmax = S[0];
#pragma unroll
            for (int x = 1; x < 16; ++x) tmax = fmaxf(tmax, S[x]);
            tmax = fmaxf(tmax, __shfl_xor(tmax, 32));
            if (!__all((tmax - mrun) * 0.08838834764831845f <= 8.f)) {
                const float mnew = fmaxf(mrun, tmax), alpha = __builtin_amdgcn_exp2f((mrun - mnew) * C2); mrun = mnew; lrun *= alpha;
#pragma unroll
                for (int dm = 0; dm < 4; ++dm)
#pragma unroll
                    for (int x = 0; x < 16; ++x) O[dm][x] *= alpha; }
            float ps = 0.f;
#pragma unroll
            for (int x = 0; x < 16; ++x) { S[x] = __builtin_amdgcn_exp2f((S[x] - mrun) * C2); ps += S[x]; }
            lrun += ps;
            bf16x8 pf[2];
#pragma unroll
            for (int t = 0; t < 2; ++t) { const u32x4 w = (u32x4){cvtpk(S[8 * t], S[8 * t + 1]), cvtpk(S[8 * t + 2], S[8 * t + 3]), cvtpk(S[8 * t + 4], S[8 * t + 5]), cvtpk(S[8 * t + 6], S[8 * t + 7])}; pf[t] = __builtin_bit_cast(bf16x8, w); }
#pragma unroll
            for (int dm = 0; dm < 4; ++dm)
#pragma unroll
                for (int t = 0; t < 2; ++t) {
                    const s16x4 a0 = lds_tr((LAS unsigned char*)vb + off_b(16 * t + 4 * hi + qq4, 4 * dm + 2 * blk + (pp >> 1)) + 8 * (pp & 1));
                    const s16x4 a1 = lds_tr((LAS unsigned char*)vb + off_b(16 * t + 8 + 4 * hi + qq4, 4 * dm + 2 * blk + (pp >> 1)) + 8 * (pp & 1));
                    O[dm] = __builtin_amdgcn_mfma_f32_32x32x16_bf16(cat8(a0, a1), pf[t], O[dm], 0, 0, 0); }
        }
        bj = bj == 2 ? 0 : bj + 1; bn = bn == 2 ? 0 : bn + 1;
    }
#undef ATT_DMA
    lrun += __shfl_xor(lrun, 32);
    const float inv = 1.f / lrun;
    bf16_t* og = (bf16_t*)(p.ws + WS_OG) + ((size_t)g * SEQ + tokq) * 1024 + h * 128;
#pragma unroll
    for (int dm = 0; dm < 4; ++dm)
#pragma unroll
        for (int a = 0; a < 2; ++a) {
            const unsigned e0 = cvtpk(O[dm][8 * a] * inv, O[dm][8 * a + 1] * inv), e1 = cvtpk(O[dm][8 * a + 2] * inv, O[dm][8 * a + 3] * inv);
            const unsigned f0 = cvtpk(O[dm][8 * a + 4] * inv, O[dm][8 * a + 5] * inv), f1 = cvtpk(O[dm][8 * a + 6] * inv, O[dm][8 * a + 7] * inv);
            const auto s0 = __builtin_amdgcn_permlane32_swap(e0, f0, false, false), s1 = __builtin_amdgcn_permlane32_swap(e1, f1, false, false);
            *(u32x4*)(og + 32 * dm + 16 * a + 8 * hi) = (u32x4){s0[0], s1[0], s0[1], s1[1]}; }
    if (hi == 0) ((float*)(p.ws + WS_LSE))[((size_t)g * SEQ + tokq) * 8 + h] = mrun * 0.08838834764831845f + logf(lrun);
}
constexpr int WQ_QX = 3648  , QX_S = ATT_PULL_S / 8  , QX_N = QX_S + ATT_PULL_A / 8;
static_assert(ATT_PULL_A % 8 == 0 && ATT_PULL_S % 8 == 0 && WQ_QX + 8 * 16 <= 4096, "per-XCD counters");
__device__ __forceinline__ void ph_attn(const Params& p, LAS unsigned char* lds) {
    const int tid = tidx(), lane = tid & 63, wid = __builtin_amdgcn_readfirstlane(tid >> 6);
    unsigned* ctr = (unsigned*)(p.ws + WS_BAR) + WQ_ATT; unsigned* ctrq = (unsigned*)(p.ws + WS_BAR) + WQ_QX;
    LAS int* slot = (LAS int*)(lds + ATT_LDS_PULL);
    bool main_done = false; int qcur = (int)(xb_xcc_id() & 7u);
    for (;;) {
        __syncthreads();
        if (wid == 0) {
            int v = -1;
            if (!main_done) { unsigned m = 0; if (lane == 0) m = __hip_atomic_fetch_add(ctr, 1u, __ATOMIC_RELAXED, __HIP_MEMORY_SCOPE_AGENT); m = __builtin_amdgcn_readfirstlane(m);
                if (m < (unsigned)ATT_PULL_R) v = (int)m; else main_done = true; }
            if (v < 0) {
                for (;;) {
                    unsigned a = 0; if (lane == 0) a = __hip_atomic_fetch_add(ctrq + 16 * qcur, 1u, __ATOMIC_RELAXED, __HIP_MEMORY_SCOPE_AGENT); a = __builtin_amdgcn_readfirstlane(a);
                    if (a < (unsigned)QX_N) { v = (int)a < QX_S ? ATT_PULL_R + qcur * QX_S + (int)a : ATT_PULL_R + ATT_PULL_S + qcur * (QX_N - QX_S) + (int)a - QX_S; break; }
                    unsigned c = (unsigned)QX_N; if (lane < 8) c = __hip_atomic_load(ctrq + 16 * lane, __ATOMIC_RELAXED, __HIP_MEMORY_SCOPE_AGENT);
                    const unsigned ne = (unsigned)__ballot(c < (unsigned)QX_N) & 0xffu;
                    if (ne == 0u) { v = ATT_PULLS; break; }
                    const unsigned rot = ((ne >> qcur) | (ne << (8 - qcur))) & 0xffu; qcur = (qcur + __builtin_ctz(rot)) & 7;
                }
            }
            if (lane == 0) *slot = v;
        }
        __syncthreads();
        const int pull = __builtin_amdgcn_readfirstlane(*slot);
        if (pull >= ATT_PULLS) break;
        if (pull < ATT_PULL_R) delta_rec_sample_task(p, pull * 8 + wid, lane);
        else if (pull < ATT_PULL_R + ATT_PULL_S) { const int task = (pull - ATT_PULL_R) * 8 + wid; attn_sample_task(p, SEQ + (task >> 3), task & 7, lane); }
        else { const int pa = pull - ATT_PULL_R - ATT_PULL_S;
            if (wid < 4) attn_quad_task(p, pa, lds, wid, lane); else kvcopy_companion(p, pa, wid - 4, lane); }
    }
}
__device__ __forceinline__ void ph_mix(const Params& p, int bid, int nb) {
    const bf16_t* P = (const bf16_t*)(p.ws + WS_P); const bf16_t* OG = (const bf16_t*)(p.ws + WS_OG); const float* LSE = (const float*)(p.ws + WS_LSE); bf16_t* OB = (bf16_t*)(p.ws + WS_OB);
    const int tid = tidx(), lane = tid & 63, gw = __builtin_amdgcn_readfirstlane(tid >> 6) * nb + bid, nw = nb * 8, h = lane >> 3;
    for (int tok = gw; tok < SEQ; tok += nw) {
        const size_t o = (size_t)tok * 1024 + lane * 16;
        u32x4 a[3][2];
#pragma unroll
        for (int g = 0; g < 3; ++g) { a[g][0] = *(const u32x4*)(OG + (size_t)g * SEQ * 1024 + o); a[g][1] = *(const u32x4*)(OG + (size_t)g * SEQ * 1024 + o + 8); }
        const u32x4 z0 = *(const u32x4*)(P + (size_t)tok * NP + C_ZB + lane * 16), z1 = *(const u32x4*)(P + (size_t)tok * NP + C_ZB + lane * 16 + 8);
        const float l0 = LSE[((size_t)0 * SEQ + tok) * 8 + h], l1 = LSE[((size_t)1 * SEQ + tok) * 8 + h], l2 = LSE[((size_t)2 * SEQ + tok) * 8 + h];
        const float mx = fmaxf(l0, fmaxf(l1, l2)); float w0 = __expf(l0 - mx), w1 = __expf(l1 - mx), w2 = __expf(l2 - mx); const float inv = 1.f / (w0 + w1 + w2); w0 *= inv; w1 *= inv; w2 *= inv;
        u32x4 r[2];
#pragma unroll
        for (int q = 0; q < 2; ++q) { const u32x4 z = q ? z1 : z0;
#pragma unroll
            for (int i = 0; i < 4; ++i) r[q][i] = pk2((w0 * bflo(a[0][q][i]) + w1 * bflo(a[1][q][i]) + w2 * bflo(a[2][q][i])) * siluf_(bflo(z[i])), (w0 * bfhi(a[0][q][i]) + w1 * bfhi(a[1][q][i]) + w2 * bfhi(a[2][q][i])) * siluf_(bfhi(z[i]))); }
        *(u32x4*)(OB + o) = r[0]; *(u32x4*)(OB + o + 8) = r[1];
    }
}

__device__ __forceinline__ void ph_gnorm(const Params& p, int bid, int nb) {
    const bf16_t* P = (const bf16_t*)(p.ws + WS_P); bf16_t* OA = (bf16_t*)(p.ws + WS_OA);
    const int tid = tidx(), lane = tid & 63, gw = __builtin_amdgcn_readfirstlane(tid >> 6) * nb + bid, nw = nb * 8;
    const f32x4 nwa = *(const f32x4*)(p.norm_a + 8 * (lane & 15)), nwb = *(const f32x4*)(p.norm_a + 8 * (lane & 15) + 4);
    for (int task = gw; task < MR * 4; task += nw) { const int row = task >> 2, c0 = (task & 3) * 1024 + 8 * lane;
        bf16_t* op = OA + (size_t)row * 4096 + c0; const bf16_t* zp = P + (size_t)row * NP + C_ZA + c0;
        u32x4 u[2], z[2]; float ss[2];
#pragma unroll
        for (int i = 0; i < 2; ++i) { u[i] = *(const u32x4*)(op + i * 512); z[i] = *(const u32x4*)(zp + i * 512); }
#pragma unroll
        for (int i = 0; i < 2; ++i) { ss[i] = 0.f;
#pragma unroll
            for (int q = 0; q < 4; ++q) ss[i] += bflo(u[i][q]) * bflo(u[i][q]) + bfhi(u[i][q]) * bfhi(u[i][q]); }
#pragma unroll
        for (int o = 1; o <= 8; o <<= 1)
#pragma unroll
            for (int i = 0; i < 2; ++i) ss[i] += __shfl_xor(ss[i], o);
#pragma unroll
        for (int i = 0; i < 2; ++i) { const float r = rsqrtf(ss[i] * (1.f / 128.f) + EPS); u32x4 o;
#pragma unroll
            for (int q = 0; q < 4; ++q) { const f32x4 nv = q < 2 ? nwa : nwb;
                o[q] = pk2(bflo(u[i][q]) * r * nv[(2 * q) & 3] * siluf_(bflo(z[i][q])), bfhi(u[i][q]) * r * nv[(2 * q + 1) & 3] * siluf_(bfhi(z[i][q]))); }
            *(u32x4*)(op + i * 512) = o; } }
}

__device__ __forceinline__ void ph_final(const Params& p, int bid, int nb) {
    const int lane = tidx() & 63, gw = __builtin_amdgcn_readfirstlane(tidx() >> 6) * nb + bid, nw = nb * 8;
    const bf16_t* H = (const bf16_t*)(p.ws + WS_T);
    for (int row = gw; row < MR; row += nw) { float* hr = p.out + (size_t)row * DM; f32x4 v[8]; float ss = 0.f;
        if (row < SEQ) {
#pragma unroll
            for (int i = 0; i < 8; ++i) { const u32x2 q = *(const u32x2*)(H + (size_t)row * DM + i * 256 + lane * 4); v[i] = (f32x4){bflo(q[0]), bfhi(q[0]), bflo(q[1]), bfhi(q[1])}; }
        } else {
#pragma unroll
            for (int i = 0; i < 8; ++i) v[i] = *(const f32x4*)(hr + i * 256 + lane * 4); }
#pragma unroll
        for (int i = 0; i < 8; ++i) ss += v[i][0] * v[i][0] + v[i][1] * v[i][1] + v[i][2] * v[i][2] + v[i][3] * v[i][3];
        ss = wave_sum(ss); const float r = rsqrtf(ss * (1.f / DM) + EPS);
#pragma unroll
        for (int i = 0; i < 8; ++i) { const f32x4 w = *(const f32x4*)(p.ln_f + i * 256 + lane * 4); *(f32x4*)(hr + i * 256 + lane * 4) = (f32x4){v[i][0] * r * w[0], v[i][1] * r * w[1], v[i][2] * r * w[2], v[i][3] * r * w[3]}; } }
}

__device__ __forceinline__ void ph_gemm1(const Params& p, LAS unsigned char* lds, int bid, int nb) {
    pg8::StaticOrder S; S.init(MP, NPAD, nb, bid);
    pg8::gemm_phase(lds, pg8::Gemm{(const bf16_t*)(p.ws + WS_XN), (const bf16_t*)(p.ws + WS_BT1), MP, NPAD, 2048}, S, pg8::EpiProj{(bf16_t*)(p.ws + WS_P), (float*)(p.ws + WS_BA), (bf16_t*)(p.ws + WS_QKVC), (bf16_t*)(p.ws + WS_PS)});
    static_assert((MP / 256) * (NPAD / 256) == 26 * 256 + 169, "the idle workgroups of GEMM 1's last round");
    if (nb == 256 && bid >= 169) {
        const float *w_in = p.w_in, *w_pa = p.w_proj_a, *w_pb = p.w_proj_b, *w_o = p.w_out;
        asm volatile("" : "+s"(w_in), "+s"(w_pa), "+s"(w_pb), "+s"(w_o));
        const int tid = tidx();
        for (int u0 = PRO_TILES1 + (bid - 169) * 4; u0 < PRO_TILES; u0 += 87 * 4) pro_tiles4(p, lds, u0, tid, w_in, w_pa, w_pb, w_o);
    }
}
__device__ __forceinline__ void ph_gemm2a(const Params& p, LAS unsigned char* lds, int bid, int nb) {
    pg8::StaticOrder S; S.init(SEQ, DM, nb, bid);
    pg8::gemm_phase(lds, pg8::Gemm{(const bf16_t*)(p.ws + WS_OB), (const bf16_t*)(p.ws + WS_BT2B), MP, DM, 1024}, S, pg8::EpiGateB{(const bf16_t*)(p.ws + WS_P), (bf16_t*)(p.ws + WS_T)});
}
__device__ __forceinline__ void ph_gemm2b(const Params& p, LAS unsigned char* lds, int bid, int nb) {
    pg8::StaticOrder S; S.init(SEQ, DM, nb, bid);
    pg8::gemm_phase(lds, pg8::Gemm{(const bf16_t*)(p.ws + WS_OA), (const bf16_t*)(p.ws + WS_BT2A), MP, DM, 4096}, S, pg8::EpiMerge{(const bf16_t*)(p.ws + WS_P), (const bf16_t*)(p.ws + WS_T), (bf16_t*)(p.ws + WS_MG)});
}
__device__ __forceinline__ void ph_gemm3(const Params& p, LAS unsigned char* lds, int bid, int nb) {
    pg8::StaticOrder S; S.init(SEQ, DM, nb, bid);
    pg8::gemm_phase(lds, pg8::Gemm{(const bf16_t*)(p.ws + WS_MG), (const bf16_t*)(p.ws + WS_BT3), MP, DM, 2048}, S, pg8::EpiOut{p.x_prompt, (bf16_t*)(p.ws + WS_T)});
}

template <int K> __device__ __forceinline__ f32x4 skinny_acc(const bf16_t* a, const bf16_t* b, f32x4 acc) {
    static_assert(K % 512 == 0, "K step");
#pragma unroll 1
    for (int k0 = 0; k0 < K; k0 += 512) {
        bf16x8 af[16], bfr[16];
#pragma unroll
        for (int i = 0; i < 16; ++i) { af[i] = *(const bf16x8*)(a + k0 + 32 * i); bfr[i] = *(const bf16x8*)(b + k0 + 32 * i); }
#pragma unroll
        for (int i = 0; i < 16; ++i) acc = __builtin_amdgcn_mfma_f32_16x16x32_bf16(af[i], bfr[i], acc, 0, 0, 0);
    }
    return acc;
}
__device__ __forceinline__ void ph_gemm2_sample(const Params& p, LAS unsigned char* lds, int bid) {
    if (bid >= 256) return;
    const int tid = tidx(), lane = tid & 63, wv = __builtin_amdgcn_readfirstlane(tid >> 6), fr = lane & 15, fq = lane >> 4, rt = (bid & 1) * 4 + (wv & 3), kh = wv >> 2, cb = bid >> 1;
    const bf16_t* P = (const bf16_t*)(p.ws + WS_P);
    const int arow = SEQ + 16 * rt + fr, bcol = 16 * cb + fr;
    f32x4 aa = (f32x4){0.f, 0.f, 0.f, 0.f}, ab = aa;
    aa = skinny_acc<2048>((const bf16_t*)(p.ws + WS_OA) + (size_t)arow * 4096 + kh * 2048 + 8 * fq, (const bf16_t*)(p.ws + WS_BT2A) + (size_t)bcol * 4096 + kh * 2048 + 8 * fq, aa);
    ab = skinny_acc<512>((const bf16_t*)(p.ws + WS_OB) + (size_t)arow * 1024 + kh * 512 + 8 * fq, (const bf16_t*)(p.ws + WS_BT2B) + (size_t)bcol * 1024 + kh * 512 + 8 * fq, ab);
    LAS f32x4* red = (LAS f32x4*)lds + (wv & 3) * 128 + lane * 2;
    if (kh) { red[0] = aa; red[1] = ab; }
    __syncthreads();
    if (!kh) { aa += red[0]; ab += red[1];
        bf16_t* MG = (bf16_t*)(p.ws + WS_MG);
#pragma unroll
        for (int r = 0; r < 4; ++r) { const size_t row = (size_t)(SEQ + 16 * rt + 4 * fq + r); const int c = 16 * cb + fr;
            const float ga = sigmoidf_(bf2f(P[row * NP + C_GA + c])), gb = sigmoidf_(bf2f(P[row * NP + C_GB + c]));
            MG[row * DM + c] = f2bf(ga * aa[r] + gb * ab[r]); } }
    __syncthreads();
}
__device__ __forceinline__ void ph_gemm3_sample(const Params& p, LAS unsigned char* lds, int bid) {
    if (bid >= 256) return;
    const int tid = tidx(), lane = tid & 63, wv = __builtin_amdgcn_readfirstlane(tid >> 6), fr = lane & 15, fq = lane >> 4, rt = (bid & 1) * 4 + (wv & 3), kh = wv >> 2, cb = bid >> 1;
    const int arow = SEQ + 16 * rt + fr, bcol = 16 * cb + fr;
    f32x4 acc = (f32x4){0.f, 0.f, 0.f, 0.f};
    acc = skinny_acc<1024>((const bf16_t*)(p.ws + WS_MG) + (size_t)arow * 2048 + kh * 1024 + 8 * fq, (const bf16_t*)(p.ws + WS_BT3) + (size_t)bcol * 2048 + kh * 1024 + 8 * fq, acc);
    LAS f32x4* red = (LAS f32x4*)lds + (wv & 3) * 64 + lane;
    if (kh) red[0] = acc;
    __syncthreads();
    if (!kh) { acc += red[0];
#pragma unroll
        for (int r = 0; r < 4; ++r) { const int srow = 16 * rt + 4 * fq + r, c = 16 * cb + fr;
            p.out[(size_t)(SEQ + srow) * DM + c] = p.x_sample[(size_t)srow * DM + c] + acc[r]; } }
    __syncthreads();
}

constexpr int LDS_MAIN = 4 * REC_DMA + 8192;
constexpr int LDS_BYTES = LDS_MAIN + 16;
__global__ __launch_bounds__(512, 2) void k_fwd(Params p) {
    extern __shared__ __attribute__((aligned(16))) unsigned char shm[];
    LAS unsigned char* lds = (LAS unsigned char*)shm;
    const int bid = blockIdx.x, nb = gridDim.x;
    if (threadIdx.x < 4) ((LAS unsigned*)(lds + LDS_MAIN))[threadIdx.x] = 0u;
    __syncthreads();
    XcdBarrier bar = xcd_barrier_post((unsigned*)(p.ws + WS_BAR), (volatile LAS unsigned*)(lds + LDS_MAIN));
    ph_prologue(p, lds, bid, nb);
    xcd_barrier(bar);
    ph_gemm1(p, lds, bid, nb);
    xcd_barrier(bar);
    ph_prep(p, bid, nb);
    ph_stage_a(p, lds, bid, nb);
    xcd_barrier(bar);
    if (bid < SCAN_WGS) ph_scan(p, lds, bid);
    ph_attn(p, lds);
    xcd_barrier(bar);
    ph_gnorm(p, bid, nb);
    ph_mix(p, bid, nb);
    xcd_barrier(bar);
    ph_gemm2_sample(p, lds, bid);
    ph_gemm2a(p, lds, bid, nb);
    ph_gemm2b(p, lds, bid, nb);
    xcd_barrier(bar);
    ph_gemm3_sample(p, lds, bid);
    ph_gemm3(p, lds, bid, nb);
    xcd_barrier(bar);
    ph_final(p, bid, nb);
}

extern "C" void kernel_launch(void* const* d_in, const int* in_sizes, int n_in, void* d_out, int out_size, void* d_ws, size_t ws_size, hipStream_t stream) {
    if (n_in != 17 || (size_t)out_size != O_END || ws_size < WS_END) { fprintf(stderr, "kernel_launch: unexpected sizes n_in %d out %d ws %zu (need %zu)\n", n_in, out_size, ws_size, (size_t)WS_END); return; }
    static int grid = 0;
    if (!grid) {
        int dev = 0, cus = 0, per_cu = 0;
        if (hipGetDevice(&dev) != hipSuccess || hipDeviceGetAttribute(&cus, hipDeviceAttributeMultiprocessorCount, dev) != hipSuccess) { fprintf(stderr, "kernel_launch: device query failed\n"); return; }
        if (hipFuncSetAttribute((const void*)k_fwd, hipFuncAttributeMaxDynamicSharedMemorySize, LDS_BYTES) != hipSuccess) { fprintf(stderr, "kernel_launch: hipFuncSetAttribute failed\n"); return; }
        if (hipOccupancyMaxActiveBlocksPerMultiprocessor(&per_cu, (const void*)k_fwd, 512, LDS_BYTES) != hipSuccess || per_cu < 1) { fprintf(stderr, "kernel_launch: occupancy query says %d blocks per CU\n", per_cu); return; }
        grid = cus;
    }
    Params p{};
    p.x_prompt = (const float*)d_in[0]; p.x_sample = (const float*)d_in[1]; p.c128 = (const float*)d_in[2]; p.c512 = (const float*)d_in[3]; p.c2048 = (const float*)d_in[4];
    p.state_delta = (const float*)d_in[5]; p.state_conv = (const float*)d_in[6]; p.ln_in = (const float*)d_in[7]; p.w_in = (const float*)d_in[8]; p.conv_w = (const float*)d_in[9];
    p.a_log = (const float*)d_in[10]; p.dt_bias = (const float*)d_in[11]; p.norm_a = (const float*)d_in[12]; p.w_proj_a = (const float*)d_in[13]; p.w_proj_b = (const float*)d_in[14];
    p.w_out = (const float*)d_in[15]; p.ln_f = (const float*)d_in[16]; p.out = (float*)d_out; p.ws = (unsigned char*)d_ws;
    (void)hipMemsetAsync((char*)d_ws + WS_BAR, 0, 16384, stream);
    hipLaunchKernelGGL(k_fwd, dim3(grid), dim3(512), LDS_BYTES, stream, p);
}
```

```cpp
#include <hip/hip_runtime.h>
#include <stdint.h>
#include <stdio.h>

#define LAS __attribute__((address_space(3)))
typedef unsigned short bf16_t;
typedef short bf16x8 __attribute__((ext_vector_type(8)));
typedef float f32x4 __attribute__((ext_vector_type(4)));
typedef float f32x2 __attribute__((ext_vector_type(2)));
typedef unsigned u32x4 __attribute__((ext_vector_type(4)));
typedef unsigned u32x2 __attribute__((ext_vector_type(2)));

constexpr int DM = 2048, SEQ = 16384, NSAMP = 128, MR = SEQ + NSAMP  , MP = 16640  ;
constexpr int NPAD = 26880;
constexpr int NP = 17408;
constexpr int C_QA = 0, C_KA = 2048, C_VA = 4096, C_ZA = 8192, C_ZB = 12288, C_GA = 13312, C_GB = 15360;
constexpr float EPS = 1e-6f;
constexpr size_t O_Y = 0, O_YS = 33554432, O_KV128P = O_YS + 262144, O_KV512P = O_KV128P + 262144, O_KV2048P = O_KV512P + 1048576, O_DELTAP = O_KV2048P + 4194304,
                 O_CONVP = O_DELTAP + 524288, O_KV128S = O_CONVP + 24576, O_KV512S = O_KV128S + 8388608, O_KV2048S = O_KV512S + 33554432, O_DELTAS = O_KV2048S + 134217728,
                 O_CONVS = O_DELTAS + 16777216, O_END = O_CONVS + 786432;
constexpr int CH = 32, NCHUNK = SEQ / CH;
constexpr int REC_W = 0, REC_QG = 8192, REC_IN = 16384, REC_KD = 18432, REC_U = 26624, REC_GL = 34816, RECB = 35072, REC_DMA = 36864;
constexpr size_t WS_BAR = 0, WS_REC = 16384, REC_BYTES = (size_t)NCHUNK * 32 * RECB + 4096,
                 WS_XN = WS_REC, WS_BT1 = WS_XN + (size_t)MP * 2048 * 2, WS_T = WS_REC + ((size_t)200 << 20), WS_MG = WS_REC + ((size_t)300 << 20),
                 WS_BT2A = WS_REC + ((REC_BYTES + 255) & ~(size_t)255), WS_BT2B = WS_BT2A + (size_t)2048 * 4096 * 2,
                 WS_BT3 = WS_BT2B + (size_t)2048 * 1024 * 2, WS_P = WS_BT3 + (size_t)2048 * 2048 * 2, WS_BA = WS_P + (size_t)MP * NP * 2, WS_BG = WS_BA + (size_t)MP * 64 * 4,
                 WS_CV = WS_BG + (size_t)MP * 64 * 4, WS_OA = WS_CV + (size_t)MP * 8192 * 2, WS_OB = WS_OA + (size_t)MP * 4096 * 2, WS_QKVC = WS_OB + (size_t)MP * 1024 * 2, WS_PS = WS_QKVC + (size_t)3 * 3 * 8 * SEQ * 128 * 2, WS_END = WS_PS + (size_t)256 * 9216 * 2,
                 WS_OG = WS_CV  , WS_LSE = WS_CV + (size_t)3 * SEQ * 1024 * 2;
static_assert(WS_LSE + (size_t)3 * SEQ * 8 * 4 <= WS_OA, "OG/LSE inside CV");
static_assert(WS_BT1 + (size_t)NPAD * 2048 * 2 <= WS_T && WS_T + (size_t)MP * 2048 * 2 <= WS_MG && WS_MG + (size_t)MP * 2048 * 2 <= WS_BT2A, "aliases inside REC");

__host__ __device__ __forceinline__ size_t qkvc_row(int which, int g, int h, int tok) { const int sh = 2 * g, pos = (tok & ((1 << sh) - 1)) * (SEQ >> sh) + (tok >> sh); return ((size_t)((which * 3 + g) * 8 + h) * SEQ + pos) * 128; }
struct Params {
    const float *x_prompt, *x_sample, *c128, *c512, *c2048, *state_delta, *state_conv, *ln_in, *w_in, *conv_w, *a_log, *dt_bias, *norm_a, *w_proj_a, *w_proj_b, *w_out, *ln_f;
    float* out;
    unsigned char* ws;
};

__device__ __forceinline__ int tidx() { int t = threadIdx.x; asm volatile("" : "+v"(t)); return t; }
__device__ __forceinline__ float bf2f(bf16_t b) { return __uint_as_float(((unsigned)b) << 16); }
__device__ __forceinline__ float bflo(unsigned u) { return __uint_as_float(u << 16); }
__device__ __forceinline__ float bfhi(unsigned u) { return __uint_as_float(u & 0xffff0000u); }
__device__ __forceinline__ bf16_t f2bf(float f) { unsigned u = __float_as_uint(f); u += 0x7FFFu + ((u >> 16) & 1u); return (bf16_t)(u >> 16); }
typedef __bf16 bf16x2_t __attribute__((ext_vector_type(2)));
__device__ __forceinline__ unsigned pk2(float lo, float hi) { const f32x2 v = {lo, hi}; return __builtin_bit_cast(unsigned, __builtin_convertvector(v, bf16x2_t)); }
__device__ __forceinline__ float sigmoidf_(float x) { return __builtin_amdgcn_rcpf(1.f + __builtin_amdgcn_exp2f(-1.4426950408889634f * x)); }
__device__ __forceinline__ float siluf_(float x) { return x * __builtin_amdgcn_rcpf(1.f + __builtin_amdgcn_exp2f(-1.4426950408889634f * x)); }
__device__ __forceinline__ float wave_sum(float v) {
#pragma unroll
    for (int o = 32; o >= 1; o >>= 1) v += __shfl_xor(v, o);
    return v;
}
__device__ __forceinline__ float wave_max(float v) {
#pragma unroll
    for (int o = 32; o >= 1; o >>= 1) v = fmaxf(v, __shfl_xor(v, o));
    return v;
}


#define XB_TMO      128
#define XB_XCNT(j)  (256  + 64 * (j))
#define XB_XSUB(j)  (1280 + 64 * (j))
#define XB_XGEN(j)  (2304 + 64 * (j))
#define XB_TOP      3328
#define XB_TOPGEN   3392
#define XCD_BAR_WORDS 3456
#define XB_SPIN_CAP (1u << 18)
__device__ __forceinline__ unsigned xb_ld(unsigned* p)              { return __hip_atomic_load(p, __ATOMIC_RELAXED, __HIP_MEMORY_SCOPE_AGENT); }
__device__ __forceinline__ unsigned xb_add(unsigned* p, unsigned v) { return __hip_atomic_fetch_add(p, v, __ATOMIC_RELAXED, __HIP_MEMORY_SCOPE_AGENT); }
__device__ __forceinline__ unsigned xb_xcc_id() { return (unsigned)__builtin_amdgcn_s_getreg((3 << 11) | 20) & 0xFu; }
#define XB_SPIN(cond, bar) do { unsigned _sp = 0; while (cond) { __builtin_amdgcn_s_sleep(1); \
    if ((++_sp & 255u) == 0u) { if (xb_ld(&(bar)[XB_TMO])) break; if (_sp > XB_SPIN_CAP) { atomicAdd(&(bar)[XB_TMO], 1u); break; } } } } while (0)
struct XcdBarrier { unsigned* bar; unsigned x; volatile LAS unsigned* st; };
__device__ __forceinline__ XcdBarrier xcd_barrier_post(unsigned* bar, volatile LAS unsigned* st) {
    XcdBarrier b; b.bar = bar; b.x = xb_xcc_id(); b.st = st;
    if (threadIdx.x == 0) (void)xb_add(&bar[XB_XCNT(b.x)], 1u);
    return b;
}
__device__ __forceinline__ void xcd_barrier_complete(unsigned* bar, unsigned x, unsigned& nloc, unsigned& nx) {
    const unsigned G = gridDim.x * gridDim.y * gridDim.z;
    unsigned sum, cnt, mine, sp = 0u;
    for (;;) {
        sum = 0u; cnt = 0u; mine = 0u;
#pragma unroll
        for (unsigned j = 0; j < 16; ++j) { const unsigned c = xb_ld(&bar[XB_XCNT(j)]); sum += c; cnt += (c > 0u) ? 1u : 0u; mine = (j == x) ? c : mine; }
        if (sum == G) break;
        __builtin_amdgcn_s_sleep(1);
        if ((++sp & 255u) == 0u) { if (xb_ld(&bar[XB_TMO])) break; if (sp > XB_SPIN_CAP) { atomicAdd(&bar[XB_TMO], 1u); break; } }
    }
    nloc = mine > 0u ? mine : 1u; nx = cnt > 0u ? cnt : 1u;
}
__device__ __forceinline__ void xcd_barrier(const XcdBarrier& b) {
    asm volatile("s_waitcnt vmcnt(0)" ::: "memory");
    __syncthreads();
    if (threadIdx.x == 0) {
        unsigned* bar = b.bar;
        __builtin_amdgcn_s_waitcnt(0);
        unsigned nloc = b.st[0], nx = b.st[1];
        if (nloc == 0u) { xcd_barrier_complete(bar, b.x, nloc, nx); b.st[0] = nloc; b.st[1] = nx; }
        const unsigned old = xb_add(&bar[XB_XSUB(b.x)], 1u);
        const unsigned gen = old / nloc;
        if (old + 1u == (gen + 1u) * nloc) {
            __builtin_amdgcn_fence(__ATOMIC_RELEASE, "agent");
            asm volatile("s_waitcnt vmcnt(0)" ::: "memory");
            const unsigned og = xb_add(&bar[XB_TOP], 1u);
            const unsigned tg = og / nx;
            if (og + 1u == (tg + 1u) * nx) xb_add(&bar[XB_TOPGEN], 1u);
            else XB_SPIN(xb_ld(&bar[XB_TOPGEN]) == tg, bar);
            __builtin_amdgcn_fence(__ATOMIC_ACQUIRE, "agent");
            xb_add(&bar[XB_XGEN(b.x)], 1u);
            asm volatile("s_waitcnt vmcnt(0)" ::: "memory");
        } else {
            XB_SPIN(xb_ld(&bar[XB_XGEN(b.x)]) == gen, bar);
            __builtin_amdgcn_fence(__ATOMIC_ACQUIRE, "agent");
            asm volatile("s_waitcnt vmcnt(0)" ::: "memory");
        }
    }
    __syncthreads();
}

namespace pg8 {
constexpr int BM = 256, BK = 64, HALF = 128, HTB = HALF * BK * 2, STAGE_BYTES = 8 * HTB, NXCD = 8, WGM = 8;
__host__ __device__ __forceinline__ int lds_byte(int r, int c) { const int st = (r >> 4) * 2 + (c >> 5), rr = r & 15, cc = c & 31, ob = rr * 64 + cc * 2; return st * 1024 + (ob ^ (((ob >> 9) & 1) << 5)); }
__host__ __device__ __forceinline__ void stage_rc(int b, int& R, int& C) { const int st = b / 1024, sb = b % 1024, swz = sb ^ (((sb >> 9) & 1) << 5); R = (st >> 1) * 16 + swz / 64; C = (st & 1) * 32 + (swz % 64) / 2; }
__host__ __device__ __forceinline__ int perm32(int rho) { const int n = rho >> 4, i = rho & 15; return 8 * (i >> 2) + 4 * n + (i & 3); }
struct Unit { int pm, pn; };
struct Gemm { const bf16_t* A; const bf16_t* Bt; int M, N, K; };
struct StaticOrder {
    int nM, nN, nwg, G, c;
    __host__ __device__ void init(int M, int N, int G_, int c_) { nM = M / BM; nN = N / BM; nwg = nM * nN; G = G_; c = c_; }
    __host__ __device__ bool next(int i, Unit& u) const {
        const long L = (long)i * G + c; if (L >= nwg) return false;
        int wgid = (int)L; { const int q = nwg / NXCD, r = nwg % NXCD, xcd = wgid % NXCD, off = wgid / NXCD; wgid = (xcd < r ? xcd * (q + 1) : r * (q + 1) + (xcd - r) * q) + off; }
        const int nig = WGM * nN, gid = wgid / nig, fm = gid * WGM, gsz = (nM - fm) < WGM ? (nM - fm) : WGM;
        u.pm = fm + ((wgid % nig) % gsz); u.pn = (wgid % nig) / gsz; return true;
    }
    __device__ __forceinline__ void a_ready(const Unit&) const {}
    __device__ __forceinline__ void done(const Unit&) const {}
};
__device__ __forceinline__ unsigned cvt_pk_bf16(float lo, float hi) { return pk2(lo, hi); }

template <class Epi, class Sched>
__device__ __forceinline__ void gemm_phase(LAS unsigned char* lds, const Gemm g, const Sched& S, const Epi& E) {
    const int tid = tidx(), wid = __builtin_amdgcn_readfirstlane(tid >> 6), lane = tid & 63, wr = wid >> 2, wc = wid & 3, fr = lane & 15, fq = lane >> 4;
    const int K = g.K, nt = K / BK;
    unsigned voffA[2], voffB[2];
#pragma unroll
    for (int i = 0; i < 2; ++i) { int R, C; stage_rc(tid * 16 + i * 8192, R, C); const int Rb = Epi::PERM ? ((R & ~31) + perm32(R & 31)) : R;
        voffA[i] = (unsigned)(R * K + C) * 2u; voffB[i] = (unsigned)(Rb * K + C) * 2u; }
    const size_t kstep = (size_t)(BK * 2);
    const size_t hstep = (size_t)HALF * K * 2;
    const size_t tstep = 2 * hstep;
    const unsigned ldsw = (unsigned)wid * 1024u;
    const int aoff = lds_byte(wr * 64 + fr, fq * 8), boff = lds_byte(wc * 32 + fr, fq * 8);
#define PG8_SA(b, h) (((b) * 2 + (h)) * HTB)
#define PG8_SB(b, h) ((4 + (b) * 2 + (h)) * HTB)
#define PG8_STAGE(bufoff, gbase, voff) do { _Pragma("unroll") for (int _i = 0; _i < 2; ++_i) \
        __builtin_amdgcn_global_load_lds((const unsigned*)((const char*)(gbase) + (voff)[_i]), (LAS unsigned*)(lds + (bufoff) + ldsw + _i * 8192), 16, 0, 0); } while (0)
#define PG8_LDA(dst, b, h) do { _Pragma("unroll") for (int m = 0; m < 4; ++m) _Pragma("unroll") for (int k = 0; k < 2; ++k) dst[m][k] = *(const LAS bf16x8*)(lds + PG8_SA(b, h) + aoff + m * 2048 + k * 1024); } while (0)
#define PG8_LDB(dst, b, h) do { _Pragma("unroll") for (int n = 0; n < 2; ++n) _Pragma("unroll") for (int k = 0; k < 2; ++k) dst[n][k] = *(const LAS bf16x8*)(lds + PG8_SB(b, h) + boff + n * 2048 + k * 1024); } while (0)
#define PG8_MMA(ai, bj, At, Bt) do { __builtin_amdgcn_s_setprio(1); _Pragma("unroll") for (int m = 0; m < 4; ++m) _Pragma("unroll") for (int n = 0; n < 2; ++n) _Pragma("unroll") for (int k = 0; k < 2; ++k) \
        acc[ai][bj][m][n] = __builtin_amdgcn_mfma_f32_16x16x32_bf16(Bt[n][k], At[m][k], acc[ai][bj][m][n], 0, 0, 0); __builtin_amdgcn_s_setprio(0); } while (0)
#define PG8_WAIT_V(n) asm volatile("s_waitcnt vmcnt(" #n ")" ::: "memory")
#define PG8_WAIT_L(n) asm volatile("s_waitcnt lgkmcnt(" #n ")" ::: "memory")
#define PG8_BAR __builtin_amdgcn_s_barrier()
#define PG8_SCHED __builtin_amdgcn_sched_barrier(0)
    Unit cur, nxt; int ui = 0;
    if (!S.next(0, cur)) return;
    f32x4 acc[2][2][4][2];
#pragma unroll
    for (int a = 0; a < 2; ++a)
#pragma unroll
        for (int b = 0; b < 2; ++b)
#pragma unroll
            for (int m = 0; m < 4; ++m)
#pragma unroll
                for (int n = 0; n < 2; ++n) acc[a][b][m][n] = (f32x4){0.f, 0.f, 0.f, 0.f};
    bf16x8 At[4][2], B0[2][2], B1[2][2];
    const char* cA = (const char*)g.A + (size_t)cur.pm * tstep; const char* cB = (const char*)g.Bt + (size_t)cur.pn * tstep;
    S.a_ready(cur);
    PG8_STAGE(PG8_SB(0, 0), cB, voffB); PG8_STAGE(PG8_SA(0, 0), cA, voffA); PG8_STAGE(PG8_SB(0, 1), cB + hstep, voffB); PG8_STAGE(PG8_SA(0, 1), cA + hstep, voffA);
    if (wr == 1) PG8_BAR;
    PG8_WAIT_V(4); PG8_BAR;
    PG8_STAGE(PG8_SB(1, 0), cB + kstep, voffB); PG8_STAGE(PG8_SA(1, 0), cA + kstep, voffA); PG8_STAGE(PG8_SB(1, 1), cB + hstep + kstep, voffB);
    PG8_WAIT_V(6); PG8_BAR;
    for (;;) {
        const bool has_next = S.next(ui + 1, nxt);
        const char* nA = has_next ? (const char*)g.A + (size_t)nxt.pm * tstep : cA; const char* nB = has_next ? (const char*)g.Bt + (size_t)nxt.pn * tstep : cB;
        for (int t = 0; t < nt; t += 2) {
            const bool last = (t == nt - 2);
            const char* a1 = cA + (size_t)(t + 1) * kstep;
            const char* a2 = last ? nA : cA + (size_t)(t + 2) * kstep; const char* b2 = last ? nB : cB + (size_t)(t + 2) * kstep;
            const char* a3 = a2 + kstep; const char* b3 = b2 + kstep;
            if (last && has_next) S.a_ready(nxt);
            PG8_LDB(B0, 0, 0); PG8_SCHED; PG8_LDA(At, 0, 0); PG8_STAGE(PG8_SA(1, 1), a1 + hstep, voffA);
            PG8_WAIT_L(8); PG8_BAR; PG8_WAIT_L(0); PG8_MMA(0, 0, At, B0); PG8_BAR; PG8_SCHED;
            PG8_LDB(B1, 0, 1); PG8_STAGE(PG8_SB(0, 0), b2, voffB);
            PG8_BAR; PG8_WAIT_L(0); PG8_MMA(0, 1, At, B1); PG8_BAR;
            PG8_LDA(At, 0, 1); PG8_STAGE(PG8_SA(0, 0), a2, voffA);
            PG8_BAR; PG8_WAIT_L(0); PG8_MMA(1, 0, At, B0); PG8_BAR; PG8_SCHED;
            PG8_STAGE(PG8_SB(0, 1), b2 + hstep, voffB);
            PG8_WAIT_V(6); PG8_BAR; PG8_MMA(1, 1, At, B1); PG8_BAR;
            PG8_LDB(B0, 1, 0); PG8_SCHED; PG8_LDA(At, 1, 0); PG8_STAGE(PG8_SA(0, 1), a2 + hstep, voffA);
            PG8_WAIT_L(8); PG8_BAR; PG8_WAIT_L(0); PG8_MMA(0, 0, At, B0); PG8_BAR; PG8_SCHED;
            PG8_LDB(B1, 1, 1); PG8_STAGE(PG8_SB(1, 0), b3, voffB);
            PG8_BAR; PG8_WAIT_L(0); PG8_MMA(0, 1, At, B1); PG8_BAR;
            PG8_LDA(At, 1, 1); PG8_STAGE(PG8_SA(1, 0), a3, voffA);
            PG8_BAR; PG8_WAIT_L(0); PG8_MMA(1, 0, At, B0); PG8_BAR; PG8_SCHED;
            PG8_STAGE(PG8_SB(1, 1), b3 + hstep, voffB);
            PG8_WAIT_V(6); PG8_BAR; PG8_MMA(1, 1, At, B1); PG8_BAR;
        }
        E(acc, cur, wr, wc, fr, fq); S.done(cur);
        if (!has_next) break;
#pragma unroll
        for (int a = 0; a < 2; ++a)
#pragma unroll
            for (int b = 0; b < 2; ++b)
#pragma unroll
                for (int m = 0; m < 4; ++m)
#pragma unroll
                    for (int n = 0; n < 2; ++n) acc[a][b][m][n] = (f32x4){0.f, 0.f, 0.f, 0.f};
        cur = nxt; cA = nA; cB = nB; ++ui;
    }
    PG8_WAIT_V(0);
    if (wr == 0) PG8_BAR;
    PG8_BAR;
#undef PG8_SA
#undef PG8_SB
#undef PG8_STAGE
#undef PG8_LDA
#undef PG8_LDB
#undef PG8_MMA
#undef PG8_WAIT_V
#undef PG8_WAIT_L
#undef PG8_BAR
#undef PG8_SCHED
}

struct EpiProj {
    static constexpr bool PERM = true;
    bf16_t* P; float* BA; bf16_t* QKVC; bf16_t* PS;
    __device__ __forceinline__ void operator()(const f32x4 (&acc)[2][2][4][2], const Unit& u, int wr, int wc, int fr, int fq) const {
        const int row0 = u.pm * BM + wr * 64 + fr;
        if (u.pn >= 48 && u.pn < 84) {
#pragma unroll
            for (int bj = 0; bj < 2; ++bj) { const int hh = (u.pn - 48) * 2 + bj, which = hh / 24, g = (hh % 24) >> 3, h = hh & 7, d0 = wc * 32 + 8 * fq;
#pragma unroll
                for (int ai = 0; ai < 2; ++ai)
#pragma unroll
                    for (int m = 0; m < 4; ++m) { const int row = row0 + ai * HALF + m * 16; const f32x4 v0 = acc[ai][bj][m][0], v1 = acc[ai][bj][m][1];
                        bf16_t* dst = row < SEQ ? QKVC + qkvc_row(which, g, h, row) + d0 : PS + (size_t)(row - SEQ) * 9216 + hh * 128 + d0;
                        *(u32x4*)dst = (u32x4){cvt_pk_bf16(v0[0], v0[1]), cvt_pk_bf16(v0[2], v0[3]), cvt_pk_bf16(v1[0], v1[1]), cvt_pk_bf16(v1[2], v1[3])}; } }
        } else if (u.pn < 104) {
            const int col0 = (u.pn < 48 ? u.pn : u.pn - 36) * BM + wc * 32 + 8 * fq;
#pragma unroll
            for (int ai = 0; ai < 2; ++ai)
#pragma unroll
                for (int m = 0; m < 4; ++m) { bf16_t* rowp = P + (size_t)(row0 + ai * HALF + m * 16) * NP + col0;
#pragma unroll
                    for (int bj = 0; bj < 2; ++bj) { const f32x4 v0 = acc[ai][bj][m][0], v1 = acc[ai][bj][m][1];
                        *(u32x4*)(rowp + bj * HALF) = (u32x4){cvt_pk_bf16(v0[0], v0[1]), cvt_pk_bf16(v0[2], v0[3]), cvt_pk_bf16(v1[0], v1[1]), cvt_pk_bf16(v1[2], v1[3])}; } }
        } else if (wc < 2) {
#pragma unroll
            for (int ai = 0; ai < 2; ++ai)
#pragma unroll
                for (int m = 0; m < 4; ++m) { float* rp = BA + (size_t)(row0 + ai * HALF + m * 16) * 64 + wc * 32 + 8 * fq;
                    *(f32x4*)rp = acc[ai][0][m][0]; *(f32x4*)(rp + 4) = acc[ai][0][m][1]; }
        }
    }
};
__device__ __forceinline__ void sig8(const bf16_t* p, float (&s)[8]) {
    const u32x4 g = *(const u32x4*)p;
#pragma unroll
    for (int i = 0; i < 4; ++i) { s[2 * i] = sigmoidf_(bflo(g[i])); s[2 * i + 1] = sigmoidf_(bfhi(g[i])); }
}
struct EpiGateB {
    static constexpr bool PERM = true;
    const bf16_t* P; bf16_t* T;
    __device__ __forceinline__ void operator()(const f32x4 (&acc)[2][2][4][2], const Unit& u, int wr, int wc, int fr, int fq) const {
        const int row0 = u.pm * BM + wr * 64 + fr, col0 = u.pn * BM + wc * 32 + 8 * fq;
#pragma unroll
        for (int ai = 0; ai < 2; ++ai)
#pragma unroll
            for (int m = 0; m < 4; ++m) { const size_t row = (size_t)(row0 + ai * HALF + m * 16);
#pragma unroll
                for (int bj = 0; bj < 2; ++bj) { const f32x4 v0 = acc[ai][bj][m][0], v1 = acc[ai][bj][m][1]; const int c = col0 + bj * HALF;
                    float s[8]; sig8(P + row * NP + C_GB + c, s);
                    *(u32x4*)(T + row * DM + c) = (u32x4){cvt_pk_bf16(v0[0] * s[0], v0[1] * s[1]), cvt_pk_bf16(v0[2] * s[2], v0[3] * s[3]), cvt_pk_bf16(v1[0] * s[4], v1[1] * s[5]), cvt_pk_bf16(v1[2] * s[6], v1[3] * s[7])}; } }
    }
};
struct EpiMerge {
    static constexpr bool PERM = true;
    const bf16_t* P; const bf16_t* T; bf16_t* MG;
    __device__ __forceinline__ void operator()(const f32x4 (&acc)[2][2][4][2], const Unit& u, int wr, int wc, int fr, int fq) const {
        const int row0 = u.pm * BM + wr * 64 + fr, col0 = u.pn * BM + wc * 32 + 8 * fq;
#pragma unroll
        for (int ai = 0; ai < 2; ++ai)
#pragma unroll
            for (int m = 0; m < 4; ++m) { const size_t row = (size_t)(row0 + ai * HALF + m * 16);
#pragma unroll
                for (int bj = 0; bj < 2; ++bj) { const f32x4 v0 = acc[ai][bj][m][0], v1 = acc[ai][bj][m][1]; const int c = col0 + bj * HALF;
                    float s[8]; sig8(P + row * NP + C_GA + c, s);
                    const u32x4 t = *(const u32x4*)(T + row * DM + c);
                    *(u32x4*)(MG + row * DM + c) = (u32x4){cvt_pk_bf16(v0[0] * s[0] + bflo(t[0]), v0[1] * s[1] + bfhi(t[0])), cvt_pk_bf16(v0[2] * s[2] + bflo(t[1]), v0[3] * s[3] + bfhi(t[1])),
                                                           cvt_pk_bf16(v1[0] * s[4] + bflo(t[2]), v1[1] * s[5] + bfhi(t[2])), cvt_pk_bf16(v1[2] * s[6] + bflo(t[3]), v1[3] * s[7] + bfhi(t[3]))}; } }
    }
};
struct EpiOut {
    static constexpr bool PERM = true;
    const float* xp; bf16_t* H;
    __device__ __forceinline__ void operator()(const f32x4 (&acc)[2][2][4][2], const Unit& u, int wr, int wc, int fr, int fq) const {
        const int row0 = u.pm * BM + wr * 64 + fr, col0 = u.pn * BM + wc * 32 + 8 * fq;
#pragma unroll
        for (int ai = 0; ai < 2; ++ai)
#pragma unroll
            for (int m = 0; m < 4; ++m) { const int row = row0 + ai * HALF + m * 16;
                if (row < SEQ) { const float* xr = xp + (size_t)row * DM; bf16_t* hr = H + (size_t)row * DM;
#pragma unroll
                    for (int bj = 0; bj < 2; ++bj) { const int c = col0 + bj * HALF; const f32x4 v0 = acc[ai][bj][m][0] + *(const f32x4*)(xr + c), v1 = acc[ai][bj][m][1] + *(const f32x4*)(xr + c + 4);
                        *(u32x4*)(hr + c) = (u32x4){cvt_pk_bf16(v0[0], v0[1]), cvt_pk_bf16(v0[2], v0[3]), cvt_pk_bf16(v1[0], v1[1]), cvt_pk_bf16(v1[2], v1[3])}; } } }
    }
};
}

struct TileDesc { const float* src; bf16_t* dst; int ld_src, ld_dst, k0, n0src, n0dst; bool zero; };
__device__ __forceinline__ TileDesc tile_desc(const Params& p, const float* w_in, const float* w_pa, const float* w_pb, const float* w_o, int u) {
    constexpr int U0 = 32 * 420, U1 = U0 + 64 * 32, U2 = U1 + 16 * 32;
    TileDesc t; t.zero = false;
    if (u < U0) { const int kt = u & 31, nt = u >> 5, n0 = nt * 64; int ns;
        if (n0 < 12288) ns = n0; else if (n0 < 26624) ns = n0 + 64; else if (n0 < 26688) ns = 12288 + (n0 - 26624); else { ns = 0; t.zero = true; }
        t.src = w_in; t.ld_src = 26688; t.k0 = kt * 64; t.n0src = ns; t.dst = (bf16_t*)(p.ws + WS_BT1); t.ld_dst = 2048; t.n0dst = n0;
    } else if (u < U1) { const int v = u - U0, kt = v & 63, nt = v >> 6; t.src = w_pa; t.ld_src = 2048; t.k0 = kt * 64; t.n0src = nt * 64; t.dst = (bf16_t*)(p.ws + WS_BT2A); t.ld_dst = 4096; t.n0dst = nt * 64;
    } else if (u < U2) { const int v = u - U1, kt = v & 15, nt = v >> 4; t.src = w_pb; t.ld_src = 2048; t.k0 = kt * 64; t.n0src = nt * 64; t.dst = (bf16_t*)(p.ws + WS_BT2B); t.ld_dst = 1024; t.n0dst = nt * 64;
    } else { const int v = u - U2, kt = v & 31, nt = v >> 5; t.src = w_o; t.ld_src = 2048; t.k0 = kt * 64; t.n0src = nt * 64; t.dst = (bf16_t*)(p.ws + WS_BT3); t.ld_dst = 2048; t.n0dst = nt * 64; }
    return t;
}
constexpr int PRO_TILES = 32 * 420 + 64 * 32 + 16 * 32 + 32 * 32;
constexpr int PRO_TILES1 = 32 * 420;
static_assert(PRO_TILES1 % 4 == 0 && PRO_TILES % 4 == 0, "tile batches");
__device__ __forceinline__ void pro_tiles4(const Params& p, LAS unsigned char* lds, int u0, int tid, const float* w_in, const float* w_pa, const float* w_pb, const float* w_o) {
    const int r = tid >> 4, c4 = tid & 15, n = tid >> 3, k8 = tid & 7;
        f32x4 v[4][2];
#pragma unroll
        for (int j = 0; j < 4; ++j) { const int u = u0 + j;
#pragma unroll
            for (int h = 0; h < 2; ++h) v[j][h] = (f32x4){0.f, 0.f, 0.f, 0.f};
            if (u < PRO_TILES) { const TileDesc t = tile_desc(p, w_in, w_pa, w_pb, w_o, u);
                if (!t.zero) {
#pragma unroll
                    for (int h = 0; h < 2; ++h) v[j][h] = *(const f32x4*)(t.src + (size_t)(t.k0 + r + 32 * h) * t.ld_src + t.n0src + 4 * c4); } } }
#pragma unroll
        for (int j = 0; j < 4; ++j) { LAS float* tile = (LAS float*)(lds + j * 16640);
#pragma unroll
            for (int h = 0; h < 2; ++h)
#pragma unroll
                for (int i = 0; i < 4; ++i) tile[(r + 32 * h) * 65 + 4 * c4 + i] = v[j][h][i]; }
        __syncthreads();
#pragma unroll
        for (int j = 0; j < 4; ++j) { const int u = u0 + j;
            if (u < PRO_TILES) { const TileDesc t = tile_desc(p, w_in, w_pa, w_pb, w_o, u); const LAS float* tile = (const LAS float*)(lds + j * 16640); float f[8];
#pragma unroll
                for (int i = 0; i < 8; ++i) f[i] = tile[(8 * k8 + i) * 65 + n];
                *(u32x4*)(t.dst + (size_t)(t.n0dst + n) * t.ld_dst + t.k0 + 8 * k8) = (u32x4){pk2(f[0], f[1]), pk2(f[2], f[3]), pk2(f[4], f[5]), pk2(f[6], f[7])}; } }
        __syncthreads();
}
__device__ __forceinline__ void ph_prologue(const Params& p, LAS unsigned char* lds, int bid, int nb) {
    const int tid = tidx(), r = tid >> 4, c4 = tid & 15, n = tid >> 3, k8 = tid & 7;
    const float *w_in = p.w_in, *w_pa = p.w_proj_a, *w_pb = p.w_proj_b, *w_o = p.w_out;
    asm volatile("" : "+s"(w_in), "+s"(w_pa), "+s"(w_pb), "+s"(w_o));
    const int ulim = nb == 256 ? PRO_TILES1 : PRO_TILES;
    for (int u0 = bid * 4; u0 < ulim; u0 += nb * 4) pro_tiles4(p, lds, u0, tid, w_in, w_pa, w_pb, w_o);
    const int lane = tid & 63, gw = __builtin_amdgcn_readfirstlane(tid >> 6) * nb + bid, nw = nb * 8;
    for (int row = gw; row < MP; row += nw) {
        bf16_t* xn = (bf16_t*)(p.ws + WS_XN) + (size_t)row * DM;
        if (row < MR) { const float* xr = row < SEQ ? p.x_prompt + (size_t)row * DM : p.x_sample + (size_t)(row - SEQ) * DM;
            f32x4 v[8]; float ss = 0.f;
#pragma unroll
            for (int i = 0; i < 8; ++i) { v[i] = *(const f32x4*)(xr + i * 256 + lane * 4); ss += v[i][0] * v[i][0] + v[i][1] * v[i][1] + v[i][2] * v[i][2] + v[i][3] * v[i][3]; }
            ss = wave_sum(ss); const float rr = rsqrtf(ss * (1.f / DM) + EPS);
#pragma unroll
            for (int i = 0; i < 8; ++i) { const f32x4 w = *(const f32x4*)(p.ln_in + i * 256 + lane * 4);
                *(u32x2*)(xn + i * 256 + lane * 4) = (u32x2){pk2(v[i][0] * rr * w[0], v[i][1] * rr * w[1]), pk2(v[i][2] * rr * w[2], v[i][3] * rr * w[3])}; }
        } else {
#pragma unroll
            for (int i = 0; i < 8; ++i) *(u32x2*)(xn + i * 256 + lane * 4) = (u32x2){0u, 0u};
            bf16_t* oa = (bf16_t*)(p.ws + WS_OA) + (size_t)row * 4096; bf16_t* ob = (bf16_t*)(p.ws + WS_OB) + (size_t)row * 1024;
#pragma unroll
            for (int i = 0; i < 16; ++i) *(u32x2*)(oa + i * 256 + lane * 4) = (u32x2){0u, 0u};
#pragma unroll
            for (int i = 0; i < 4; ++i) *(u32x2*)(ob + i * 256 + lane * 4) = (u32x2){0u, 0u};
        }
    }
}

template <int WIN> __device__ __forceinline__ void kvcopy_one(const float* cache, float* dst, int cb, int ncb, int tid) {
    constexpr int NR = 32 * (WIN - 4);
    f32x4 va[12], vb[12];
#define KV_ROWS(R0_, src_, dst_) do { _Pragma("unroll") for (int k = 0; k < 12; ++k) { int R = (R0_) + k * ncb; R = R < NR ? R : NR - 1; const int b = R / (WIN - 4), j = R - b * (WIN - 4); \
        src_[k] = cache + ((size_t)(b * WIN + j + 4) * 512 + tid) * 4; dst_[k] = dst + ((size_t)(b * WIN + j) * 512 + tid) * 4; } } while (0)
    const float* sa[12]; float* da[12]; const float* sb[12]; float* db[12];
    int R0 = cb;
    KV_ROWS(R0, sa, da);
#pragma unroll
    for (int k = 0; k < 12; ++k) va[k] = *(const f32x4*)sa[k];
    for (; R0 < NR; R0 += 24 * ncb) {
        KV_ROWS(R0 + 12 * ncb, sb, db);
#pragma unroll
        for (int k = 0; k < 12; ++k) vb[k] = *(const f32x4*)sb[k];
#pragma unroll
        for (int k = 0; k < 12; ++k) *(f32x4*)da[k] = va[k];
        KV_ROWS(R0 + 24 * ncb, sa, da);
#pragma unroll
        for (int k = 0; k < 12; ++k) va[k] = *(const f32x4*)sa[k];
#pragma unroll
        for (int k = 0; k < 12; ++k) *(f32x4*)db[k] = vb[k];
    }
#undef KV_ROWS
}
__device__ __forceinline__ void ph_kvcopy(const Params& p, int cb, int ncb) {
    const int tid = tidx();
    kvcopy_one<128>(p.c128, p.out + O_KV128S, cb, ncb, tid);
    kvcopy_one<512>(p.c512, p.out + O_KV512S, cb, ncb, tid);
    kvcopy_one<2048>(p.c2048, p.out + O_KV2048S, cb, ncb, tid);
}

__device__ __forceinline__ void ph_prep(const Params& p, int bid, int nb) {
    const bf16_t* P = (const bf16_t*)(p.ws + WS_P); bf16_t* CV = (bf16_t*)(p.ws + WS_CV);
    const float* BA = (const float*)(p.ws + WS_BA); float* BG = (float*)(p.ws + WS_BG);
    const int tid = tidx(), lane = tid & 63, gw = __builtin_amdgcn_readfirstlane(tid >> 6) * nb + bid, nw = nb * 8;
    const float *pc128 = p.c128, *pc512 = p.c512, *pc2048 = p.c2048;
    asm volatile("" : "+s"(pc128), "+s"(pc512), "+s"(pc2048));
    for (int task0 = gw; task0 < NSAMP * 64; task0 += 4 * nw) {
        float x0[4][4], x1[4][4]; f32x2 w[4][4];
#pragma unroll
        for (int u = 0; u < 4; ++u) { const int task = task0 + u * nw;
            if (task < NSAMP * 64) { const int row = SEQ + (task >> 6), seg = task & 63, c = seg * 128 + 2 * lane, b = (row - SEQ) >> 2, t = (row - SEQ) & 3;
#pragma unroll
                for (int i = 0; i < 4; ++i) { w[u][i] = *(const f32x2*)(p.conv_w + i * 8192 + c); const int j = t + i;
                    if (j < 3) { const f32x2 sv = *(const f32x2*)(p.state_conv + ((size_t)b * 3 + j) * 8192 + c); x0[u][i] = sv[0]; x1[u][i] = sv[1]; }
                    else { const unsigned q = *(const unsigned*)(P + (size_t)(SEQ + 4 * b + j - 3) * NP + c); x0[u][i] = bflo(q); x1[u][i] = bfhi(q); } } } }
#pragma unroll
        for (int u = 0; u < 4; ++u) { const int task = task0 + u * nw;
            if (task < NSAMP * 64) { const int row = SEQ + (task >> 6), seg = task & 63, c = seg * 128 + 2 * lane;
                float y0 = 0.f, y1 = 0.f;
#pragma unroll
                for (int i = 0; i < 4; ++i) { y0 += x0[u][i] * w[u][i][0]; y1 += x1[u][i] * w[u][i][1]; }
                y0 = siluf_(y0); y1 = siluf_(y1);
                if (seg < 32) { const float ss = wave_sum(y0 * y0 + y1 * y1); float r = rsqrtf(ss + EPS); if (seg < 16) r *= 0.08838834764831845f; y0 *= r; y1 *= r; }
                *(unsigned*)(CV + (size_t)row * 8192 + c) = pk2(y0, y1); } }
    }
    for (int i = SEQ * 32 + bid * 512 + tid; i < MR * 32; i += nb * 512) { const int row = i >> 5, h = i & 31;
        const float b = BA[(size_t)row * 64 + h], a = BA[(size_t)row * 64 + 32 + h] + p.dt_bias[h];
        const float sp = a > 20.f ? a : log1pf(expf(a));
        BG[(size_t)row * 64 + h] = 1.f / (1.f + expf(-b)); BG[(size_t)row * 64 + 32 + h] = -expf(p.a_log[h]) * sp; }
    for (int i = bid * 512 + tid; i < 3 * 8192; i += nb * 512) { const int r = i >> 13, c = i & 8191; p.out[O_CONVP + i] = bf2f(P[(size_t)(SEQ - 3 + r) * NP + c]); }
    for (int i = bid * 512 + tid; i < 32 * 3 * 8192; i += nb * 512) { const int c = i & 8191, r = (i >> 13) % 3, b = i / (3 * 8192); p.out[O_CONVS + i] = bf2f(P[(size_t)(SEQ + 4 * b + 1 + r) * NP + c]); }
    { const bf16_t* QKVC = (const bf16_t*)(p.ws + WS_QKVC); const bf16_t* PS = (const bf16_t*)(p.ws + WS_PS);
      constexpr int RP = 128 + 512 + 2048, NT = 2 * RP + 2 * 32 * 12;
      for (int task = gw; task < NT; task += nw) {
        const int half = task & 1; int r = task >> 1; float* dst;
        if (r < RP) { int g, win, j; size_t ob; if (r < 128) { g = 0; win = 128; j = r; ob = O_KV128P; } else if (r < 640) { g = 1; win = 512; j = r - 128; ob = O_KV512P; } else { g = 2; win = 2048; j = r - 640; ob = O_KV2048P; }
            dst = p.out + ob + (size_t)j * 2048 + half * 1024; const int tok = SEQ - win + j;
#pragma unroll
            for (int i = 0; i < 4; ++i) { const int e = i * 256 + lane * 4, h = e >> 7; const u32x2 u = *(const u32x2*)(QKVC + qkvc_row(1 + half, g, h, tok) + (e & 127)); *(f32x4*)(dst + e) = (f32x4){bflo(u[0]), bfhi(u[0]), bflo(u[1]), bfhi(u[1])}; }
        } else { r -= RP; const int b = r / 12, q = r % 12, g = q >> 2, t = q & 3, win = g == 0 ? 128 : (g == 1 ? 512 : 2048); const size_t ob = g == 0 ? O_KV128S : (g == 1 ? O_KV512S : O_KV2048S);
            dst = p.out + ob + ((size_t)b * win + (win - 4 + t)) * 2048 + half * 1024; const bf16_t* srcb = PS + (size_t)(4 * b + t) * 9216 + (1 + half) * 3072 + g * 1024;
#pragma unroll
            for (int i = 0; i < 4; ++i) { const u32x2 u = *(const u32x2*)(srcb + i * 256 + lane * 4); *(f32x4*)(dst + i * 256 + lane * 4) = (f32x4){bflo(u[0]), bfhi(u[0]), bflo(u[1]), bfhi(u[1])}; }
        }
      } }
}

__device__ __forceinline__ float dq_sum(float v) { v += __shfl_xor(v, 16); v += __shfl_xor(v, 32); return v; }
__device__ __forceinline__ void delta_rec_sample_task(const Params& p, int task, int lane) {
    asm volatile("" : "+v"(lane));
    const bf16_t* CV = (const bf16_t*)(p.ws + WS_CV); const float* BG = (const float*)(p.ws + WS_BG); bf16_t* OA = (bf16_t*)(p.ws + WS_OA);
    const int b = task >> 6, hv = (task >> 1) & 31, half = task & 1, cg = lane & 15, dq = lane >> 4, hk = hv >> 1, e0 = 64 * half + 4 * cg;
    const float* sin = p.state_delta + ((size_t)b * 32 + hv) * 16384 + (size_t)(dq * 32) * 128 + e0;
    float* sout = p.out + O_DELTAS + ((size_t)b * 32 + hv) * 16384 + (size_t)(dq * 32) * 128 + e0;
    f32x4 s[32];
#pragma unroll
    for (int i = 0; i < 32; ++i) s[i] = *(const f32x4*)(sin + (size_t)i * 128);
#pragma unroll 1
    for (int t = 0; t < 4; ++t) {
        const size_t row = (size_t)(SEQ + 4 * b + t);
        const bf16_t* kp = CV + row * 8192 + C_KA + hk * 128 + dq * 32; const bf16_t* qp = CV + row * 8192 + C_QA + hk * 128 + dq * 32;
        u32x4 kk[4], qq[4];
#pragma unroll
        for (int i = 0; i < 4; ++i) { kk[i] = *(const u32x4*)(kp + 8 * i); qq[i] = *(const u32x4*)(qp + 8 * i); }
        const u32x2 vv = *(const u32x2*)(CV + row * 8192 + C_VA + hv * 128 + e0);
        const float beta = BG[row * 64 + hv], eg = expf(BG[row * 64 + 32 + hv]);
        f32x4 dot = (f32x4){0.f, 0.f, 0.f, 0.f};
#pragma unroll
        for (int i = 0; i < 16; ++i) { const float k0 = bflo(kk[i >> 2][i & 3]), k1 = bfhi(kk[i >> 2][i & 3]); s[2 * i] *= eg; s[2 * i + 1] *= eg; dot += s[2 * i] * k0 + s[2 * i + 1] * k1; }
#pragma unroll
        for (int c = 0; c < 4; ++c) dot[c] = dq_sum(dot[c]);
        const f32x4 vn = ((f32x4){bflo(vv[0]), bfhi(vv[0]), bflo(vv[1]), bfhi(vv[1])} - dot) * beta;
        f32x4 o = (f32x4){0.f, 0.f, 0.f, 0.f};
#pragma unroll
        for (int i = 0; i < 16; ++i) { const float k0 = bflo(kk[i >> 2][i & 3]), k1 = bfhi(kk[i >> 2][i & 3]), q0 = bflo(qq[i >> 2][i & 3]), q1 = bfhi(qq[i >> 2][i & 3]);
            s[2 * i] += vn * k0; s[2 * i + 1] += vn * k1; o += s[2 * i] * q0 + s[2 * i + 1] * q1; }
#pragma unroll
        for (int c = 0; c < 4; ++c) o[c] = dq_sum(o[c]);
        if (dq == 0) *(u32x2*)(OA + row * 4096 + hv * 128 + e0) = (u32x2){pk2(o[0], o[1]), pk2(o[2], o[3])};
    }
#pragma unroll
    for (int i = 0; i < 32; ++i) *(f32x4*)(sout + (size_t)i * 128) = s[i];
}
__device__ __forceinline__ void ph_delta_rec_sample(const Params& p, int bid, int nb) {
    const int tid = tidx(), lane = tid & 63, gw = __builtin_amdgcn_readfirstlane(tid >> 6) * nb + bid, nw = nb * 8;
    for (int task = gw; task < 32 * 32 * 2; task += nw) delta_rec_sample_task(p, task, lane);
}

typedef short s16x4 __attribute__((ext_vector_type(4)));
typedef float f32x16 __attribute__((ext_vector_type(16)));
__device__ __forceinline__ unsigned off_b(unsigned row, unsigned ch) { return 256u * row + 16u * (ch ^ (((row & 3) << 2) | ((row >> 2) & 3))); }
__device__ __forceinline__ unsigned tr_read_addr(unsigned lane, unsigned c, unsigned ks, unsigned t) {
    const unsigned h = lane >> 5, blk = (lane >> 4) & 1, q = (lane & 15) >> 2, p = lane & 3;
    return off_b(16 * ks + 8 * h + 4 * t + q, 4 * c + 2 * blk + (p >> 1)) + 8 * (p & 1);
}
__device__ __forceinline__ s16x4 lds_tr(LAS unsigned char* p) { return __builtin_bit_cast(s16x4, __builtin_amdgcn_ds_read_tr16_b64_v4i16((LAS s16x4*)p)); }
__device__ __forceinline__ bf16x8 cat8(s16x4 a, s16x4 b) { return (bf16x8){a[0], a[1], a[2], a[3], b[0], b[1], b[2], b[3]}; }
__device__ __forceinline__ unsigned cvtpk(float lo, float hi) { return pk2(lo, hi); }
__device__ __forceinline__ int afrag_off(int row, int col, int nkb) { return ((row >> 4) * nkb + (col >> 5)) * 512 + (16 * ((col >> 2) & 3) + (row & 15)) * 8 + 4 * ((col >> 4) & 1) + (col & 3); }
__device__ __forceinline__ int u_off(int c, int e) { return ((e >> 4) * 64 + 16 * ((c >> 2) & 3) + (e & 15)) * 8 + (c >> 4) * 4 + (c & 3); }
__device__ __forceinline__ float rdlane(float v, int l) { return __int_as_float(__builtin_amdgcn_readlane(__float_as_int(v), l)); }
#define LDS_WAIT() asm volatile("s_waitcnt lgkmcnt(0)" ::: "memory")

#define DPPF(v, ctrl) __int_as_float(__builtin_amdgcn_update_dpp(0, __float_as_int(v), (ctrl), 0xF, 0xF, true))
__device__ __forceinline__ float row16_sum(float v) {
    v += DPPF(v, 0xB1);
    v += DPPF(v, 0x4E);
    v += DPPF(v, 0x141);
    v += DPPF(v, 0x140);
    return v;
}
__device__ __forceinline__ float scan32_incl(float v) {
    v += DPPF(v, 0x111); v += DPPF(v, 0x112); v += DPPF(v, 0x114); v += DPPF(v, 0x118);
    v += __int_as_float(__builtin_amdgcn_update_dpp(0, __float_as_int(v), 0x142, 0xA, 0xF, true));
    return v;
}
__device__ __forceinline__ void conv_load(const Params& p, size_t row0, int col0, int lane, u32x4 (&x)[11]) {
    asm volatile("" : "+v"(lane));
    const bf16_t* P = (const bf16_t*)(p.ws + WS_P); const int cg = lane & 15, rg = lane >> 4, cv = col0 + 8 * cg;
#pragma unroll
    for (int i = 0; i < 11; ++i) { const long r = (long)row0 + 8 * rg - 3 + i; x[i] = r >= 0 ? *(const u32x4*)(P + (size_t)r * NP + cv) : (u32x4){0u, 0u, 0u, 0u}; }
}
template <int MODE> __device__ __forceinline__ void conv_comp(const Params& p, int col0, const u32x4 (&x)[11], LAS unsigned char* ldst, int lane) {
    asm volatile("" : "+v"(lane));
    const int cg = lane & 15, rg = lane >> 4, cv = col0 + 8 * cg;
    f32x4 w[4][2];
#pragma unroll
    for (int i = 0; i < 4; ++i) { w[i][0] = *(const f32x4*)(p.conv_w + i * 8192 + cv); w[i][1] = *(const f32x4*)(p.conv_w + i * 8192 + cv + 4); }
#pragma unroll
    for (int r = 0; r < 8; ++r) { float y[8];
#pragma unroll
        for (int e = 0; e < 8; ++e) y[e] = 0.f;
#pragma unroll
        for (int t = 0; t < 4; ++t)
#pragma unroll
            for (int q = 0; q < 4; ++q) { y[2 * q] += bflo(x[r + t][q]) * w[t][q >> 1][(2 * q) & 3]; y[2 * q + 1] += bfhi(x[r + t][q]) * w[t][q >> 1][(2 * q + 1) & 3]; }
        float ss = 0.f;
#pragma unroll
        for (int e = 0; e < 8; ++e) { y[e] = siluf_(y[e]); ss += y[e] * y[e]; }
        if (MODE != 0) { ss = row16_sum(ss);
            const float rs = rsqrtf(ss + EPS) * (MODE == 2 ? 0.08838834764831845f : 1.f);
#pragma unroll
            for (int e = 0; e < 8; ++e) y[e] *= rs; }
        *(LAS u32x4*)(ldst + off_b(8 * rg + r, cg)) = (u32x4){pk2(y[0], y[1]), pk2(y[2], y[3]), pk2(y[4], y[5]), pk2(y[6], y[7])}; }
}
struct HeadSc { float beta, G, eG, ekd; };
__device__ __forceinline__ void sa_head1(const Params& p, int n, int hv, float braw, float araw0, const LAS unsigned char* ldq, LAS float* sc, const f32x16& KKr, const f32x16& QKr, f32x16& L, HeadSc& hs, int lane) {
    asm volatile("" : "+v"(lane));
    unsigned char* rec = p.ws + WS_REC + ((size_t)hv * NCHUNK + n) * RECB;
    const int t = lane & 31, hi = lane >> 5;
    const float araw = araw0 + p.dt_bias[hv];
    const float beta = 1.f / (1.f + expf(-braw)); float G = -expf(p.a_log[hv]) * (araw > 20.f ? araw : log1pf(expf(araw)));
    G = scan32_incl(G);
    const float Glast = rdlane(G, 31), eG = expf(G), ekd = expf(Glast - G);
    if (lane < 32) { sc[t] = G; sc[32 + t] = beta; sc[64 + t] = eG; sc[96 + t] = ekd;
        *(float*)(rec + REC_GL + 4 * t) = eG; *(float*)(rec + REC_GL + 128 + 4 * t) = ekd; }
    hs.beta = beta; hs.G = G; hs.eG = eG; hs.ekd = ekd;
    {
        bf16_t* INf = (bf16_t*)(rec + REC_IN);
        unsigned ipk[4][2];
#pragma unroll
        for (int xg = 0; xg < 4; ++xg) { const f32x4 Gr = *(const LAS f32x4*)(sc + 8 * xg + 4 * hi), Br = *(const LAS f32x4*)(sc + 32 + 8 * xg + 4 * hi); float iv[4];
#pragma unroll
            for (int b = 0; b < 4; ++b) { const int r = 8 * xg + 4 * hi + b;
                L[4 * xg + b] = (t < r) ? Br[b] * KKr[4 * xg + b] * __expf(Gr[b] - G) : 0.f;
                iv[b] = (r <= t) ? QKr[4 * xg + b] * __expf(G - Gr[b]) : 0.f; }
            ipk[xg][0] = cvtpk(iv[0], iv[1]); ipk[xg][1] = cvtpk(iv[2], iv[3]); }
#pragma unroll
        for (int xg = 0; xg < 2; ++xg) *(u32x4*)(INf + afrag_off(t, 8 * xg + 4 * hi, 1)) = (u32x4){ipk[xg][0], ipk[xg][1], ipk[xg + 2][0], ipk[xg + 2][1]};
    }
}
__device__ __forceinline__ void sa_head2(const Params& p, int n, int hv, LAS unsigned char* ldk, LAS unsigned char* lds2, const LAS float* sc, const f32x16& Lacc, const HeadSc& hs, int lane) {
    asm volatile("" : "+v"(lane));
    unsigned char* rec = p.ws + WS_REC + ((size_t)hv * NCHUNK + n) * RECB;
    const int t = lane & 31, hi = lane >> 5; const size_t row0 = (size_t)n * CH;
    u32x4 xv[11]; conv_load(p, row0, C_VA + hv * 128, lane, xv);
    __builtin_amdgcn_sched_barrier(0);
    float T[32];
#pragma unroll
    for (int j = 31; j >= 0; --j) { float a = (t == j) ? 1.f : 0.f;
#pragma unroll
        for (int kk = j + 1; kk < 32; ++kk) a -= T[kk] * rdlane(Lacc[(kk & 3) + 4 * (kk >> 3)], j + 32 * ((kk >> 2) & 1));
        T[j] = a; }
    unsigned P2[16], P3[16];
#pragma unroll
    for (int m = 0; m < 16; ++m) { const float b0 = rdlane(hs.beta, 2 * m), b1 = rdlane(hs.beta, 2 * m + 1), e0 = rdlane(hs.eG, 2 * m), e1 = rdlane(hs.eG, 2 * m + 1);
        P3[m] = cvtpk(T[2 * m] * b0, T[2 * m + 1] * b1); P2[m] = cvtpk(T[2 * m] * b0 * e0, T[2 * m + 1] * b1 * e1); }
    bf16x8 F2[2], F3[2];
#pragma unroll
    for (int ks = 0; ks < 2; ++ks) { u32x4 a, b;
#pragma unroll
        for (int i = 0; i < 4; ++i) { a[i] = hi ? P2[8 * ks + 4 + i] : P2[8 * ks + i]; b[i] = hi ? P3[8 * ks + 4 + i] : P3[8 * ks + i]; }
        F2[ks] = __builtin_bit_cast(bf16x8, a); F3[ks] = __builtin_bit_cast(bf16x8, b); }
    { bf16_t* Wf = (bf16_t*)(rec + REC_W);
#pragma unroll
      for (int mt = 0; mt < 4; ++mt) { f32x16 acc;
#pragma unroll
          for (int x = 0; x < 16; ++x) acc[x] = 0.f;
#pragma unroll
          for (int ks = 0; ks < 2; ++ks) acc = __builtin_amdgcn_mfma_f32_32x32x16_bf16(cat8(lds_tr(ldk + tr_read_addr(lane, mt, ks, 0)), lds_tr(ldk + tr_read_addr(lane, mt, ks, 1))), F2[ks], acc, 0, 0, 0);
#pragma unroll
          for (int xg = 0; xg < 2; ++xg) *(u32x4*)(Wf + afrag_off(t, 32 * mt + 8 * xg + 4 * hi, 4)) = (u32x4){cvtpk(-acc[4 * xg], -acc[4 * xg + 1]), cvtpk(-acc[4 * xg + 2], -acc[4 * xg + 3]), cvtpk(-acc[4 * xg + 8], -acc[4 * xg + 9]), cvtpk(-acc[4 * xg + 10], -acc[4 * xg + 11])}; } }
    LDS_WAIT();
    conv_comp<0>(p, C_VA + hv * 128, xv, lds2, lane);
    LDS_WAIT();
    { bf16_t* Uf = (bf16_t*)(rec + REC_U);
#pragma unroll
      for (int nt = 0; nt < 4; ++nt) { f32x16 acc;
#pragma unroll
          for (int x = 0; x < 16; ++x) acc[x] = 0.f;
#pragma unroll
          for (int ks = 0; ks < 2; ++ks) acc = __builtin_amdgcn_mfma_f32_32x32x16_bf16(F3[ks], cat8(lds_tr(lds2 + tr_read_addr(lane, nt, ks, 0)), lds_tr(lds2 + tr_read_addr(lane, nt, ks, 1))), acc, 0, 0, 0);
#pragma unroll
          for (int xg = 0; xg < 2; ++xg) *(u32x4*)(Uf + u_off(8 * xg + 4 * hi, 32 * nt + t)) = (u32x4){cvtpk(acc[4 * xg], acc[4 * xg + 1]), cvtpk(acc[4 * xg + 2], acc[4 * xg + 3]), cvtpk(acc[4 * xg + 8], acc[4 * xg + 9]), cvtpk(acc[4 * xg + 10], acc[4 * xg + 11])}; } }
    LDS_WAIT();
}
__device__ __forceinline__ void stage_a_unit(const Params& p, int n, int hk, LAS unsigned char* ldsw, int lane) {
    asm volatile("" : "+v"(lane));
    LAS unsigned char* ldk = ldsw; LAS float* sc0 = (LAS float*)(ldsw + 8192); LAS float* sc1 = (LAS float*)(ldsw + 8704); LAS unsigned char* ldq = ldsw + 9216;
    const int t = lane & 31, hi = lane >> 5; const size_t row0 = (size_t)n * CH;
    float braw[2], araw[2];
    { u32x4 xk[11], xq[11]; conv_load(p, row0, C_KA + hk * 128, lane, xk); conv_load(p, row0, C_QA + hk * 128, lane, xq);
      const float* BA = (const float*)(p.ws + WS_BA) + (row0 + t) * 64 + 2 * hk;
      braw[0] = BA[0]; braw[1] = BA[1]; araw[0] = BA[32]; araw[1] = BA[33];
      __builtin_amdgcn_sched_barrier(0);
      conv_comp<1>(p, C_KA + hk * 128, xk, ldk, lane);
      conv_comp<2>(p, C_QA + hk * 128, xq, ldq, lane); }
    LDS_WAIT();
    f32x16 KKr, QKr;
#pragma unroll
    for (int x = 0; x < 16; ++x) { KKr[x] = 0.f; QKr[x] = 0.f; }
#pragma unroll
    for (int s = 0; s < 8; ++s) { const bf16x8 kf = *(const LAS bf16x8*)(ldk + off_b(t, 2 * s + hi)), qf = *(const LAS bf16x8*)(ldq + off_b(t, 2 * s + hi));
        KKr = __builtin_amdgcn_mfma_f32_32x32x16_bf16(kf, kf, KKr, 0, 0, 0); QKr = __builtin_amdgcn_mfma_f32_32x32x16_bf16(kf, qf, QKr, 0, 0, 0); }
    { unsigned char* reck = p.ws + WS_REC + ((size_t)(2 * hk) * NCHUNK + n) * RECB;
      { const int rr = lane & 15, qq = lane >> 4;
#pragma unroll
        for (int ct = 0; ct < 2; ++ct) { const int c = 16 * ct + rr;
#pragma unroll
            for (int kb = 0; kb < 4; ++kb) { const u32x2 a = *(const LAS u32x2*)(ldq + off_b(c, 4 * kb + (qq >> 1)) + 8 * (qq & 1)), b = *(const LAS u32x2*)(ldq + off_b(c, 4 * kb + 2 + (qq >> 1)) + 8 * (qq & 1));
                *(u32x4*)(reck + REC_QG + (ct * 4 + kb) * 1024 + lane * 16) = (u32x4){a[0], a[1], b[0], b[1]}; } } }
      { const unsigned qg = lane >> 4, qq = (lane & 15) >> 2, pp = lane & 3;
#pragma unroll
        for (int dt = 0; dt < 8; ++dt) { const s16x4 a0 = lds_tr(ldk + off_b(4 * qg + qq, 2 * dt + (pp >> 1)) + 8 * (pp & 1)), a1 = lds_tr(ldk + off_b(16 + 4 * qg + qq, 2 * dt + (pp >> 1)) + 8 * (pp & 1));
            *(bf16x8*)(reck + REC_KD + dt * 1024 + lane * 16) = cat8(a0, a1); } } }
    f32x16 L0, L1; HeadSc h0, h1;
    sa_head1(p, n, 2 * hk, braw[0], araw[0], ldq, sc0, KKr, QKr, L0, h0, lane);
    sa_head1(p, n, 2 * hk + 1, braw[1], araw[1], ldq, sc1, KKr, QKr, L1, h1, lane);
    sa_head2(p, n, 2 * hk, ldk, ldq, sc0, L0, h0, lane);
    sa_head2(p, n, 2 * hk + 1, ldk, ldq, sc1, L1, h1, lane);
}
__device__ __forceinline__ void ph_stage_a(const Params& p, LAS unsigned char* lds, int bid, int nb) {
    const int lane = tidx() & 63, wid = __builtin_amdgcn_readfirstlane(tidx() >> 6), gw = wid * nb + bid, nw = nb * 8;
    LAS unsigned char* ldsw = lds + wid * 17408;
    for (int task = gw; task < NCHUNK * 16; task += nw) stage_a_unit(p, NCHUNK - 1 - (task >> 4), task & 15, ldsw, lane);
}

constexpr int SCAN_WGS = 64, SCAN_OST = 4 * REC_DMA;
__device__ __forceinline__ void ph_scan(const Params& p, LAS unsigned char* lds, int bid) {
    const int tid = tidx(), lane = tid & 63, wid = __builtin_amdgcn_readfirstlane(tid >> 6), hv = 4 * (bid & 7) + ((bid >> 4) & 2) + ((bid >> 4) & 1), half = (bid >> 3) & 1;
    const unsigned char* rec0 = p.ws + WS_REC + (size_t)hv * NCHUNK * RECB; constexpr size_t RSTR = (size_t)RECB;
    if (wid >= 4) {
        const int lw = wid - 4;
        bf16_t* OA = (bf16_t*)(p.ws + WS_OA) + (size_t)(8 * lw + (lane >> 3)) * 4096 + hv * 128 + half * 64 + (lane & 7) * 8;
        const LAS unsigned char* ost = lds + SCAN_OST + (8 * lw + (lane >> 3)) * 128 + (lane & 7) * 16;
        int poff[8], loff[8];
        const int kdelta = -(hv & 1) * (int)(NCHUNK * RECB);
#pragma unroll
        for (int i = 0; i < 8; ++i) { const int idx = lw * 8 + i; loff[i] = idx < 26 ? idx * 1024 : (idx < 30 ? REC_U + (4 * half + idx - 26) * 1024 : REC_GL);
            poff[i] = loff[i] + (((idx >= 8 && idx < 16) || (idx >= 18 && idx < 26)) ? kdelta : 0); }
#define SCAN_DMA(n_) do { const int nn_ = (n_) < NCHUNK ? (n_) : NCHUNK - 1; const unsigned char* src_ = rec0 + (size_t)nn_ * RSTR + lane * 16; LAS unsigned char* dst_ = lds + ((n_) & 3) * REC_DMA; \
        _Pragma("unroll") for (int i_ = 0; i_ < 8; ++i_) __builtin_amdgcn_global_load_lds((const unsigned*)(src_ + poff[i_]), (LAS unsigned*)(dst_ + loff[i_]), 16, 0, 0); } while (0)
        SCAN_DMA(0); SCAN_DMA(1); SCAN_DMA(2);
        asm volatile("s_waitcnt vmcnt(16)" ::: "memory");
        __builtin_amdgcn_s_barrier();
        asm volatile("" ::: "memory");
        SCAN_DMA(3);
#define SCAN_STEP(n_, W_) do { asm volatile("s_waitcnt vmcnt(" #W_ ")" ::: "memory"); __builtin_amdgcn_s_barrier(); asm volatile("" ::: "memory"); \
        const u32x4 ov_ = *(const LAS u32x4*)(ost + (((n_) - 1) & 1) * 4096); *(u32x4*)(OA + (size_t)((n_) - 1) * CH * 4096) = ov_; SCAN_DMA((n_) + 3); } while (0)
        SCAN_STEP(1, 16); SCAN_STEP(2, 17);
        for (int n = 3; n < NCHUNK; ++n) SCAN_STEP(n, 18);
#undef SCAN_STEP
        asm volatile("" ::: "memory"); __builtin_amdgcn_s_barrier(); asm volatile("" ::: "memory");
        { const u32x4 ov = *(const LAS u32x4*)(ost + ((NCHUNK - 1) & 1) * 4096); *(u32x4*)(OA + (size_t)(NCHUNK - 1) * CH * 4096) = ov; }
        asm volatile("s_waitcnt vmcnt(0)" ::: "memory");
#undef SCAN_DMA
    } else {
        const int sl = half * 4 + wid, el = lane & 15, q4 = lane >> 4;
        LAS bf16_t* ost = (LAS bf16_t*)(lds + SCAN_OST) + (4 * q4) * 64 + wid * 16 + el;
        f32x4 S[8];
#pragma unroll
        for (int dt = 0; dt < 8; ++dt) S[dt] = (f32x4){0.f, 0.f, 0.f, 0.f};
        for (int n = 0; n < NCHUNK; ++n) {
            asm volatile("s_waitcnt lgkmcnt(0)" ::: "memory"); __builtin_amdgcn_s_barrier(); asm volatile("" ::: "memory");
            LAS unsigned char* buf = lds + (n & 3) * REC_DMA;
            const LAS unsigned char* fl = buf + lane * 16;
            bf16x8 Wf[8], QGf[8], KDf[8], INf[2];
#pragma unroll
            for (int f = 0; f < 8; ++f) { Wf[f] = *(const LAS bf16x8*)(fl + REC_W + f * 1024); QGf[f] = *(const LAS bf16x8*)(fl + REC_QG + f * 1024); }
            const u32x4 uu = *(const LAS u32x4*)(buf + REC_U + sl * 1024 + lane * 16);
            const float gl = *(const LAS float*)(buf + REC_GL + 124);
            f32x4 eGv[2], ekv[2];
#pragma unroll
            for (int ct = 0; ct < 2; ++ct) { eGv[ct] = *(const LAS f32x4*)(buf + REC_GL + (16 * ct + 4 * q4) * 4); ekv[ct] = *(const LAS f32x4*)(buf + REC_GL + 128 + (16 * ct + 4 * q4) * 4); }
#pragma unroll
            for (int f = 0; f < 8; ++f) KDf[f] = *(const LAS bf16x8*)(fl + REC_KD + f * 1024);
#pragma unroll
            for (int f = 0; f < 2; ++f) INf[f] = *(const LAS bf16x8*)(fl + REC_IN + f * 1024);
            bf16x8 Sf[4];
#pragma unroll
            for (int kb = 0; kb < 4; ++kb) { const u32x4 w = (u32x4){cvtpk(S[2 * kb][0], S[2 * kb][1]), cvtpk(S[2 * kb][2], S[2 * kb][3]), cvtpk(S[2 * kb + 1][0], S[2 * kb + 1][1]), cvtpk(S[2 * kb + 1][2], S[2 * kb + 1][3])}; Sf[kb] = __builtin_bit_cast(bf16x8, w); }
            __builtin_amdgcn_sched_barrier(0);
#pragma unroll
            for (int dt = 0; dt < 8; ++dt) S[dt] *= gl;
            f32x4 vn[2] = {(f32x4){bflo(uu[0]), bfhi(uu[0]), bflo(uu[1]), bfhi(uu[1])}, (f32x4){bflo(uu[2]), bfhi(uu[2]), bflo(uu[3]), bfhi(uu[3])}};
            f32x4 o[2] = {(f32x4){0.f, 0.f, 0.f, 0.f}, (f32x4){0.f, 0.f, 0.f, 0.f}};
#pragma unroll
            for (int ct = 0; ct < 2; ++ct)
#pragma unroll
                for (int kb = 0; kb < 4; ++kb) { vn[ct] = __builtin_amdgcn_mfma_f32_16x16x32_bf16(Wf[ct * 4 + kb], Sf[kb], vn[ct], 0, 0, 0);
                                                 o[ct] = __builtin_amdgcn_mfma_f32_16x16x32_bf16(QGf[ct * 4 + kb], Sf[kb], o[ct], 0, 0, 0); }
            const f32x4 vs0 = vn[0] * ekv[0], vs1 = vn[1] * ekv[1];
            const u32x4 vsw = (u32x4){cvtpk(vs0[0], vs0[1]), cvtpk(vs0[2], vs0[3]), cvtpk(vs1[0], vs1[1]), cvtpk(vs1[2], vs1[3])}; const bf16x8 VNsf = __builtin_bit_cast(bf16x8, vsw);
#pragma unroll
            for (int dt = 0; dt < 8; ++dt) S[dt] = __builtin_amdgcn_mfma_f32_16x16x32_bf16(KDf[dt], VNsf, S[dt], 0, 0, 0);
            const u32x4 vw = (u32x4){cvtpk(vn[0][0], vn[0][1]), cvtpk(vn[0][2], vn[0][3]), cvtpk(vn[1][0], vn[1][1]), cvtpk(vn[1][2], vn[1][3])}; const bf16x8 VNf = __builtin_bit_cast(bf16x8, vw);
            LAS bf16_t* os = ost + (n & 1) * 2048;
#pragma unroll
            for (int ct = 0; ct < 2; ++ct) { o[ct] = __builtin_amdgcn_mfma_f32_16x16x32_bf16(INf[ct], VNf, o[ct] * eGv[ct]  , 0, 0, 0);
#pragma unroll
                for (int r = 0; r < 4; r += 2) { const unsigned w = pk2(o[ct][r], o[ct][r + 1]); os[(16 * ct + r) * 64] = (bf16_t)w; os[(16 * ct + r + 1) * 64] = (bf16_t)(w >> 16); } }
        }
        asm volatile("s_waitcnt lgkmcnt(0)" ::: "memory"); __builtin_amdgcn_s_barrier(); asm volatile("" ::: "memory");
        float* so = p.out + O_DELTAP + (size_t)hv * 16384 + sl * 16 + el;
#pragma unroll
        for (int dt = 0; dt < 8; ++dt)
#pragma unroll
            for (int r = 0; r < 4; ++r) so[(size_t)(16 * dt + 4 * q4 + r) * 128] = S[dt][r];
    }
    __syncthreads();
}

__device__ __forceinline__ void attn_sample_task(const Params& p, int row, int h, int lane) {
    asm volatile("" : "+v"(lane));
    const bf16_t* P = (const bf16_t*)(p.ws + WS_P); const bf16_t* PS = (const bf16_t*)(p.ws + WS_PS); bf16_t* OB = (bf16_t*)(p.ws + WS_OB);
    const int sb = (row - SEQ) >> 2, st = (row - SEQ) & 3;
    float sc[3][3];
#pragma unroll
    for (int g = 0; g < 3; ++g) {
        const int dil = g == 0 ? 1 : (g == 1 ? 4 : 16), win = g == 0 ? 128 : (g == 1 ? 512 : 2048);
        const float* cache = g == 0 ? p.c128 : (g == 1 ? p.c512 : p.c2048);
        const bf16_t* qp = PS + (size_t)(row - SEQ) * 9216 + g * 1024 + h * 128;
#pragma unroll
        for (int sl = 0; sl < 3; ++sl) {
            const int j = lane + 64 * sl; float s = -1e30f;
            if (j <= 128) {
                const int idx = win + st - j * dil; float d = 0.f;
                if (idx >= win) { const bf16_t* kb = PS + (size_t)(4 * sb + idx - win) * 9216 + 3072 + g * 1024 + h * 128;
#pragma unroll 1
                    for (int i0 = 0; i0 < 16; i0 += 4) {
#pragma unroll
                        for (int i = i0; i < i0 + 4; ++i) { const u32x4 k = *(const u32x4*)(kb + 8 * i), q = *(const u32x4*)(qp + 8 * i);
#pragma unroll
                            for (int w = 0; w < 4; ++w) d += bflo(q[w]) * bflo(k[w]) + bfhi(q[w]) * bfhi(k[w]); } }
                } else { const float* kf = cache + (((size_t)sb * win + idx) * 2 + 0) * 1024 + h * 128;
#pragma unroll 1
                    for (int i0 = 0; i0 < 16; i0 += 8) {
#pragma unroll
                        for (int i = i0; i < i0 + 8; ++i) { const f32x4 k0 = *(const f32x4*)(kf + 8 * i), k1 = *(const f32x4*)(kf + 8 * i + 4); const u32x4 q = *(const u32x4*)(qp + 8 * i);
                            d += bflo(q[0]) * k0[0] + bfhi(q[0]) * k0[1] + bflo(q[1]) * k0[2] + bfhi(q[1]) * k0[3] + bflo(q[2]) * k1[0] + bfhi(q[2]) * k1[1] + bflo(q[3]) * k1[2] + bfhi(q[3]) * k1[3]; } }
                }
                s = d * 0.08838834764831845f;
            }
            sc[g][sl] = s;
        }
        __builtin_amdgcn_sched_barrier(0);
    }
    float mx = -1e30f;
#pragma unroll
    for (int g = 0; g < 3; ++g)
#pragma unroll
        for (int sl = 0; sl < 3; ++sl) mx = fmaxf(mx, sc[g][sl]);
    mx = wave_max(mx);
    float ls = 0.f;
#pragma unroll
    for (int g = 0; g < 3; ++g)
#pragma unroll
        for (int sl = 0; sl < 3; ++sl) { const float pj = (sc[g][sl] > -1e29f) ? __expf(sc[g][sl] - mx) : 0.f; sc[g][sl] = pj; ls += pj; }
    ls = wave_sum(ls);
    float a0 = 0.f, a1 = 0.f;
#pragma unroll
    for (int g = 0; g < 3; ++g) {
        const int dil = g == 0 ? 1 : (g == 1 ? 4 : 16), win = g == 0 ? 128 : (g == 1 ? 512 : 2048);
        const float* cache = g == 0 ? p.c128 : (g == 1 ? p.c512 : p.c2048);
#pragma unroll
        for (int hf = 0; hf < 2; ++hf) { const float scv = sc[g][hf];
#pragma unroll 1
            for (int j0 = 64 * hf; j0 < 64 * hf + 64; j0 += 32) {
                f32x2 v[32];
#pragma unroll
                for (int k = 0; k < 32; ++k) { const int j = j0 + k, idx = win + st - j * dil;
                    if (idx >= win) { const unsigned u = *(const unsigned*)(PS + (size_t)(4 * sb + idx - win) * 9216 + 6144 + g * 1024 + h * 128 + 2 * lane); v[k] = (f32x2){bflo(u), bfhi(u)}; }
                    else v[k] = *(const f32x2*)(cache + (((size_t)sb * win + idx) * 2 + 1) * 1024 + h * 128 + 2 * lane); }
#pragma unroll
                for (int k = 0; k < 32; ++k) { const float pj = __shfl(scv, (j0 + k) & 63); a0 += pj * v[k][0]; a1 += pj * v[k][1]; }
            } }
        { const int idx = win + st - 128 * dil; const f32x2 v = *(const f32x2*)(cache + (((size_t)sb * win + idx) * 2 + 1) * 1024 + h * 128 + 2 * lane); const float pj = __shfl(sc[g][2], 0); a0 += pj * v[0]; a1 += pj * v[1]; }
        __builtin_amdgcn_sched_barrier(0);
    }
    const float inv = 1.f / ls; const unsigned z = *(const unsigned*)(P + (size_t)row * NP + C_ZB + h * 128 + 2 * lane);
    *(unsigned*)(OB + (size_t)row * 1024 + h * 128 + 2 * lane) = pk2(a0 * inv * siluf_(bflo(z)), a1 * inv * siluf_(bfhi(z)));
}

constexpr int KVC_NR0 = 32 * 124, KVC_NR1 = 32 * 508, KVC_NR2 = 32 * 2044, KVC_ROWS = KVC_NR0 + KVC_NR1 + KVC_NR2, KVC_TASKS = KVC_ROWS / 2;
static_assert(KVC_ROWS % 16 == 0, "copy tasks come in groups of 8");
template <int WIN> __device__ __forceinline__ void kvc_rp(const float* c, float* o, int r, const float*& src, float*& dst) { const int b = r / (WIN - 4), j = r - b * (WIN - 4); src = c + (size_t)(b * WIN + j + 4) * 2048; dst = o + (size_t)(b * WIN + j) * 2048; }
__device__ __forceinline__ void kvcopy_task(const Params& p, int t, int lane) {
    asm volatile("" : "+v"(lane));
    const float *c128 = p.c128, *c512 = p.c512, *c2048 = p.c2048;
    asm volatile("" : "+s"(c128), "+s"(c512), "+s"(c2048));
    f32x4 v[16]; float* d[2];
#pragma unroll
    for (int r = 0; r < 2; ++r) { const int R = 2 * t + r; const float* s;
        if (R < KVC_NR0) kvc_rp<128>(c128, p.out + O_KV128S, R, s, d[r]); else if (R < KVC_NR0 + KVC_NR1) kvc_rp<512>(c512, p.out + O_KV512S, R - KVC_NR0, s, d[r]); else kvc_rp<2048>(c2048, p.out + O_KV2048S, R - KVC_NR0 - KVC_NR1, s, d[r]);
#pragma unroll
        for (int k = 0; k < 8; ++k) v[r * 8 + k] = *(const f32x4*)(s + k * 256 + lane * 4); }
#pragma unroll
    for (int r = 0; r < 2; ++r)
#pragma unroll
        for (int k = 0; k < 8; ++k) *(f32x4*)(d[r] + k * 256 + lane * 4) = v[r * 8 + k];
}
__device__ __forceinline__ void kvcopy_companion(const Params& p, int pullA, int cw, int lane) {
    asm volatile("" : "+v"(lane));
    const float *c128 = p.c128, *c512 = p.c512, *c2048 = p.c2048;
    asm volatile("" : "+s"(c128), "+s"(c512), "+s"(c2048));
#pragma unroll 1
    for (int k = 0; k < 4; ++k) {
        const int t = (pullA * 4 + cw) * 4 + k; const bool on = t < KVC_TASKS;
        f32x4 v[16]; float* d[2];
        asm volatile("s_waitcnt lgkmcnt(0)" ::: "memory"); __builtin_amdgcn_s_barrier(); asm volatile("" ::: "memory");
        if (on) {
#pragma unroll
            for (int r = 0; r < 2; ++r) { const int R = 2 * t + r; const float* s;
                if (R < KVC_NR0) kvc_rp<128>(c128, p.out + O_KV128S, R, s, d[r]); else if (R < KVC_NR0 + KVC_NR1) kvc_rp<512>(c512, p.out + O_KV512S, R - KVC_NR0, s, d[r]); else kvc_rp<2048>(c2048, p.out + O_KV2048S, R - KVC_NR0 - KVC_NR1, s, d[r]);
#pragma unroll
                for (int q = 0; q < 8; ++q) v[r * 8 + q] = *(const f32x4*)(s + q * 256 + lane * 4); } }
        asm volatile("s_waitcnt lgkmcnt(0)" ::: "memory"); __builtin_amdgcn_s_barrier(); asm volatile("" ::: "memory");
        if (on) {
#pragma unroll
            for (int r = 0; r < 2; ++r)
#pragma unroll
                for (int q = 0; q < 8; ++q) *(f32x4*)(d[r] + q * 256 + lane * 4) = v[r * 8 + q]; }
    }
}
constexpr int ATT_PULL_R = 32 * 32 * 2 / 8  , ATT_PULL_S = NSAMP * 8 / 8, ATT_PULL_A = 3 * 8 * (SEQ / 128)  , ATT_PULL_C = 0,
              ATT_PULLS = ATT_PULL_R + ATT_PULL_S + ATT_PULL_A + ATT_PULL_C, WQ_ATT = 3600;
static_assert(KVC_TASKS <= 3 * 8 * (SEQ / 128) * 16, "every copy task has a companion slot");
constexpr int ATT_LDS_PULL = 98304;
__device__ __forceinline__ void attn_quad_task(const Params& p, int qt, LAS unsigned char* ldsq, int wq, int lane) {
    asm volatile("" : "+v"(lane));
    const int g = qt >> 10, rem = qt & 1023, h = rem >> 7, rem2 = rem & 127, nq = 128 >> (2 * g), r = rem2 / nq, qq = rem2 % nq;
    const int ql = lane & 31, hi = lane >> 5, m0 = 128 * qq + 32 * wq, dil = 1 << (2 * g), jstart = qq == 0 ? 4 : 0;
    const size_t tokq = (size_t)r + (size_t)dil * (m0 + ql);
    const bf16_t* Qs = (const bf16_t*)(p.ws + WS_QKVC) + qkvc_row(0, g, h, r); const bf16_t* Ks = (const bf16_t*)(p.ws + WS_QKVC) + qkvc_row(1, g, h, r); const bf16_t* Vs = (const bf16_t*)(p.ws + WS_QKVC) + qkvc_row(2, g, h, r);
    const int kb0 = 128 * qq - 128;
    const bf16_t* tsrc[4];
#pragma unroll
    for (int i = 0; i < 4; ++i) { const int c = i * 256 + wq * 64 + lane, cc = c & 511, row = cc >> 4, ch = (cc & 15) ^ (((row & 3) << 2) | ((row >> 2) & 3));
        tsrc[i] = (i < 2 ? Ks : Vs) + (size_t)(kb0 + row) * 128 + ch * 8; }
#define ATT_DMA(j_, b_) do { _Pragma("unroll") for (int i = 0; i < 4; ++i) __builtin_amdgcn_global_load_lds((const unsigned*)(tsrc[i] + (size_t)(j_) * 32 * 128), (LAS unsigned*)(ldsq + (b_) * 16384 + i * 4096 + wq * 1024), 16, 0, 0); } while (0)
    ATT_DMA(jstart, jstart % 3); ATT_DMA(jstart + 1, (jstart + 1) % 3);
    bf16x8 qf[8];
    { const bf16_t* qp = Qs + (size_t)(m0 + ql) * 128 + 8 * hi;
#pragma unroll
      for (int s = 0; s < 8; ++s) qf[s] = *(const bf16x8*)(qp + 16 * s); }
    f32x16 O[4];
#pragma unroll
    for (int dm = 0; dm < 4; ++dm)
#pragma unroll
        for (int x = 0; x < 16; ++x) O[dm][x] = 0.f;
    float mrun = -1e30f, lrun = 0.f;
    constexpr float C2 = 0.08838834764831845f * 1.4426950408889634f;
    const unsigned qq4 = (lane & 15) >> 2, pp = lane & 3, blk = (lane >> 4) & 1;
    int bj = 0, bn = 2;
#pragma unroll 1
    for (int j = 0; j < 8; ++j) {
        if (j == 7) asm volatile("s_waitcnt vmcnt(0) lgkmcnt(0)" ::: "memory"); else asm volatile("s_waitcnt vmcnt(4) lgkmcnt(0)" ::: "memory");
        __builtin_amdgcn_s_barrier(); asm volatile("" ::: "memory");
        if (j + 2 <= 7 && j + 2 > jstart + 1) ATT_DMA(j + 2, bn);
        const int kt = j - wq;
        if (j >= jstart && kt >= 0 && kt <= 4) {
            const LAS unsigned char* kb = ldsq + bj * 16384; const LAS unsigned char* vb = kb + 8192;
            f32x16 S;
#pragma unroll
            for (int x = 0; x < 16; ++x) S[x] = 0.f;
#pragma unroll
            for (int s = 0; s < 8; ++s) S = __builtin_amdgcn_mfma_f32_32x32x16_bf16(*(const LAS bf16x8*)(kb + off_b(ql, 2 * s + hi)), qf[s], S, 0, 0, 0);
            const float NEG = -__builtin_inff();
            if (kt == 0) {
#pragma unroll
                for (int x = 0; x < 16; ++x) { const int kl = (x & 3) + 8 * (x >> 2) + 4 * hi; if (kl < ql) S[x] = NEG; }
            } else if (kt == 4) {
#pragma unroll
                for (int x = 0; x < 16; ++x) { const int kl = (x & 3) + 8 * (x >> 2) + 4 * hi; if (kl > ql) S[x] = NEG; }
            }
            float tmax = S[0];
#pragma unroll
            for (int x = 1; x < 16; ++x) tmax = fmaxf(tmax, S[x]);
            tmax = fmaxf(tmax, __shfl_xor(tmax, 32));
            if (!__all((tmax - mrun) * 0.08838834764831845f <= 8.f)) {
                const float mnew = fmaxf(mrun, tmax), alpha = __builtin_amdgcn_exp2f((mrun - mnew) * C2); mrun = mnew; lrun *= alpha;
#pragma unroll
                for (int dm = 0; dm < 4; ++dm)
#pragma unroll
                    for (int x = 0; x < 16; ++x) O[dm][x] *= alpha; }
            float ps = 0.f;
#pragma unroll
            for (int x = 0; x < 16; ++x) { S[x] = __builtin_amdgcn_exp2f((S[x] - mrun) * C2); ps += S[x]; }
            lrun += ps;
            bf16x8 pf[2];
#pragma unroll
            for (int t = 0; t < 2; ++t) { const u32x4 w = (u32x4){cvtpk(S[8 * t], S[8 * t + 1]), cvtpk(S[8 * t + 2], S[8 * t + 3]), cvtpk(S[8 * t + 4], S[8 * t + 5]), cvtpk(S[8 * t + 6], S[8 * t + 7])}; pf[t] = __builtin_bit_cast(bf16x8, w); }
#pragma unroll
            for (int dm = 0; dm < 4; ++dm)
#pragma unroll
                for (int t = 0; t < 2; ++t) {
                    const s16x4 a0 = lds_tr((LAS unsigned char*)vb + off_b(16 * t + 4 * hi + qq4, 4 * dm + 2 * blk + (pp >> 1)) + 8 * (pp & 1));
                    const s16x4 a1 = lds_tr((LAS unsigned char*)vb + off_b(16 * t + 8 + 4 * hi + qq4, 4 * dm + 2 * blk + (pp >> 1)) + 8 * (pp & 1));
                    O[dm] = __builtin_amdgcn_mfma_f32_32x32x16_bf16(cat8(a0, a1), pf[t], O[dm], 0, 0, 0); }
        }
        bj = bj == 2 ? 0 : bj + 1; bn = bn == 2 ? 0 : bn + 1;
    }
#undef ATT_DMA
    lrun += __shfl_xor(lrun, 32);
    const float inv = 1.f / lrun;
    bf16_t* og = (bf16_t*)(p.ws + WS_OG) + ((size_t)g * SEQ + tokq) * 1024 + h * 128;
#pragma unroll
    for (int dm = 0; dm < 4; ++dm)
#pragma unroll
        for (int a = 0; a < 2; ++a) {
            const unsigned e0 = cvtpk(O[dm][8 * a] * inv, O[dm][8 * a + 1] * inv), e1 = cvtpk(O[dm][8 * a + 2] * inv, O[dm][8 * a + 3] * inv);
            const unsigned f0 = cvtpk(O[dm][8 * a + 4] * inv, O[dm][8 * a + 5] * inv), f1 = cvtpk(O[dm][8 * a + 6] * inv, O[dm][8 * a + 7] * inv);
            const auto s0 = __builtin_amdgcn_permlane32_swap(e0, f0, false, false), s1 = __builtin_amdgcn_permlane32_swap(e1, f1, false, false);
            *(u32x4*)(og + 32 * dm + 16 * a + 8 * hi) = (u32x4){s0[0], s1[0], s0[1], s1[1]}; }
    if (hi == 0) ((float*)(p.ws + WS_LSE))[((size_t)g * SEQ + tokq) * 8 + h] = mrun * 0.08838834764831845f + logf(lrun);
}
constexpr int WQ_QX = 3648  , QX_S = ATT_PULL_S / 8  , QX_N = QX_S + ATT_PULL_A / 8;
static_assert(ATT_PULL_A % 8 == 0 && ATT_PULL_S % 8 == 0 && WQ_QX + 8 * 16 <= 4096, "per-XCD counters");
__device__ __forceinline__ void ph_attn(const Params& p, LAS unsigned char* lds) {
    const int tid = tidx(), lane = tid & 63, wid = __builtin_amdgcn_readfirstlane(tid >> 6);
    unsigned* ctr = (unsigned*)(p.ws + WS_BAR) + WQ_ATT; unsigned* ctrq = (unsigned*)(p.ws + WS_BAR) + WQ_QX;
    LAS int* slot = (LAS int*)(lds + ATT_LDS_PULL);
    bool main_done = false; int qcur = (int)(xb_xcc_id() & 7u);
    for (;;) {
        __syncthreads();
        if (wid == 0) {
            int v = -1;
            if (!main_done) { unsigned m = 0; if (lane == 0) m = __hip_atomic_fetch_add(ctr, 1u, __ATOMIC_RELAXED, __HIP_MEMORY_SCOPE_AGENT); m = __builtin_amdgcn_readfirstlane(m);
                if (m < (unsigned)ATT_PULL_R) v = (int)m; else main_done = true; }
            if (v < 0) {
                for (;;) {
                    unsigned a = 0; if (lane == 0) a = __hip_atomic_fetch_add(ctrq + 16 * qcur, 1u, __ATOMIC_RELAXED, __HIP_MEMORY_SCOPE_AGENT); a = __builtin_amdgcn_readfirstlane(a);
                    if (a < (unsigned)QX_N) { v = (int)a < QX_S ? ATT_PULL_R + qcur * QX_S + (int)a : ATT_PULL_R + ATT_PULL_S + qcur * (QX_N - QX_S) + (int)a - QX_S; break; }
                    unsigned c = (unsigned)QX_N; if (lane < 8) c = __hip_atomic_load(ctrq + 16 * lane, __ATOMIC_RELAXED, __HIP_MEMORY_SCOPE_AGENT);
                    const unsigned ne = (unsigned)__ballot(c < (unsigned)QX_N) & 0xffu;
                    if (ne == 0u) { v = ATT_PULLS; break; }
                    const unsigned rot = ((ne >> qcur) | (ne << (8 - qcur))) & 0xffu; qcur = (qcur + __builtin_ctz(rot)) & 7;
                }
            }
            if (lane == 0) *slot = v;
        }
        __syncthreads();
        const int pull = __builtin_amdgcn_readfirstlane(*slot);
        if (pull >= ATT_PULLS) break;
        if (pull < ATT_PULL_R) delta_rec_sample_task(p, pull * 8 + wid, lane);
        else if (pull < ATT_PULL_R + ATT_PULL_S) { const int task = (pull - ATT_PULL_R) * 8 + wid; attn_sample_task(p, SEQ + (task >> 3), task & 7, lane); }
        else { const int pa = pull - ATT_PULL_R - ATT_PULL_S;
            if (wid < 4) attn_quad_task(p, pa, lds, wid, lane); else kvcopy_companion(p, pa, wid - 4, lane); }
    }
}
__device__ __forceinline__ void ph_mix(const Params& p, int bid, int nb) {
    const bf16_t* P = (const bf16_t*)(p.ws + WS_P); const bf16_t* OG = (const bf16_t*)(p.ws + WS_OG); const float* LSE = (const float*)(p.ws + WS_LSE); bf16_t* OB = (bf16_t*)(p.ws + WS_OB);
    const int tid = tidx(), lane = tid & 63, gw = __builtin_amdgcn_readfirstlane(tid >> 6) * nb + bid, nw = nb * 8, h = lane >> 3;
    for (int tok = gw; tok < SEQ; tok += nw) {
        const size_t o = (size_t)tok * 1024 + lane * 16;
        u32x4 a[3][2];
#pragma unroll
        for (int g = 0; g < 3; ++g) { a[g][0] = *(const u32x4*)(OG + (size_t)g * SEQ * 1024 + o); a[g][1] = *(const u32x4*)(OG + (size_t)g * SEQ * 1024 + o + 8); }
        const u32x4 z0 = *(const u32x4*)(P + (size_t)tok * NP + C_ZB + lane * 16), z1 = *(const u32x4*)(P + (size_t)tok * NP + C_ZB + lane * 16 + 8);
        const float l0 = LSE[((size_t)0 * SEQ + tok) * 8 + h], l1 = LSE[((size_t)1 * SEQ + tok) * 8 + h], l2 = LSE[((size_t)2 * SEQ + tok) * 8 + h];
        const float mx = fmaxf(l0, fmaxf(l1, l2)); float w0 = __expf(l0 - mx), w1 = __expf(l1 - mx), w2 = __expf(l2 - mx); const float inv = 1.f / (w0 + w1 + w2); w0 *= inv; w1 *= inv; w2 *= inv;
        u32x4 r[2];
#pragma unroll
        for (int q = 0; q < 2; ++q) { const u32x4 z = q ? z1 : z0;
#pragma unroll
            for (int i = 0; i < 4; ++i) r[q][i] = pk2((w0 * bflo(a[0][q][i]) + w1 * bflo(a[1][q][i]) + w2 * bflo(a[2][q][i])) * siluf_(bflo(z[i])), (w0 * bfhi(a[0][q][i]) + w1 * bfhi(a[1][q][i]) + w2 * bfhi(a[2][q][i])) * siluf_(bfhi(z[i]))); }
        *(u32x4*)(OB + o) = r[0]; *(u32x4*)(OB + o + 8) = r[1];
    }
}

__device__ __forceinline__ void ph_gnorm(const Params& p, int bid, int nb) {
    const bf16_t* P = (const bf16_t*)(p.ws + WS_P); bf16_t* OA = (bf16_t*)(p.ws + WS_OA);
    const int tid = tidx(), lane = tid & 63, gw = __builtin_amdgcn_readfirstlane(tid >> 6) * nb + bid, nw = nb * 8;
    const f32x4 nwa = *(const f32x4*)(p.norm_a + 8 * (lane & 15)), nwb = *(const f32x4*)(p.norm_a + 8 * (lane & 15) + 4);
    for (int task0 = gw; task0 < MR * 4; task0 += 2 * nw) {
        u32x4 u[2][2], z[2][2];
#pragma unroll
        for (int k = 0; k < 2; ++k) { const int task = task0 + k * nw;
            if (task < MR * 4) { const int row = task >> 2, c0 = (task & 3) * 1024 + 8 * lane; const bf16_t* op = OA + (size_t)row * 4096 + c0; const bf16_t* zp = P + (size_t)row * NP + C_ZA + c0;
#pragma unroll
                for (int i = 0; i < 2; ++i) { u[k][i] = *(const u32x4*)(op + i * 512); z[k][i] = *(const u32x4*)(zp + i * 512); } } }
#pragma unroll
        for (int k = 0; k < 2; ++k) { const int task = task0 + k * nw;
            if (task < MR * 4) { const int row = task >> 2, c0 = (task & 3) * 1024 + 8 * lane; bf16_t* op = OA + (size_t)row * 4096 + c0; float ss[2];
#pragma unroll
                for (int i = 0; i < 2; ++i) { ss[i] = 0.f;
#pragma unroll
                    for (int q = 0; q < 4; ++q) ss[i] += bflo(u[k][i][q]) * bflo(u[k][i][q]) + bfhi(u[k][i][q]) * bfhi(u[k][i][q]); }
#pragma unroll
                for (int o = 1; o <= 8; o <<= 1)
#pragma unroll
                    for (int i = 0; i < 2; ++i) ss[i] += __shfl_xor(ss[i], o);
#pragma unroll
                for (int i = 0; i < 2; ++i) { const float r = rsqrtf(ss[i] * (1.f / 128.f) + EPS); u32x4 o;
#pragma unroll
                    for (int q = 0; q < 4; ++q) { const f32x4 nv = q < 2 ? nwa : nwb;
                        o[q] = pk2(bflo(u[k][i][q]) * r * nv[(2 * q) & 3] * siluf_(bflo(z[k][i][q])), bfhi(u[k][i][q]) * r * nv[(2 * q + 1) & 3] * siluf_(bfhi(z[k][i][q]))); }
                    *(u32x4*)(op + i * 512) = o; } } }
    }
}

__device__ __forceinline__ void ph_final(const Params& p, int bid, int nb) {
    const int lane = tidx() & 63, gw = __builtin_amdgcn_readfirstlane(tidx() >> 6) * nb + bid, nw = nb * 8;
    const bf16_t* H = (const bf16_t*)(p.ws + WS_T);
    for (int row0 = gw; row0 < MR; row0 += 2 * nw) {
        f32x4 v[2][8];
#pragma unroll
        for (int k = 0; k < 2; ++k) { const int row = row0 + k * nw;
            if (row < SEQ) {
#pragma unroll
                for (int i = 0; i < 8; ++i) { const u32x2 q = *(const u32x2*)(H + (size_t)row * DM + i * 256 + lane * 4); v[k][i] = (f32x4){bflo(q[0]), bfhi(q[0]), bflo(q[1]), bfhi(q[1])}; }
            } else if (row < MR) { const float* hr = p.out + (size_t)row * DM;
#pragma unroll
                for (int i = 0; i < 8; ++i) v[k][i] = *(const f32x4*)(hr + i * 256 + lane * 4); } }
#pragma unroll
        for (int k = 0; k < 2; ++k) { const int row = row0 + k * nw;
            if (row < MR) { float* hr = p.out + (size_t)row * DM; float ss = 0.f;
#pragma unroll
                for (int i = 0; i < 8; ++i) ss += v[k][i][0] * v[k][i][0] + v[k][i][1] * v[k][i][1] + v[k][i][2] * v[k][i][2] + v[k][i][3] * v[k][i][3];
                ss = wave_sum(ss); const float r = rsqrtf(ss * (1.f / DM) + EPS);
#pragma unroll
                for (int i = 0; i < 8; ++i) { const f32x4 w = *(const f32x4*)(p.ln_f + i * 256 + lane * 4); *(f32x4*)(hr + i * 256 + lane * 4) = (f32x4){v[k][i][0] * r * w[0], v[k][i][1] * r * w[1], v[k][i][2] * r * w[2], v[k][i][3] * r * w[3]}; } } }
    }
}

__device__ __forceinline__ void ph_gemm1(const Params& p, LAS unsigned char* lds, int bid, int nb) {
    pg8::StaticOrder S; S.init(MP, NPAD, nb, bid);
    pg8::gemm_phase(lds, pg8::Gemm{(const bf16_t*)(p.ws + WS_XN), (const bf16_t*)(p.ws + WS_BT1), MP, NPAD, 2048}, S, pg8::EpiProj{(bf16_t*)(p.ws + WS_P), (float*)(p.ws + WS_BA), (bf16_t*)(p.ws + WS_QKVC), (bf16_t*)(p.ws + WS_PS)});
    static_assert((MP / 256) * (NPAD / 256) == 26 * 256 + 169, "the idle workgroups of GEMM 1's last round");
    if (nb == 256 && bid >= 169) {
        const float *w_in = p.w_in, *w_pa = p.w_proj_a, *w_pb = p.w_proj_b, *w_o = p.w_out;
        asm volatile("" : "+s"(w_in), "+s"(w_pa), "+s"(w_pb), "+s"(w_o));
        const int tid = tidx();
        for (int u0 = PRO_TILES1 + (bid - 169) * 4; u0 < PRO_TILES; u0 += 87 * 4) pro_tiles4(p, lds, u0, tid, w_in, w_pa, w_pb, w_o);
    }
}
__device__ __forceinline__ void ph_gemm2a(const Params& p, LAS unsigned char* lds, int bid, int nb) {
    pg8::StaticOrder S; S.init(SEQ, DM, nb, bid);
    pg8::gemm_phase(lds, pg8::Gemm{(const bf16_t*)(p.ws + WS_OB), (const bf16_t*)(p.ws + WS_BT2B), MP, DM, 1024}, S, pg8::EpiGateB{(const bf16_t*)(p.ws + WS_P), (bf16_t*)(p.ws + WS_T)});
}
__device__ __forceinline__ void ph_gemm2b(const Params& p, LAS unsigned char* lds, int bid, int nb) {
    pg8::StaticOrder S; S.init(SEQ, DM, nb, bid);
    pg8::gemm_phase(lds, pg8::Gemm{(const bf16_t*)(p.ws + WS_OA), (const bf16_t*)(p.ws + WS_BT2A), MP, DM, 4096}, S, pg8::EpiMerge{(const bf16_t*)(p.ws + WS_P), (const bf16_t*)(p.ws + WS_T), (bf16_t*)(p.ws + WS_MG)});
}
__device__ __forceinline__ void ph_gemm3(const Params& p, LAS unsigned char* lds, int bid, int nb) {
    pg8::StaticOrder S; S.init(SEQ, DM, nb, bid);
    pg8::gemm_phase(lds, pg8::Gemm{(const bf16_t*)(p.ws + WS_MG), (const bf16_t*)(p.ws + WS_BT3), MP, DM, 2048}, S, pg8::EpiOut{p.x_prompt, (bf16_t*)(p.ws + WS_T)});
}

template <int K> __device__ __forceinline__ f32x4 skinny_acc(const bf16_t* a, const bf16_t* b, f32x4 acc) {
    static_assert(K % 512 == 0, "K step");
#pragma unroll 1
    for (int k0 = 0; k0 < K; k0 += 512) {
        bf16x8 af[16], bfr[16];
#pragma unroll
        for (int i = 0; i < 16; ++i) { af[i] = *(const bf16x8*)(a + k0 + 32 * i); bfr[i] = *(const bf16x8*)(b + k0 + 32 * i); }
#pragma unroll
        for (int i = 0; i < 16; ++i) acc = __builtin_amdgcn_mfma_f32_16x16x32_bf16(af[i], bfr[i], acc, 0, 0, 0);
    }
    return acc;
}
__device__ __forceinline__ void ph_gemm2_sample(const Params& p, LAS unsigned char* lds, int bid) {
    if (bid >= 256) return;
    const int tid = tidx(), lane = tid & 63, wv = __builtin_amdgcn_readfirstlane(tid >> 6), fr = lane & 15, fq = lane >> 4, rt = (bid & 1) * 4 + (wv & 3), kh = wv >> 2, cb = bid >> 1;
    const bf16_t* P = (const bf16_t*)(p.ws + WS_P);
    const int arow = SEQ + 16 * rt + fr, bcol = 16 * cb + fr;
    f32x4 aa = (f32x4){0.f, 0.f, 0.f, 0.f}, ab = aa;
    aa = skinny_acc<2048>((const bf16_t*)(p.ws + WS_OA) + (size_t)arow * 4096 + kh * 2048 + 8 * fq, (const bf16_t*)(p.ws + WS_BT2A) + (size_t)bcol * 4096 + kh * 2048 + 8 * fq, aa);
    ab = skinny_acc<512>((const bf16_t*)(p.ws + WS_OB) + (size_t)arow * 1024 + kh * 512 + 8 * fq, (const bf16_t*)(p.ws + WS_BT2B) + (size_t)bcol * 1024 + kh * 512 + 8 * fq, ab);
    LAS f32x4* red = (LAS f32x4*)lds + (wv & 3) * 128 + lane * 2;
    if (kh) { red[0] = aa; red[1] = ab; }
    __syncthreads();
    if (!kh) { aa += red[0]; ab += red[1];
        bf16_t* MG = (bf16_t*)(p.ws + WS_MG);
#pragma unroll
        for (int r = 0; r < 4; ++r) { const size_t row = (size_t)(SEQ + 16 * rt + 4 * fq + r); const int c = 16 * cb + fr;
            const float ga = sigmoidf_(bf2f(P[row * NP + C_GA + c])), gb = sigmoidf_(bf2f(P[row * NP + C_GB + c]));
            MG[row * DM + c] = f2bf(ga * aa[r] + gb * ab[r]); } }
    __syncthreads();
}
__device__ __forceinline__ void ph_gemm3_sample(const Params& p, LAS unsigned char* lds, int bid) {
    if (bid >= 256) return;
    const int tid = tidx(), lane = tid & 63, wv = __builtin_amdgcn_readfirstlane(tid >> 6), fr = lane & 15, fq = lane >> 4, rt = (bid & 1) * 4 + (wv & 3), kh = wv >> 2, cb = bid >> 1;
    const int arow = SEQ + 16 * rt + fr, bcol = 16 * cb + fr;
    f32x4 acc = (f32x4){0.f, 0.f, 0.f, 0.f};
    acc = skinny_acc<1024>((const bf16_t*)(p.ws + WS_MG) + (size_t)arow * 2048 + kh * 1024 + 8 * fq, (const bf16_t*)(p.ws + WS_BT3) + (size_t)bcol * 2048 + kh * 1024 + 8 * fq, acc);
    LAS f32x4* red = (LAS f32x4*)lds + (wv & 3) * 64 + lane;
    if (kh) red[0] = acc;
    __syncthreads();
    if (!kh) { acc += red[0];
#pragma unroll
        for (int r = 0; r < 4; ++r) { const int srow = 16 * rt + 4 * fq + r, c = 16 * cb + fr;
            p.out[(size_t)(SEQ + srow) * DM + c] = p.x_sample[(size_t)srow * DM + c] + acc[r]; } }
    __syncthreads();
}

constexpr int LDS_MAIN = 4 * REC_DMA + 8192;
constexpr int LDS_BYTES = LDS_MAIN + 16;
__global__ __launch_bounds__(512, 2) void k_fwd(Params p) {
    extern __shared__ __attribute__((aligned(16))) unsigned char shm[];
    LAS unsigned char* lds = (LAS unsigned char*)shm;
    const int bid = blockIdx.x, nb = gridDim.x;
    if (threadIdx.x < 4) ((LAS unsigned*)(lds + LDS_MAIN))[threadIdx.x] = 0u;
    __syncthreads();
    XcdBarrier bar = xcd_barrier_post((unsigned*)(p.ws + WS_BAR), (volatile LAS unsigned*)(lds + LDS_MAIN));
    ph_prologue(p, lds, bid, nb);
    xcd_barrier(bar);
    ph_gemm1(p, lds, bid, nb);
    xcd_barrier(bar);
    ph_prep(p, bid, nb);
    ph_stage_a(p, lds, bid, nb);
    xcd_barrier(bar);
    if (bid < SCAN_WGS) ph_scan(p, lds, bid);
    ph_attn(p, lds);
    xcd_barrier(bar);
    ph_gnorm(p, bid, nb);
    ph_mix(p, bid, nb);
    xcd_barrier(bar);
    ph_gemm2_sample(p, lds, bid);
    ph_gemm2a(p, lds, bid, nb);
    ph_gemm2b(p, lds, bid, nb);
    xcd_barrier(bar);
    ph_gemm3_sample(p, lds, bid);
    ph_gemm3(p, lds, bid, nb);
    xcd_barrier(bar);
    ph_final(p, bid, nb);
}

extern "C" void kernel_launch(void* const* d_in, const int* in_sizes, int n_in, void* d_out, int out_size, void* d_ws, size_t ws_size, hipStream_t stream) {
    if (n_in != 17 || (size_t)out_size != O_END || ws_size < WS_END) { fprintf(stderr, "kernel_launch: unexpected sizes n_in %d out %d ws %zu (need %zu)\n", n_in, out_size, ws_size, (size_t)WS_END); return; }
    static int grid = 0;
    if (!grid) {
        int dev = 0, cus = 0, per_cu = 0;
        if (hipGetDevice(&dev) != hipSuccess || hipDeviceGetAttribute(&cus, hipDeviceAttributeMultiprocessorCount, dev) != hipSuccess) { fprintf(stderr, "kernel_launch: device query failed\n"); return; }
        if (hipFuncSetAttribute((const void*)k_fwd, hipFuncAttributeMaxDynamicSharedMemorySize, LDS_BYTES) != hipSuccess) { fprintf(stderr, "kernel_launch: hipFuncSetAttribute failed\n"); return; }
        if (hipOccupancyMaxActiveBlocksPerMultiprocessor(&per_cu, (const void*)k_fwd, 512, LDS_BYTES) != hipSuccess || per_cu < 1) { fprintf(stderr, "kernel_launch: occupancy query says %d blocks per CU\n", per_cu); return; }
        grid = cus;
    }
    Params p{};
    p.x_prompt = (const float*)d_in[0]; p.x_sample = (const float*)d_in[1]; p.c128 = (const float*)d_in[2]; p.c512 = (const float*)d_in[3]; p.c2048 = (const float*)d_in[4];
    p.state_delta = (const float*)d_in[5]; p.state_conv = (const float*)d_in[6]; p.ln_in = (const float*)d_in[7]; p.w_in = (const float*)d_in[8]; p.conv_w = (const float*)d_in[9];
    p.a_log = (const float*)d_in[10]; p.dt_bias = (const float*)d_in[11]; p.norm_a = (const float*)d_in[12]; p.w_proj_a = (const float*)d_in[13]; p.w_proj_b = (const float*)d_in[14];
    p.w_out = (const float*)d_in[15]; p.ln_f = (const float*)d_in[16]; p.out = (float*)d_out; p.ws = (unsigned char*)d_ws;
    (void)hipMemsetAsync((char*)d_ws + WS_BAR, 0, 16384, stream);
    hipLaunchKernelGGL(k_fwd, dim3(grid), dim3(512), LDS_BYTES, stream, p);
}
```

```cpp
#include <hip/hip_runtime.h>
#include <stdint.h>
#include <stdio.h>

#define LAS __attribute__((address_space(3)))
typedef unsigned short bf16_t;
typedef short bf16x8 __attribute__((ext_vector_type(8)));
typedef float f32x4 __attribute__((ext_vector_type(4)));
typedef float f32x2 __attribute__((ext_vector_type(2)));
typedef unsigned u32x4 __attribute__((ext_vector_type(4)));
typedef unsigned u32x2 __attribute__((ext_vector_type(2)));

constexpr int DM = 2048, SEQ = 16384, NSAMP = 128, MR = SEQ + NSAMP  , MP = 16640  ;
constexpr int NPAD = 26880;
constexpr int NP = 17408;
constexpr int C_QA = 0, C_KA = 2048, C_VA = 4096, C_ZA = 8192, C_ZB = 12288, C_GA = 13312, C_GB = 15360;
constexpr float EPS = 1e-6f;
constexpr size_t O_Y = 0, O_YS = 33554432, O_KV128P = O_YS + 262144, O_KV512P = O_KV128P + 262144, O_KV2048P = O_KV512P + 1048576, O_DELTAP = O_KV2048P + 4194304,
                 O_CONVP = O_DELTAP + 524288, O_KV128S = O_CONVP + 24576, O_KV512S = O_KV128S + 8388608, O_KV2048S = O_KV512S + 33554432, O_DELTAS = O_KV2048S + 134217728,
                 O_CONVS = O_DELTAS + 16777216, O_END = O_CONVS + 786432;
constexpr int CH = 32, NCHUNK = SEQ / CH;
constexpr int REC_W = 0, REC_QG = 8192, REC_IN = 16384, REC_KD = 18432, REC_U = 26624, REC_GL = 34816, RECB = 35072, REC_DMA = 36864;
constexpr size_t WS_BAR = 0, WS_REC = 16384, REC_BYTES = (size_t)NCHUNK * 32 * RECB + 4096,
                 WS_XN = WS_REC, WS_BT1 = WS_XN + (size_t)MP * 2048 * 2, WS_T = WS_REC + ((size_t)200 << 20), WS_MG = WS_REC + ((size_t)300 << 20),
                 WS_BT2A = WS_REC + ((REC_BYTES + 255) & ~(size_t)255), WS_BT2B = WS_BT2A + (size_t)2048 * 4096 * 2,
                 WS_BT3 = WS_BT2B + (size_t)2048 * 1024 * 2, WS_P = WS_BT3 + (size_t)2048 * 2048 * 2, WS_BA = WS_P + (size_t)MP * NP * 2, WS_BG = WS_BA + (size_t)MP * 64 * 4,
                 WS_CV = WS_BG + (size_t)MP * 64 * 4, WS_OA = WS_CV + (size_t)MP * 8192 * 2, WS_OB = WS_OA + (size_t)MP * 4096 * 2, WS_QKVC = WS_OB + (size_t)MP * 1024 * 2, WS_PS = WS_QKVC + (size_t)3 * 3 * 8 * SEQ * 128 * 2, WS_END = WS_PS + (size_t)256 * 9216 * 2,
                 WS_OG = WS_CV  , WS_LSE = WS_CV + (size_t)3 * SEQ * 1024 * 2;
static_assert(WS_LSE + (size_t)3 * SEQ * 8 * 4 <= WS_OA, "OG/LSE inside CV");
static_assert(WS_BT1 + (size_t)NPAD * 2048 * 2 <= WS_T && WS_T + (size_t)MP * 2048 * 2 <= WS_MG && WS_MG + (size_t)MP * 2048 * 2 <= WS_BT2A, "aliases inside REC");

__host__ __device__ __forceinline__ size_t qkvc_row(int which, int g, int h, int tok) { const int sh = 2 * g, pos = (tok & ((1 << sh) - 1)) * (SEQ >> sh) + (tok >> sh); return ((size_t)((which * 3 + g) * 8 + h) * SEQ + pos) * 128; }
struct Params {
    const float *x_prompt, *x_sample, *c128, *c512, *c2048, *state_delta, *state_conv, *ln_in, *w_in, *conv_w, *a_log, *dt_bias, *norm_a, *w_proj_a, *w_proj_b, *w_out, *ln_f;
    float* out;
    unsigned char* ws;
};

__device__ __forceinline__ int tidx() { int t = threadIdx.x; asm volatile("" : "+v"(t)); return t; }
__device__ __forceinline__ float bf2f(bf16_t b) { return __uint_as_float(((unsigned)b) << 16); }
__device__ __forceinline__ float bflo(unsigned u) { return __uint_as_float(u << 16); }
__device__ __forceinline__ float bfhi(unsigned u) { return __uint_as_float(u & 0xffff0000u); }
__device__ __forceinline__ bf16_t f2bf(float f) { unsigned u = __float_as_uint(f); u += 0x7FFFu + ((u >> 16) & 1u); return (bf16_t)(u >> 16); }
typedef __bf16 bf16x2_t __attribute__((ext_vector_type(2)));
__device__ __forceinline__ unsigned pk2(float lo, float hi) { const f32x2 v = {lo, hi}; return __builtin_bit_cast(unsigned, __builtin_convertvector(v, bf16x2_t)); }
__device__ __forceinline__ float sigmoidf_(float x) { return __builtin_amdgcn_rcpf(1.f + __builtin_amdgcn_exp2f(-1.4426950408889634f * x)); }
__device__ __forceinline__ float siluf_(float x) { return x * __builtin_amdgcn_rcpf(1.f + __builtin_amdgcn_exp2f(-1.4426950408889634f * x)); }
__device__ __forceinline__ float wave_sum(float v) {
#pragma unroll
    for (int o = 32; o >= 1; o >>= 1) v += __shfl_xor(v, o);
    return v;
}
__device__ __forceinline__ float wave_max(float v) {
#pragma unroll
    for (int o = 32; o >= 1; o >>= 1) v = fmaxf(v, __shfl_xor(v, o));
    return v;
}


#define XB_TMO      128
#define XB_XCNT(j)  (256  + 64 * (j))
#define XB_XSUB(j)  (1280 + 64 * (j))
#define XB_XGEN(j)  (2304 + 64 * (j))
#define XB_TOP      3328
#define XB_TOPGEN   3392
#define XCD_BAR_WORDS 3456
#define XB_SPIN_CAP (1u << 18)
__device__ __forceinline__ unsigned xb_ld(unsigned* p)              { return __hip_atomic_load(p, __ATOMIC_RELAXED, __HIP_MEMORY_SCOPE_AGENT); }
__device__ __forceinline__ unsigned xb_add(unsigned* p, unsigned v) { return __hip_atomic_fetch_add(p, v, __ATOMIC_RELAXED, __HIP_MEMORY_SCOPE_AGENT); }
__device__ __forceinline__ unsigned xb_xcc_id() { return (unsigned)__builtin_amdgcn_s_getreg((3 << 11) | 20) & 0xFu; }
#define XB_SPIN(cond, bar) do { unsigned _sp = 0; while (cond) { __builtin_amdgcn_s_sleep(1); \
    if ((++_sp & 255u) == 0u) { if (xb_ld(&(bar)[XB_TMO])) break; if (_sp > XB_SPIN_CAP) { atomicAdd(&(bar)[XB_TMO], 1u); break; } } } } while (0)
struct XcdBarrier { unsigned* bar; unsigned x; volatile LAS unsigned* st; };
__device__ __forceinline__ XcdBarrier xcd_barrier_post(unsigned* bar, volatile LAS unsigned* st) {
    XcdBarrier b; b.bar = bar; b.x = xb_xcc_id(); b.st = st;
    if (threadIdx.x == 0) (void)xb_add(&bar[XB_XCNT(b.x)], 1u);
    return b;
}
__device__ __forceinline__ void xcd_barrier_complete(unsigned* bar, unsigned x, unsigned& nloc, unsigned& nx) {
    const unsigned G = gridDim.x * gridDim.y * gridDim.z;
    unsigned sum, cnt, mine, sp = 0u;
    for (;;) {
        sum = 0u; cnt = 0u; mine = 0u;
#pragma unroll
        for (unsigned j = 0; j < 16; ++j) { const unsigned c = xb_ld(&bar[XB_XCNT(j)]); sum += c; cnt += (c > 0u) ? 1u : 0u; mine = (j == x) ? c : mine; }
        if (sum == G) break;
        __builtin_amdgcn_s_sleep(1);
        if ((++sp & 255u) == 0u) { if (xb_ld(&bar[XB_TMO])) break; if (sp > XB_SPIN_CAP) { atomicAdd(&bar[XB_TMO], 1u); break; } }
    }
    nloc = mine > 0u ? mine : 1u; nx = cnt > 0u ? cnt : 1u;
}
__device__ __forceinline__ void xcd_barrier(const XcdBarrier& b) {
    asm volatile("s_waitcnt vmcnt(0)" ::: "memory");
    __syncthreads();
    if (threadIdx.x == 0) {
        unsigned* bar = b.bar;
        __builtin_amdgcn_s_waitcnt(0);
        unsigned nloc = b.st[0], nx = b.st[1];
        if (nloc == 0u) { xcd_barrier_complete(bar, b.x, nloc, nx); b.st[0] = nloc; b.st[1] = nx; }
        const unsigned old = xb_add(&bar[XB_XSUB(b.x)], 1u);
        const unsigned gen = old / nloc;
        if (old + 1u == (gen + 1u) * nloc) {
            __builtin_amdgcn_fence(__ATOMIC_RELEASE, "agent");
            asm volatile("s_waitcnt vmcnt(0)" ::: "memory");
            const unsigned og = xb_add(&bar[XB_TOP], 1u);
            const unsigned tg = og / nx;
            if (og + 1u == (tg + 1u) * nx) xb_add(&bar[XB_TOPGEN], 1u);
            else XB_SPIN(xb_ld(&bar[XB_TOPGEN]) == tg, bar);
            __builtin_amdgcn_fence(__ATOMIC_ACQUIRE, "agent");
            xb_add(&bar[XB_XGEN(b.x)], 1u);
            asm volatile("s_waitcnt vmcnt(0)" ::: "memory");
        } else {
            XB_SPIN(xb_ld(&bar[XB_XGEN(b.x)]) == gen, bar);
            __builtin_amdgcn_fence(__ATOMIC_ACQUIRE, "agent");
            asm volatile("s_waitcnt vmcnt(0)" ::: "memory");
        }
    }
    __syncthreads();
}

namespace pg8 {
constexpr int BM = 256, BK = 64, HALF = 128, HTB = HALF * BK * 2, STAGE_BYTES = 8 * HTB, NXCD = 8, WGM = 8;
__host__ __device__ __forceinline__ int lds_byte(int r, int c) { const int st = (r >> 4) * 2 + (c >> 5), rr = r & 15, cc = c & 31, ob = rr * 64 + cc * 2; return st * 1024 + (ob ^ (((ob >> 9) & 1) << 5)); }
__host__ __device__ __forceinline__ void stage_rc(int b, int& R, int& C) { const int st = b / 1024, sb = b % 1024, swz = sb ^ (((sb >> 9) & 1) << 5); R = (st >> 1) * 16 + swz / 64; C = (st & 1) * 32 + (swz % 64) / 2; }
__host__ __device__ __forceinline__ int perm32(int rho) { const int n = rho >> 4, i = rho & 15; return 8 * (i >> 2) + 4 * n + (i & 3); }
struct Unit { int pm, pn; };
struct Gemm { const bf16_t* A; const bf16_t* Bt; int M, N, K; };
struct StaticOrder {
    int nM, nN, nwg, G, c;
    __host__ __device__ void init(int M, int N, int G_, int c_) { nM = M / BM; nN = N / BM; nwg = nM * nN; G = G_; c = c_; }
    __host__ __device__ bool next(int i, Unit& u) const {
        const long L = (long)i * G + c; if (L >= nwg) return false;
        int wgid = (int)L; { const int q = nwg / NXCD, r = nwg % NXCD, xcd = wgid % NXCD, off = wgid / NXCD; wgid = (xcd < r ? xcd * (q + 1) : r * (q + 1) + (xcd - r) * q) + off; }
        const int nig = WGM * nN, gid = wgid / nig, fm = gid * WGM, gsz = (nM - fm) < WGM ? (nM - fm) : WGM;
        u.pm = fm + ((wgid % nig) % gsz); u.pn = (wgid % nig) / gsz; return true;
    }
    __device__ __forceinline__ void a_ready(const Unit&) const {}
    __device__ __forceinline__ void done(const Unit&) const {}
};
__device__ __forceinline__ unsigned cvt_pk_bf16(float lo, float hi) { return pk2(lo, hi); }

template <class Epi, class Sched>
__device__ __forceinline__ void gemm_phase(LAS unsigned char* lds, const Gemm g, const Sched& S, const Epi& E) {
    const int tid = tidx(), wid = __builtin_amdgcn_readfirstlane(tid >> 6), lane = tid & 63, wr = wid >> 2, wc = wid & 3, fr = lane & 15, fq = lane >> 4;
    const int K = g.K, nt = K / BK;
    unsigned voffA[2], voffB[2];
#pragma unroll
    for (int i = 0; i < 2; ++i) { int R, C; stage_rc(tid * 16 + i * 8192, R, C); const int Rb = Epi::PERM ? ((R & ~31) + perm32(R & 31)) : R;
        voffA[i] = (unsigned)(R * K + C) * 2u; voffB[i] = (unsigned)(Rb * K + C) * 2u; }
    const size_t kstep = (size_t)(BK * 2);
    const size_t hstep = (size_t)HALF * K * 2;
    const size_t tstep = 2 * hstep;
    const unsigned ldsw = (unsigned)wid * 1024u;
    const int aoff = lds_byte(wr * 64 + fr, fq * 8), boff = lds_byte(wc * 32 + fr, fq * 8);
#define PG8_SA(b, h) (((b) * 2 + (h)) * HTB)
#define PG8_SB(b, h) ((4 + (b) * 2 + (h)) * HTB)
#define PG8_STAGE(bufoff, gbase, voff) do { _Pragma("unroll") for (int _i = 0; _i < 2; ++_i) \
        __builtin_amdgcn_global_load_lds((const unsigned*)((const char*)(gbase) + (voff)[_i]), (LAS unsigned*)(lds + (bufoff) + ldsw + _i * 8192), 16, 0, 0); } while (0)
#define PG8_LDA(dst, b, h) do { _Pragma("unroll") for (int m = 0; m < 4; ++m) _Pragma("unroll") for (int k = 0; k < 2; ++k) dst[m][k] = *(const LAS bf16x8*)(lds + PG8_SA(b, h) + aoff + m * 2048 + k * 1024); } while (0)
#define PG8_LDB(dst, b, h) do { _Pragma("unroll") for (int n = 0; n < 2; ++n) _Pragma("unroll") for (int k = 0; k < 2; ++k) dst[n][k] = *(const LAS bf16x8*)(lds + PG8_SB(b, h) + boff + n * 2048 + k * 1024); } while (0)
#define PG8_MMA(ai, bj, At, Bt) do { __builtin_amdgcn_s_setprio(1); _Pragma("unroll") for (int m = 0; m < 4; ++m) _Pragma("unroll") for (int n = 0; n < 2; ++n) _Pragma("unroll") for (int k = 0; k < 2; ++k) \
        acc[ai][bj][m][n] = __builtin_amdgcn_mfma_f32_16x16x32_bf16(Bt[n][k], At[m][k], acc[ai][bj][m][n], 0, 0, 0); __builtin_amdgcn_s_setprio(0); } while (0)
#define PG8_WAIT_V(n) asm volatile("s_waitcnt vmcnt(" #n ")" ::: "memory")
#define PG8_WAIT_L(n) asm volatile("s_waitcnt lgkmcnt(" #n ")" ::: "memory")
#define PG8_BAR __builtin_amdgcn_s_barrier()
#define PG8_SCHED __builtin_amdgcn_sched_barrier(0)
    Unit cur, nxt; int ui = 0;
    if (!S.next(0, cur)) return;
    f32x4 acc[2][2][4][2];
#pragma unroll
    for (int a = 0; a < 2; ++a)
#pragma unroll
        for (int b = 0; b < 2; ++b)
#pragma unroll
            for (int m = 0; m < 4; ++m)
#pragma unroll
                for (int n = 0; n < 2; ++n) acc[a][b][m][n] = (f32x4){0.f, 0.f, 0.f, 0.f};
    bf16x8 At[4][2], B0[2][2], B1[2][2];
    const char* cA = (const char*)g.A + (size_t)cur.pm * tstep; const char* cB = (const char*)g.Bt + (size_t)cur.pn * tstep;
    S.a_ready(cur);
    PG8_STAGE(PG8_SB(0, 0), cB, voffB); PG8_STAGE(PG8_SA(0, 0), cA, voffA); PG8_STAGE(PG8_SB(0, 1), cB + hstep, voffB); PG8_STAGE(PG8_SA(0, 1), cA + hstep, voffA);
    if (wr == 1) PG8_BAR;
    PG8_WAIT_V(4); PG8_BAR;
    PG8_STAGE(PG8_SB(1, 0), cB + kstep, voffB); PG8_STAGE(PG8_SA(1, 0), cA + kstep, voffA); PG8_STAGE(PG8_SB(1, 1), cB + hstep + kstep, voffB);
    PG8_WAIT_V(6); PG8_BAR;
    for (;;) {
        const bool has_next = S.next(ui + 1, nxt);
        const char* nA = has_next ? (const char*)g.A + (size_t)nxt.pm * tstep : cA; const char* nB = has_next ? (const char*)g.Bt + (size_t)nxt.pn * tstep : cB;
        for (int t = 0; t < nt; t += 2) {
            const bool last = (t == nt - 2);
            const char* a1 = cA + (size_t)(t + 1) * kstep;
            const char* a2 = last ? nA : cA + (size_t)(t + 2) * kstep; const char* b2 = last ? nB : cB + (size_t)(t + 2) * kstep;
            const char* a3 = a2 + kstep; const char* b3 = b2 + kstep;
            if (last && has_next) S.a_ready(nxt);
            PG8_LDB(B0, 0, 0); PG8_SCHED; PG8_LDA(At, 0, 0); PG8_STAGE(PG8_SA(1, 1), a1 + hstep, voffA);
            PG8_WAIT_L(8); PG8_BAR; PG8_WAIT_L(0); PG8_MMA(0, 0, At, B0); PG8_BAR; PG8_SCHED;
            PG8_LDB(B1, 0, 1); PG8_STAGE(PG8_SB(0, 0), b2, voffB);
            PG8_BAR; PG8_WAIT_L(0); PG8_MMA(0, 1, At, B1); PG8_BAR;
            PG8_LDA(At, 0, 1); PG8_STAGE(PG8_SA(0, 0), a2, voffA);
            PG8_BAR; PG8_WAIT_L(0); PG8_MMA(1, 0, At, B0); PG8_BAR; PG8_SCHED;
            PG8_STAGE(PG8_SB(0, 1), b2 + hstep, voffB);
            PG8_WAIT_V(6); PG8_BAR; PG8_MMA(1, 1, At, B1); PG8_BAR;
            PG8_LDB(B0, 1, 0); PG8_SCHED; PG8_LDA(At, 1, 0); PG8_STAGE(PG8_SA(0, 1), a2 + hstep, voffA);
            PG8_WAIT_L(8); PG8_BAR; PG8_WAIT_L(0); PG8_MMA(0, 0, At, B0); PG8_BAR; PG8_SCHED;
            PG8_LDB(B1, 1, 1); PG8_STAGE(PG8_SB(1, 0), b3, voffB);
            PG8_BAR; PG8_WAIT_L(0); PG8_MMA(0, 1, At, B1); PG8_BAR;
            PG8_LDA(At, 1, 1); PG8_STAGE(PG8_SA(1, 0), a3, voffA);
            PG8_BAR; PG8_WAIT_L(0); PG8_MMA(1, 0, At, B0); PG8_BAR; PG8_SCHED;
            PG8_STAGE(PG8_SB(1, 1), b3 + hstep, voffB);
            PG8_WAIT_V(6); PG8_BAR; PG8_MMA(1, 1, At, B1); PG8_BAR;
        }
        E(acc, cur, wr, wc, fr, fq); S.done(cur);
        if (!has_next) break;
#pragma unroll
        for (int a = 0; a < 2; ++a)
#pragma unroll
            for (int b = 0; b < 2; ++b)
#pragma unroll
                for (int m = 0; m < 4; ++m)
#pragma unroll
                    for (int n = 0; n < 2; ++n) acc[a][b][m][n] = (f32x4){0.f, 0.f, 0.f, 0.f};
        cur = nxt; cA = nA; cB = nB; ++ui;
    }
    PG8_WAIT_V(0);
    if (wr == 0) PG8_BAR;
    PG8_BAR;
#undef PG8_SA
#undef PG8_SB
#undef PG8_STAGE
#undef PG8_LDA
#undef PG8_LDB
#undef PG8_MMA
#undef PG8_WAIT_V
#undef PG8_WAIT_L
#undef PG8_BAR
#undef PG8_SCHED
}

struct EpiProj {
    static constexpr bool PERM = true;
    bf16_t* P; float* BA; bf16_t* QKVC; bf16_t* PS;
    __device__ __forceinline__ void operator()(const f32x4 (&acc)[2][2][4][2], const Unit& u, int wr, int wc, int fr, int fq) const {
        const int row0 = u.pm * BM + wr * 64 + fr;
        if (u.pn >= 48 && u.pn < 84) {
#pragma unroll
            for (int bj = 0; bj < 2; ++bj) { const int hh = (u.pn - 48) * 2 + bj, which = hh / 24, g = (hh % 24) >> 3, h = hh & 7, d0 = wc * 32 + 8 * fq;
#pragma unroll
                for (int ai = 0; ai < 2; ++ai)
#pragma unroll
                    for (int m = 0; m < 4; ++m) { const int row = row0 + ai * HALF + m * 16; const f32x4 v0 = acc[ai][bj][m][0], v1 = acc[ai][bj][m][1];
                        bf16_t* dst = row < SEQ ? QKVC + qkvc_row(which, g, h, row) + d0 : PS + (size_t)(row - SEQ) * 9216 + hh * 128 + d0;
                        *(u32x4*)dst = (u32x4){cvt_pk_bf16(v0[0], v0[1]), cvt_pk_bf16(v0[2], v0[3]), cvt_pk_bf16(v1[0], v1[1]), cvt_pk_bf16(v1[2], v1[3])}; } }
        } else if (u.pn < 104) {
            const int col0 = (u.pn < 48 ? u.pn : u.pn - 36) * BM + wc * 32 + 8 * fq;
#pragma unroll
            for (int ai = 0; ai < 2; ++ai)
#pragma unroll
                for (int m = 0; m < 4; ++m) { bf16_t* rowp = P + (size_t)(row0 + ai * HALF + m * 16) * NP + col0;
#pragma unroll
                    for (int bj = 0; bj < 2; ++bj) { const f32x4 v0 = acc[ai][bj][m][0], v1 = acc[ai][bj][m][1];
                        *(u32x4*)(rowp + bj * HALF) = (u32x4){cvt_pk_bf16(v0[0], v0[1]), cvt_pk_bf16(v0[2], v0[3]), cvt_pk_bf16(v1[0], v1[1]), cvt_pk_bf16(v1[2], v1[3])}; } }
        } else if (wc < 2) {
#pragma unroll
            for (int ai = 0; ai < 2; ++ai)
#pragma unroll
                for (int m = 0; m < 4; ++m) { float* rp = BA + (size_t)(row0 + ai * HALF + m * 16) * 64 + wc * 32 + 8 * fq;
                    *(f32x4*)rp = acc[ai][0][m][0]; *(f32x4*)(rp + 4) = acc[ai][0][m][1]; }
        }
    }
};
__device__ __forceinline__ void sig8(const bf16_t* p, float (&s)[8]) {
    const u32x4 g = *(const u32x4*)p;
#pragma unroll
    for (int i = 0; i < 4; ++i) { s[2 * i] = sigmoidf_(bflo(g[i])); s[2 * i + 1] = sigmoidf_(bfhi(g[i])); }
}
struct EpiGateB {
    static constexpr bool PERM = true;
    const bf16_t* P; bf16_t* T;
    __device__ __forceinline__ void operator()(const f32x4 (&acc)[2][2][4][2], const Unit& u, int wr, int wc, int fr, int fq) const {
        const int row0 = u.pm * BM + wr * 64 + fr, col0 = u.pn * BM + wc * 32 + 8 * fq;
#pragma unroll
        for (int ai = 0; ai < 2; ++ai)
#pragma unroll
            for (int m = 0; m < 4; ++m) { const size_t row = (size_t)(row0 + ai * HALF + m * 16);
#pragma unroll
                for (int bj = 0; bj < 2; ++bj) { const f32x4 v0 = acc[ai][bj][m][0], v1 = acc[ai][bj][m][1]; const int c = col0 + bj * HALF;
                    float s[8]; sig8(P + row * NP + C_GB + c, s);
                    *(u32x4*)(T + row * DM + c) = (u32x4){cvt_pk_bf16(v0[0] * s[0], v0[1] * s[1]), cvt_pk_bf16(v0[2] * s[2], v0[3] * s[3]), cvt_pk_bf16(v1[0] * s[4], v1[1] * s[5]), cvt_pk_bf16(v1[2] * s[6], v1[3] * s[7])}; } }
    }
};
struct EpiMerge {
    static constexpr bool PERM = true;
    const bf16_t* P; const bf16_t* T; bf16_t* MG;
    __device__ __forceinline__ void operator()(const f32x4 (&acc)[2][2][4][2], const Unit& u, int wr, int wc, int fr, int fq) const {
        const int row0 = u.pm * BM + wr * 64 + fr, col0 = u.pn * BM + wc * 32 + 8 * fq;
#pragma unroll
        for (int ai = 0; ai < 2; ++ai)
#pragma unroll
            for (int m = 0; m < 4; ++m) { const size_t row = (size_t)(row0 + ai * HALF + m * 16);
#pragma unroll
                for (int bj = 0; bj < 2; ++bj) { const f32x4 v0 = acc[ai][bj][m][0], v1 = acc[ai][bj][m][1]; const int c = col0 + bj * HALF;
                    float s[8]; sig8(P + row * NP + C_GA + c, s);
                    const u32x4 t = *(const u32x4*)(T + row * DM + c);
                    *(u32x4*)(MG + row * DM + c) = (u32x4){cvt_pk_bf16(v0[0] * s[0] + bflo(t[0]), v0[1] * s[1] + bfhi(t[0])), cvt_pk_bf16(v0[2] * s[2] + bflo(t[1]), v0[3] * s[3] + bfhi(t[1])),
                                                           cvt_pk_bf16(v1[0] * s[4] + bflo(t[2]), v1[1] * s[5] + bfhi(t[2])), cvt_pk_bf16(v1[2] * s[6] + bflo(t[3]), v1[3] * s[7] + bfhi(t[3]))}; } }
    }
};
struct EpiOut {
    static constexpr bool PERM = true;
    const float* xp; bf16_t* H;
    __device__ __forceinline__ void operator()(const f32x4 (&acc)[2][2][4][2], const Unit& u, int wr, int wc, int fr, int fq) const {
        const int row0 = u.pm * BM + wr * 64 + fr, col0 = u.pn * BM + wc * 32 + 8 * fq;
#pragma unroll
        for (int ai = 0; ai < 2; ++ai)
#pragma unroll
            for (int m = 0; m < 4; ++m) { const int row = row0 + ai * HALF + m * 16;
                if (row < SEQ) { const float* xr = xp + (size_t)row * DM; bf16_t* hr = H + (size_t)row * DM;
#pragma unroll
                    for (int bj = 0; bj < 2; ++bj) { const int c = col0 + bj * HALF; const f32x4 v0 = acc[ai][bj][m][0] + *(const f32x4*)(xr + c), v1 = acc[ai][bj][m][1] + *(const f32x4*)(xr + c + 4);
                        *(u32x4*)(hr + c) = (u32x4){cvt_pk_bf16(v0[0], v0[1]), cvt_pk_bf16(v0[2], v0[3]), cvt_pk_bf16(v1[0], v1[1]), cvt_pk_bf16(v1[2], v1[3])}; } } }
    }
};
}

struct TileDesc { const float* src; bf16_t* dst; int ld_src, ld_dst, k0, n0src, n0dst; bool zero; };
__device__ __forceinline__ TileDesc tile_desc(const Params& p, const float* w_in, const float* w_pa, const float* w_pb, const float* w_o, int u) {
    constexpr int U0 = 32 * 420, U1 = U0 + 64 * 32, U2 = U1 + 16 * 32;
    TileDesc t; t.zero = false;
    if (u < U0) { const int kt = u & 31, nt = u >> 5, n0 = nt * 64; int ns;
        if (n0 < 12288) ns = n0; else if (n0 < 26624) ns = n0 + 64; else if (n0 < 26688) ns = 12288 + (n0 - 26624); else { ns = 0; t.zero = true; }
        t.src = w_in; t.ld_src = 26688; t.k0 = kt * 64; t.n0src = ns; t.dst = (bf16_t*)(p.ws + WS_BT1); t.ld_dst = 2048; t.n0dst = n0;
    } else if (u < U1) { const int v = u - U0, kt = v & 63, nt = v >> 6; t.src = w_pa; t.ld_src = 2048; t.k0 = kt * 64; t.n0src = nt * 64; t.dst = (bf16_t*)(p.ws + WS_BT2A); t.ld_dst = 4096; t.n0dst = nt * 64;
    } else if (u < U2) { const int v = u - U1, kt = v & 15, nt = v >> 4; t.src = w_pb; t.ld_src = 2048; t.k0 = kt * 64; t.n0src = nt * 64; t.dst = (bf16_t*)(p.ws + WS_BT2B); t.ld_dst = 1024; t.n0dst = nt * 64;
    } else { const int v = u - U2, kt = v & 31, nt = v >> 5; t.src = w_o; t.ld_src = 2048; t.k0 = kt * 64; t.n0src = nt * 64; t.dst = (bf16_t*)(p.ws + WS_BT3); t.ld_dst = 2048; t.n0dst = nt * 64; }
    return t;
}
constexpr int PRO_TILES = 32 * 420 + 64 * 32 + 16 * 32 + 32 * 32;
constexpr int PRO_TILES1 = 32 * 420;
static_assert(PRO_TILES1 % 4 == 0 && PRO_TILES % 4 == 0, "tile batches");
__device__ __forceinline__ void pro_tiles4(const Params& p, LAS unsigned char* lds, int u0, int tid, const float* w_in, const float* w_pa, const float* w_pb, const float* w_o) {
    const int r = tid >> 4, c4 = tid & 15, n = tid >> 3, k8 = tid & 7;
        f32x4 v[4][2];
#pragma unroll
        for (int j = 0; j < 4; ++j) { const int u = u0 + j;
#pragma unroll
            for (int h = 0; h < 2; ++h) v[j][h] = (f32x4){0.f, 0.f, 0.f, 0.f};
            if (u < PRO_TILES) { const TileDesc t = tile_desc(p, w_in, w_pa, w_pb, w_o, u);
                if (!t.zero) {
#pragma unroll
                    for (int h = 0; h < 2; ++h) v[j][h] = *(const f32x4*)(t.src + (size_t)(t.k0 + r + 32 * h) * t.ld_src + t.n0src + 4 * c4); } } }
#pragma unroll
        for (int j = 0; j < 4; ++j) { LAS float* tile = (LAS float*)(lds + j * 16640);
#pragma unroll
            for (int h = 0; h < 2; ++h)
#pragma unroll
                for (int i = 0; i < 4; ++i) tile[(r + 32 * h) * 65 + 4 * c4 + i] = v[j][h][i]; }
        __syncthreads();
#pragma unroll
        for (int j = 0; j < 4; ++j) { const int u = u0 + j;
            if (u < PRO_TILES) { const TileDesc t = tile_desc(p, w_in, w_pa, w_pb, w_o, u); const LAS float* tile = (const LAS float*)(lds + j * 16640); float f[8];
#pragma unroll
                for (int i = 0; i < 8; ++i) f[i] = tile[(8 * k8 + i) * 65 + n];
                *(u32x4*)(t.dst + (size_t)(t.n0dst + n) * t.ld_dst + t.k0 + 8 * k8) = (u32x4){pk2(f[0], f[1]), pk2(f[2], f[3]), pk2(f[4], f[5]), pk2(f[6], f[7])}; } }
        __syncthreads();
}
__device__ __forceinline__ void ph_prologue(const Params& p, LAS unsigned char* lds, int bid, int nb) {
    const int tid = tidx(), r = tid >> 4, c4 = tid & 15, n = tid >> 3, k8 = tid & 7;
    const float *w_in = p.w_in, *w_pa = p.w_proj_a, *w_pb = p.w_proj_b, *w_o = p.w_out;
    asm volatile("" : "+s"(w_in), "+s"(w_pa), "+s"(w_pb), "+s"(w_o));
    const int ulim = nb == 256 ? PRO_TILES1 : PRO_TILES;
    for (int u0 = bid * 4; u0 < ulim; u0 += nb * 4) pro_tiles4(p, lds, u0, tid, w_in, w_pa, w_pb, w_o);
    const int lane = tid & 63, gw = __builtin_amdgcn_readfirstlane(tid >> 6) * nb + bid, nw = nb * 8;
    for (int row = gw; row < MP; row += nw) {
        bf16_t* xn = (bf16_t*)(p.ws + WS_XN) + (size_t)row * DM;
        if (row < MR) { const float* xr = row < SEQ ? p.x_prompt + (size_t)row * DM : p.x_sample + (size_t)(row - SEQ) * DM;
            f32x4 v[8]; float ss = 0.f;
#pragma unroll
            for (int i = 0; i < 8; ++i) { v[i] = *(const f32x4*)(xr + i * 256 + lane * 4); ss += v[i][0] * v[i][0] + v[i][1] * v[i][1] + v[i][2] * v[i][2] + v[i][3] * v[i][3]; }
            ss = wave_sum(ss); const float rr = rsqrtf(ss * (1.f / DM) + EPS);
#pragma unroll
            for (int i = 0; i < 8; ++i) { const f32x4 w = *(const f32x4*)(p.ln_in + i * 256 + lane * 4);
                *(u32x2*)(xn + i * 256 + lane * 4) = (u32x2){pk2(v[i][0] * rr * w[0], v[i][1] * rr * w[1]), pk2(v[i][2] * rr * w[2], v[i][3] * rr * w[3])}; }
        } else {
#pragma unroll
            for (int i = 0; i < 8; ++i) *(u32x2*)(xn + i * 256 + lane * 4) = (u32x2){0u, 0u};
            bf16_t* oa = (bf16_t*)(p.ws + WS_OA) + (size_t)row * 4096; bf16_t* ob = (bf16_t*)(p.ws + WS_OB) + (size_t)row * 1024;
#pragma unroll
            for (int i = 0; i < 16; ++i) *(u32x2*)(oa + i * 256 + lane * 4) = (u32x2){0u, 0u};
#pragma unroll
            for (int i = 0; i < 4; ++i) *(u32x2*)(ob + i * 256 + lane * 4) = (u32x2){0u, 0u};
        }
    }
}

template <int WIN> __device__ __forceinline__ void kvcopy_one(const float* cache, float* dst, int cb, int ncb, int tid) {
    constexpr int NR = 32 * (WIN - 4);
    f32x4 va[12], vb[12];
#define KV_ROWS(R0_, src_, dst_) do { _Pragma("unroll") for (int k = 0; k < 12; ++k) { int R = (R0_) + k * ncb; R = R < NR ? R : NR - 1; const int b = R / (WIN - 4), j = R - b * (WIN - 4); \
        src_[k] = cache + ((size_t)(b * WIN + j + 4) * 512 + tid) * 4; dst_[k] = dst + ((size_t)(b * WIN + j) * 512 + tid) * 4; } } while (0)
    const float* sa[12]; float* da[12]; const float* sb[12]; float* db[12];
    int R0 = cb;
    KV_ROWS(R0, sa, da);
#pragma unroll
    for (int k = 0; k < 12; ++k) va[k] = *(const f32x4*)sa[k];
    for (; R0 < NR; R0 += 24 * ncb) {
        KV_ROWS(R0 + 12 * ncb, sb, db);
#pragma unroll
        for (int k = 0; k < 12; ++k) vb[k] = *(const f32x4*)sb[k];
#pragma unroll
        for (int k = 0; k < 12; ++k) *(f32x4*)da[k] = va[k];
        KV_ROWS(R0 + 24 * ncb, sa, da);
#pragma unroll
        for (int k = 0; k < 12; ++k) va[k] = *(const f32x4*)sa[k];
#pragma unroll
        for (int k = 0; k < 12; ++k) *(f32x4*)db[k] = vb[k];
    }
#undef KV_ROWS
}
__device__ __forceinline__ void ph_kvcopy(const Params& p, int cb, int ncb) {
    const int tid = tidx();
    kvcopy_one<128>(p.c128, p.out + O_KV128S, cb, ncb, tid);
    kvcopy_one<512>(p.c512, p.out + O_KV512S, cb, ncb, tid);
    kvcopy_one<2048>(p.c2048, p.out + O_KV2048S, cb, ncb, tid);
}

__device__ __forceinline__ void ph_prep(const Params& p, int bid, int nb) {
    const bf16_t* P = (const bf16_t*)(p.ws + WS_P); bf16_t* CV = (bf16_t*)(p.ws + WS_CV);
    const float* BA = (const float*)(p.ws + WS_BA); float* BG = (float*)(p.ws + WS_BG);
    const int tid = tidx(), lane = tid & 63, gw = __builtin_amdgcn_readfirstlane(tid >> 6) * nb + bid, nw = nb * 8;
    const float *pc128 = p.c128, *pc512 = p.c512, *pc2048 = p.c2048;
    asm volatile("" : "+s"(pc128), "+s"(pc512), "+s"(pc2048));
    for (int task0 = gw; task0 < NSAMP * 64; task0 += 4 * nw) {
        float x0[4][4], x1[4][4]; f32x2 w[4][4];
#pragma unroll
        for (int u = 0; u < 4; ++u) { const int task = task0 + u * nw;
            if (task < NSAMP * 64) { const int row = SEQ + (task >> 6), seg = task & 63, c = seg * 128 + 2 * lane, b = (row - SEQ) >> 2, t = (row - SEQ) & 3;
#pragma unroll
                for (int i = 0; i < 4; ++i) { w[u][i] = *(const f32x2*)(p.conv_w + i * 8192 + c); const int j = t + i;
                    if (j < 3) { const f32x2 sv = *(const f32x2*)(p.state_conv + ((size_t)b * 3 + j) * 8192 + c); x0[u][i] = sv[0]; x1[u][i] = sv[1]; }
                    else { const unsigned q = *(const unsigned*)(P + (size_t)(SEQ + 4 * b + j - 3) * NP + c); x0[u][i] = bflo(q); x1[u][i] = bfhi(q); } } } }
#pragma unroll
        for (int u = 0; u < 4; ++u) { const int task = task0 + u * nw;
            if (task < NSAMP * 64) { const int row = SEQ + (task >> 6), seg = task & 63, c = seg * 128 + 2 * lane;
                float y0 = 0.f, y1 = 0.f;
#pragma unroll
                for (int i = 0; i < 4; ++i) { y0 += x0[u][i] * w[u][i][0]; y1 += x1[u][i] * w[u][i][1]; }
                y0 = siluf_(y0); y1 = siluf_(y1);
                if (seg < 32) { const float ss = wave_sum(y0 * y0 + y1 * y1); float r = rsqrtf(ss + EPS); if (seg < 16) r *= 0.08838834764831845f; y0 *= r; y1 *= r; }
                *(unsigned*)(CV + (size_t)row * 8192 + c) = pk2(y0, y1); } }
    }
    for (int i = SEQ * 32 + bid * 512 + tid; i < MR * 32; i += nb * 512) { const int row = i >> 5, h = i & 31;
        const float b = BA[(size_t)row * 64 + h], a = BA[(size_t)row * 64 + 32 + h] + p.dt_bias[h];
        const float sp = a > 20.f ? a : log1pf(expf(a));
        BG[(size_t)row * 64 + h] = 1.f / (1.f + expf(-b)); BG[(size_t)row * 64 + 32 + h] = -expf(p.a_log[h]) * sp; }
    for (int i = bid * 512 + tid; i < 3 * 8192; i += nb * 512) { const int r = i >> 13, c = i & 8191; p.out[O_CONVP + i] = bf2f(P[(size_t)(SEQ - 3 + r) * NP + c]); }
    for (int i = bid * 512 + tid; i < 32 * 3 * 8192; i += nb * 512) { const int c = i & 8191, r = (i >> 13) % 3, b = i / (3 * 8192); p.out[O_CONVS + i] = bf2f(P[(size_t)(SEQ + 4 * b + 1 + r) * NP + c]); }
    { const bf16_t* QKVC = (const bf16_t*)(p.ws + WS_QKVC); const bf16_t* PS = (const bf16_t*)(p.ws + WS_PS);
      constexpr int RP = 128 + 512 + 2048, NT = 2 * RP + 2 * 32 * 12;
      for (int task = gw; task < NT; task += nw) {
        const int half = task & 1; int r = task >> 1; float* dst;
        if (r < RP) { int g, win, j; size_t ob; if (r < 128) { g = 0; win = 128; j = r; ob = O_KV128P; } else if (r < 640) { g = 1; win = 512; j = r - 128; ob = O_KV512P; } else { g = 2; win = 2048; j = r - 640; ob = O_KV2048P; }
            dst = p.out + ob + (size_t)j * 2048 + half * 1024; const int tok = SEQ - win + j;
#pragma unroll
            for (int i = 0; i < 4; ++i) { const int e = i * 256 + lane * 4, h = e >> 7; const u32x2 u = *(const u32x2*)(QKVC + qkvc_row(1 + half, g, h, tok) + (e & 127)); *(f32x4*)(dst + e) = (f32x4){bflo(u[0]), bfhi(u[0]), bflo(u[1]), bfhi(u[1])}; }
        } else { r -= RP; const int b = r / 12, q = r % 12, g = q >> 2, t = q & 3, win = g == 0 ? 128 : (g == 1 ? 512 : 2048); const size_t ob = g == 0 ? O_KV128S : (g == 1 ? O_KV512S : O_KV2048S);
            dst = p.out + ob + ((size_t)b * win + (win - 4 + t)) * 2048 + half * 1024; const bf16_t* srcb = PS + (size_t)(4 * b + t) * 9216 + (1 + half) * 3072 + g * 1024;
#pragma unroll
            for (int i = 0; i < 4; ++i) { const u32x2 u = *(const u32x2*)(srcb + i * 256 + lane * 4); *(f32x4*)(dst + i * 256 + lane * 4) = (f32x4){bflo(u[0]), bfhi(u[0]), bflo(u[1]), bfhi(u[1])}; }
        }
      } }
}

__device__ __forceinline__ float dq_sum(float v) { v += __shfl_xor(v, 16); v += __shfl_xor(v, 32); return v; }
__device__ __forceinline__ void delta_rec_sample_task(const Params& p, int task, int lane) {
    asm volatile("" : "+v"(lane));
    const bf16_t* CV = (const bf16_t*)(p.ws + WS_CV); const float* BG = (const float*)(p.ws + WS_BG); bf16_t* OA = (bf16_t*)(p.ws + WS_OA);
    const int b = task >> 6, hv = (task >> 1) & 31, half = task & 1, cg = lane & 15, dq = lane >> 4, hk = hv >> 1, e0 = 64 * half + 4 * cg;
    const float* sin = p.state_delta + ((size_t)b * 32 + hv) * 16384 + (size_t)(dq * 32) * 128 + e0;
    float* sout = p.out + O_DELTAS + ((size_t)b * 32 + hv) * 16384 + (size_t)(dq * 32) * 128 + e0;
    f32x4 s[32];
#pragma unroll
    for (int i = 0; i < 32; ++i) s[i] = *(const f32x4*)(sin + (size_t)i * 128);
#pragma unroll 1
    for (int t = 0; t < 4; ++t) {
        const size_t row = (size_t)(SEQ + 4 * b + t);
        const bf16_t* kp = CV + row * 8192 + C_KA + hk * 128 + dq * 32; const bf16_t* qp = CV + row * 8192 + C_QA + hk * 128 + dq * 32;
        u32x4 kk[4], qq[4];
#pragma unroll
        for (int i = 0; i < 4; ++i) { kk[i] = *(const u32x4*)(kp + 8 * i); qq[i] = *(const u32x4*)(qp + 8 * i); }
        const u32x2 vv = *(const u32x2*)(CV + row * 8192 + C_VA + hv * 128 + e0);
        const float beta = BG[row * 64 + hv], eg = expf(BG[row * 64 + 32 + hv]);
        f32x4 dot = (f32x4){0.f, 0.f, 0.f, 0.f};
#pragma unroll
        for (int i = 0; i < 16; ++i) { const float k0 = bflo(kk[i >> 2][i & 3]), k1 = bfhi(kk[i >> 2][i & 3]); s[2 * i] *= eg; s[2 * i + 1] *= eg; dot += s[2 * i] * k0 + s[2 * i + 1] * k1; }
#pragma unroll
        for (int c = 0; c < 4; ++c) dot[c] = dq_sum(dot[c]);
        const f32x4 vn = ((f32x4){bflo(vv[0]), bfhi(vv[0]), bflo(vv[1]), bfhi(vv[1])} - dot) * beta;
        f32x4 o = (f32x4){0.f, 0.f, 0.f, 0.f};
#pragma unroll
        for (int i = 0; i < 16; ++i) { const float k0 = bflo(kk[i >> 2][i & 3]), k1 = bfhi(kk[i >> 2][i & 3]), q0 = bflo(qq[i >> 2][i & 3]), q1 = bfhi(qq[i >> 2][i & 3]);
            s[2 * i] += vn * k0; s[2 * i + 1] += vn * k1; o += s[2 * i] * q0 + s[2 * i + 1] * q1; }
#pragma unroll
        for (int c = 0; c < 4; ++c) o[c] = dq_sum(o[c]);
        if (dq == 0) *(u32x2*)(OA + row * 4096 + hv * 128 + e0) = (u32x2){pk2(o[0], o[1]), pk2(o[2], o[3])};
    }
#pragma unroll
    for (int i = 0; i < 32; ++i) *(f32x4*)(sout + (size_t)i * 128) = s[i];
}
__device__ __forceinline__ void ph_delta_rec_sample(const Params& p, int bid, int nb) {
    const int tid = tidx(), lane = tid & 63, gw = __builtin_amdgcn_readfirstlane(tid >> 6) * nb + bid, nw = nb * 8;
    for (int task = gw; task < 32 * 32 * 2; task += nw) delta_rec_sample_task(p, task, lane);
}

typedef short s16x4 __attribute__((ext_vector_type(4)));
typedef float f32x16 __attribute__((ext_vector_type(16)));
__device__ __forceinline__ unsigned off_b(unsigned row, unsigned ch) { return 256u * row + 16u * (ch ^ (((row & 3) << 2) | ((row >> 2) & 3))); }
__device__ __forceinline__ unsigned tr_read_addr(unsigned lane, unsigned c, unsigned ks, unsigned t) {
    const unsigned h = lane >> 5, blk = (lane >> 4) & 1, q = (lane & 15) >> 2, p = lane & 3;
    return off_b(16 * ks + 8 * h + 4 * t + q, 4 * c + 2 * blk + (p >> 1)) + 8 * (p & 1);
}
__device__ __forceinline__ s16x4 lds_tr(LAS unsigned char* p) { return __builtin_bit_cast(s16x4, __builtin_amdgcn_ds_read_tr16_b64_v4i16((LAS s16x4*)p)); }
__device__ __forceinline__ bf16x8 cat8(s16x4 a, s16x4 b) { return (bf16x8){a[0], a[1], a[2], a[3], b[0], b[1], b[2], b[3]}; }
__device__ __forceinline__ unsigned cvtpk(float lo, float hi) { return pk2(lo, hi); }
__device__ __forceinline__ int afrag_off(int row, int col, int nkb) { return ((row >> 4) * nkb + (col >> 5)) * 512 + (16 * ((col >> 2) & 3) + (row & 15)) * 8 + 4 * ((col >> 4) & 1) + (col & 3); }
__device__ __forceinline__ int u_off(int c, int e) { return ((e >> 4) * 64 + 16 * ((c >> 2) & 3) + (e & 15)) * 8 + (c >> 4) * 4 + (c & 3); }
__device__ __forceinline__ float rdlane(float v, int l) { return __int_as_float(__builtin_amdgcn_readlane(__float_as_int(v), l)); }
#define LDS_WAIT() asm volatile("s_waitcnt lgkmcnt(0)" ::: "memory")

#define DPPF(v, ctrl) __int_as_float(__builtin_amdgcn_update_dpp(0, __float_as_int(v), (ctrl), 0xF, 0xF, true))
__device__ __forceinline__ float row16_sum(float v) {
    v += DPPF(v, 0xB1);
    v += DPPF(v, 0x4E);
    v += DPPF(v, 0x141);
    v += DPPF(v, 0x140);
    return v;
}
__device__ __forceinline__ float scan32_incl(float v) {
    v += DPPF(v, 0x111); v += DPPF(v, 0x112); v += DPPF(v, 0x114); v += DPPF(v, 0x118);
    v += __int_as_float(__builtin_amdgcn_update_dpp(0, __float_as_int(v), 0x142, 0xA, 0xF, true));
    return v;
}
__device__ __forceinline__ void conv_load(const Params& p, size_t row0, int col0, int lane, u32x4 (&x)[11]) {
    asm volatile("" : "+v"(lane));
    const bf16_t* P = (const bf16_t*)(p.ws + WS_P); const int cg = lane & 15, rg = lane >> 4, cv = col0 + 8 * cg;
#pragma unroll
    for (int i = 0; i < 11; ++i) { const long r = (long)row0 + 8 * rg - 3 + i; x[i] = r >= 0 ? *(const u32x4*)(P + (size_t)r * NP + cv) : (u32x4){0u, 0u, 0u, 0u}; }
}
template <int MODE> __device__ __forceinline__ void conv_comp(const Params& p, int col0, const u32x4 (&x)[11], LAS unsigned char* ldst, int lane) {
    asm volatile("" : "+v"(lane));
    const int cg = lane & 15, rg = lane >> 4, cv = col0 + 8 * cg;
    f32x4 w[4][2];
#pragma unroll
    for (int i = 0; i < 4; ++i) { w[i][0] = *(const f32x4*)(p.conv_w + i * 8192 + cv); w[i][1] = *(const f32x4*)(p.conv_w + i * 8192 + cv + 4); }
#pragma unroll
    for (int r = 0; r < 8; ++r) { float y[8];
#pragma unroll
        for (int e = 0; e < 8; ++e) y[e] = 0.f;
#pragma unroll
        for (int t = 0; t < 4; ++t)
#pragma unroll
            for (int q = 0; q < 4; ++q) { y[2 * q] += bflo(x[r + t][q]) * w[t][q >> 1][(2 * q) & 3]; y[2 * q + 1] += bfhi(x[r + t][q]) * w[t][q >> 1][(2 * q + 1) & 3]; }
        float ss = 0.f;
#pragma unroll
        for (int e = 0; e < 8; ++e) { y[e] = siluf_(y[e]); ss += y[e] * y[e]; }
        if (MODE != 0) { ss = row16_sum(ss);
            const float rs = rsqrtf(ss + EPS) * (MODE == 2 ? 0.08838834764831845f : 1.f);
#pragma unroll
            for (int e = 0; e < 8; ++e) y[e] *= rs; }
        *(LAS u32x4*)(ldst + off_b(8 * rg + r, cg)) = (u32x4){pk2(y[0], y[1]), pk2(y[2], y[3]), pk2(y[4], y[5]), pk2(y[6], y[7])}; }
}
struct HeadSc { float beta, G, eG, ekd; };
__device__ __forceinline__ void sa_head1(const Params& p, int n, int hv, float braw, float araw0, const LAS unsigned char* ldq, LAS float* sc, const f32x16& KKr, const f32x16& QKr, f32x16& L, HeadSc& hs, int lane) {
    asm volatile("" : "+v"(lane));
    unsigned char* rec = p.ws + WS_REC + ((size_t)hv * NCHUNK + n) * RECB;
    const int t = lane & 31, hi = lane >> 5;
    const float araw = araw0 + p.dt_bias[hv];
    const float beta = 1.f / (1.f + expf(-braw)); float G = -expf(p.a_log[hv]) * (araw > 20.f ? araw : log1pf(expf(araw)));
    G = scan32_incl(G);
    const float Glast = rdlane(G, 31), eG = expf(G), ekd = expf(Glast - G);
    if (lane < 32) { sc[t] = G; sc[32 + t] = beta; sc[64 + t] = eG; sc[96 + t] = ekd;
        *(float*)(rec + REC_GL + 4 * t) = eG; *(float*)(rec + REC_GL + 128 + 4 * t) = ekd; }
    hs.beta = beta; hs.G = G; hs.eG = eG; hs.ekd = ekd;
    {
        bf16_t* INf = (bf16_t*)(rec + REC_IN);
        unsigned ipk[4][2];
#pragma unroll
        for (int xg = 0; xg < 4; ++xg) { const f32x4 Gr = *(const LAS f32x4*)(sc + 8 * xg + 4 * hi), Br = *(const LAS f32x4*)(sc + 32 + 8 * xg + 4 * hi); float iv[4];
#pragma unroll
            for (int b = 0; b < 4; ++b) { const int r = 8 * xg + 4 * hi + b;
                L[4 * xg + b] = (t < r) ? Br[b] * KKr[4 * xg + b] * __expf(Gr[b] - G) : 0.f;
                iv[b] = (r <= t) ? QKr[4 * xg + b] * __expf(G - Gr[b]) : 0.f; }
            ipk[xg][0] = cvtpk(iv[0], iv[1]); ipk[xg][1] = cvtpk(iv[2], iv[3]); }
#pragma unroll
        for (int xg = 0; xg < 2; ++xg) *(u32x4*)(INf + afrag_off(t, 8 * xg + 4 * hi, 1)) = (u32x4){ipk[xg][0], ipk[xg][1], ipk[xg + 2][0], ipk[xg + 2][1]};
    }
}
__device__ __forceinline__ void sa_head2(const Params& p, int n, int hv, LAS unsigned char* ldk, LAS unsigned char* lds2, const LAS float* sc, const f32x16& Lacc, const HeadSc& hs, int lane) {
    asm volatile("" : "+v"(lane));
    unsigned char* rec = p.ws + WS_REC + ((size_t)hv * NCHUNK + n) * RECB;
    const int t = lane & 31, hi = lane >> 5; const size_t row0 = (size_t)n * CH;
    u32x4 xv[11]; conv_load(p, row0, C_VA + hv * 128, lane, xv);
    __builtin_amdgcn_sched_barrier(0);
    float T[32];
#pragma unroll
    for (int j = 31; j >= 0; --j) { float a = (t == j) ? 1.f : 0.f;
#pragma unroll
        for (int kk = j + 1; kk < 32; ++kk) a -= T[kk] * rdlane(Lacc[(kk & 3) + 4 * (kk >> 3)], j + 32 * ((kk >> 2) & 1));
        T[j] = a; }
    unsigned P2[16], P3[16];
#pragma unroll
    for (int m = 0; m < 16; ++m) { const float b0 = rdlane(hs.beta, 2 * m), b1 = rdlane(hs.beta, 2 * m + 1), e0 = rdlane(hs.eG, 2 * m), e1 = rdlane(hs.eG, 2 * m + 1);
        P3[m] = cvtpk(T[2 * m] * b0, T[2 * m + 1] * b1); P2[m] = cvtpk(T[2 * m] * b0 * e0, T[2 * m + 1] * b1 * e1); }
    bf16x8 F2[2], F3[2];
#pragma unroll
    for (int ks = 0; ks < 2; ++ks) { u32x4 a, b;
#pragma unroll
        for (int i = 0; i < 4; ++i) { a[i] = hi ? P2[8 * ks + 4 + i] : P2[8 * ks + i]; b[i] = hi ? P3[8 * ks + 4 + i] : P3[8 * ks + i]; }
        F2[ks] = __builtin_bit_cast(bf16x8, a); F3[ks] = __builtin_bit_cast(bf16x8, b); }
    { bf16_t* Wf = (bf16_t*)(rec + REC_W);
#pragma unroll
      for (int mt = 0; mt < 4; ++mt) { f32x16 acc;
#pragma unroll
          for (int x = 0; x < 16; ++x) acc[x] = 0.f;
#pragma unroll
          for (int ks = 0; ks < 2; ++ks) acc = __builtin_amdgcn_mfma_f32_32x32x16_bf16(cat8(lds_tr(ldk + tr_read_addr(lane, mt, ks, 0)), lds_tr(ldk + tr_read_addr(lane, mt, ks, 1))), F2[ks], acc, 0, 0, 0);
#pragma unroll
          for (int xg = 0; xg < 2; ++xg) *(u32x4*)(Wf + afrag_off(t, 32 * mt + 8 * xg + 4 * hi, 4)) = (u32x4){cvtpk(-acc[4 * xg], -acc[4 * xg + 1]), cvtpk(-acc[4 * xg + 2], -acc[4 * xg + 3]), cvtpk(-acc[4 * xg + 8], -acc[4 * xg + 9]), cvtpk(-acc[4 * xg + 10], -acc[4 * xg + 11])}; } }
    LDS_WAIT();
    conv_comp<0>(p, C_VA + hv * 128, xv, lds2, lane);
    LDS_WAIT();
    { bf16_t* Uf = (bf16_t*)(rec + REC_U);
#pragma unroll
      for (int nt = 0; nt < 4; ++nt) { f32x16 acc;
#pragma unroll
          for (int x = 0; x < 16; ++x) acc[x] = 0.f;
#pragma unroll
          for (int ks = 0; ks < 2; ++ks) acc = __builtin_amdgcn_mfma_f32_32x32x16_bf16(F3[ks], cat8(lds_tr(lds2 + tr_read_addr(lane, nt, ks, 0)), lds_tr(lds2 + tr_read_addr(lane, nt, ks, 1))), acc, 0, 0, 0);
#pragma unroll
          for (int xg = 0; xg < 2; ++xg) *(u32x4*)(Uf + u_off(8 * xg + 4 * hi, 32 * nt + t)) = (u32x4){cvtpk(acc[4 * xg], acc[4 * xg + 1]), cvtpk(acc[4 * xg + 2], acc[4 * xg + 3]), cvtpk(acc[4 * xg + 8], acc[4 * xg + 9]), cvtpk(acc[4 * xg + 10], acc[4 * xg + 11])}; } }
    LDS_WAIT();
}
__device__ __forceinline__ void stage_a_unit(const Params& p, int n, int hk, LAS unsigned char* ldsw, int lane) {
    asm volatile("" : "+v"(lane));
    LAS unsigned char* ldk = ldsw; LAS float* sc0 = (LAS float*)(ldsw + 8192); LAS float* sc1 = (LAS float*)(ldsw + 8704); LAS unsigned char* ldq = ldsw + 9216;
    const int t = lane & 31, hi = lane >> 5; const size_t row0 = (size_t)n * CH;
    float braw[2], araw[2];
    { u32x4 xk[11], xq[11]; conv_load(p, row0, C_KA + hk * 128, lane, xk); conv_load(p, row0, C_QA + hk * 128, lane, xq);
      const float* BA = (const float*)(p.ws + WS_BA) + (row0 + t) * 64 + 2 * hk;
      braw[0] = BA[0]; braw[1] = BA[1]; araw[0] = BA[32]; araw[1] = BA[33];
      __builtin_amdgcn_sched_barrier(0);
      conv_comp<1>(p, C_KA + hk * 128, xk, ldk, lane);
      conv_comp<2>(p, C_QA + hk * 128, xq, ldq, lane); }
    LDS_WAIT();
    f32x16 KKr, QKr;
#pragma unroll
    for (int x = 0; x < 16; ++x) { KKr[x] = 0.f; QKr[x] = 0.f; }
#pragma unroll
    for (int s = 0; s < 8; ++s) { const bf16x8 kf = *(const LAS bf16x8*)(ldk + off_b(t, 2 * s + hi)), qf = *(const LAS bf16x8*)(ldq + off_b(t, 2 * s + hi));
        KKr = __builtin_amdgcn_mfma_f32_32x32x16_bf16(kf, kf, KKr, 0, 0, 0); QKr = __builtin_amdgcn_mfma_f32_32x32x16_bf16(kf, qf, QKr, 0, 0, 0); }
    { unsigned char* reck = p.ws + WS_REC + ((size_t)(2 * hk) * NCHUNK + n) * RECB;
      { const int rr = lane & 15, qq = lane >> 4;
#pragma unroll
        for (int ct = 0; ct < 2; ++ct) { const int c = 16 * ct + rr;
#pragma unroll
            for (int kb = 0; kb < 4; ++kb) { const u32x2 a = *(const LAS u32x2*)(ldq + off_b(c, 4 * kb + (qq >> 1)) + 8 * (qq & 1)), b = *(const LAS u32x2*)(ldq + off_b(c, 4 * kb + 2 + (qq >> 1)) + 8 * (qq & 1));
                *(u32x4*)(reck + REC_QG + (ct * 4 + kb) * 1024 + lane * 16) = (u32x4){a[0], a[1], b[0], b[1]}; } } }
      { const unsigned qg = lane >> 4, qq = (lane & 15) >> 2, pp = lane & 3;
#pragma unroll
        for (int dt = 0; dt < 8; ++dt) { const s16x4 a0 = lds_tr(ldk + off_b(4 * qg + qq, 2 * dt + (pp >> 1)) + 8 * (pp & 1)), a1 = lds_tr(ldk + off_b(16 + 4 * qg + qq, 2 * dt + (pp >> 1)) + 8 * (pp & 1));
            *(bf16x8*)(reck + REC_KD + dt * 1024 + lane * 16) = cat8(a0, a1); } } }
    f32x16 L0, L1; HeadSc h0, h1;
    sa_head1(p, n, 2 * hk, braw[0], araw[0], ldq, sc0, KKr, QKr, L0, h0, lane);
    sa_head1(p, n, 2 * hk + 1, braw[1], araw[1], ldq, sc1, KKr, QKr, L1, h1, lane);
    sa_head2(p, n, 2 * hk, ldk, ldq, sc0, L0, h0, lane);
    sa_head2(p, n, 2 * hk + 1, ldk, ldq, sc1, L1, h1, lane);
}
__device__ __forceinline__ void ph_stage_a(const Params& p, LAS unsigned char* lds, int bid, int nb) {
    const int lane = tidx() & 63, wid = __builtin_amdgcn_readfirstlane(tidx() >> 6), gw = wid * nb + bid, nw = nb * 8;
    LAS unsigned char* ldsw = lds + wid * 17408;
    for (int task = gw; task < NCHUNK * 16; task += nw) stage_a_unit(p, NCHUNK - 1 - (task >> 4), task & 15, ldsw, lane);
}

constexpr int SCAN_WGS = 64, SCAN_OST = 4 * REC_DMA;
__device__ __forceinline__ void ph_scan(const Params& p, LAS unsigned char* lds, int bid) {
    const int tid = tidx(), lane = tid & 63, wid = __builtin_amdgcn_readfirstlane(tid >> 6), hv = 4 * (bid & 7) + ((bid >> 4) & 2) + ((bid >> 4) & 1), half = (bid >> 3) & 1;
    const unsigned char* rec0 = p.ws + WS_REC + (size_t)hv * NCHUNK * RECB; constexpr size_t RSTR = (size_t)RECB;
    if (wid >= 4) {
        const int lw = wid - 4;
        bf16_t* OA = (bf16_t*)(p.ws + WS_OA) + (size_t)(8 * lw + (lane >> 3)) * 4096 + hv * 128 + half * 64 + (lane & 7) * 8;
        const LAS unsigned char* ost = lds + SCAN_OST + (8 * lw + (lane >> 3)) * 128 + (lane & 7) * 16;
        int poff[8], loff[8];
        const int kdelta = -(hv & 1) * (int)(NCHUNK * RECB);
#pragma unroll
        for (int i = 0; i < 8; ++i) { const int idx = lw * 8 + i; loff[i] = idx < 26 ? idx * 1024 : (idx < 30 ? REC_U + (4 * half + idx - 26) * 1024 : REC_GL);
            poff[i] = loff[i] + (((idx >= 8 && idx < 16) || (idx >= 18 && idx < 26)) ? kdelta : 0); }
#define SCAN_DMA(n_) do { const int nn_ = (n_) < NCHUNK ? (n_) : NCHUNK - 1; const unsigned char* src_ = rec0 + (size_t)nn_ * RSTR + lane * 16; LAS unsigned char* dst_ = lds + ((n_) & 3) * REC_DMA; \
        _Pragma("unroll") for (int i_ = 0; i_ < 8; ++i_) __builtin_amdgcn_global_load_lds((const unsigned*)(src_ + poff[i_]), (LAS unsigned*)(dst_ + loff[i_]), 16, 0, 0); } while (0)
        SCAN_DMA(0); SCAN_DMA(1); SCAN_DMA(2);
        asm volatile("s_waitcnt vmcnt(16)" ::: "memory");
        __builtin_amdgcn_s_barrier();
        asm volatile("" ::: "memory");
        SCAN_DMA(3);
#define SCAN_STEP(n_, W_) do { asm volatile("s_waitcnt vmcnt(" #W_ ")" ::: "memory"); __builtin_amdgcn_s_barrier(); asm volatile("" ::: "memory"); \
        const u32x4 ov_ = *(const LAS u32x4*)(ost + (((n_) - 1) & 1) * 4096); *(u32x4*)(OA + (size_t)((n_) - 1) * CH * 4096) = ov_; SCAN_DMA((n_) + 3); } while (0)
        SCAN_STEP(1, 16); SCAN_STEP(2, 17);
        for (int n = 3; n < NCHUNK; ++n) SCAN_STEP(n, 18);
#undef SCAN_STEP
        asm volatile("" ::: "memory"); __builtin_amdgcn_s_barrier(); asm volatile("" ::: "memory");
        { const u32x4 ov = *(const LAS u32x4*)(ost + ((NCHUNK - 1) & 1) * 4096); *(u32x4*)(OA + (size_t)(NCHUNK - 1) * CH * 4096) = ov; }
        asm volatile("s_waitcnt vmcnt(0)" ::: "memory");
#undef SCAN_DMA
    } else {
        __builtin_amdgcn_s_setprio(3);
        const int sl = half * 4 + wid, el = lane & 15, q4 = lane >> 4;
        LAS bf16_t* ost = (LAS bf16_t*)(lds + SCAN_OST) + (4 * q4) * 64 + wid * 16 + el;
        f32x4 S[8];
#pragma unroll
        for (int dt = 0; dt < 8; ++dt) S[dt] = (f32x4){0.f, 0.f, 0.f, 0.f};
        for (int n = 0; n < NCHUNK; ++n) {
            asm volatile("s_waitcnt lgkmcnt(0)" ::: "memory"); __builtin_amdgcn_s_barrier(); asm volatile("" ::: "memory");
            LAS unsigned char* buf = lds + (n & 3) * REC_DMA;
            const LAS unsigned char* fl = buf + lane * 16;
            bf16x8 Wf[8], QGf[8], KDf[8], INf[2];
#pragma unroll
            for (int f = 0; f < 8; ++f) { Wf[f] = *(const LAS bf16x8*)(fl + REC_W + f * 1024); QGf[f] = *(const LAS bf16x8*)(fl + REC_QG + f * 1024); }
            const u32x4 uu = *(const LAS u32x4*)(buf + REC_U + sl * 1024 + lane * 16);
            const float gl = *(const LAS float*)(buf + REC_GL + 124);
            f32x4 eGv[2], ekv[2];
#pragma unroll
            for (int ct = 0; ct < 2; ++ct) { eGv[ct] = *(const LAS f32x4*)(buf + REC_GL + (16 * ct + 4 * q4) * 4); ekv[ct] = *(const LAS f32x4*)(buf + REC_GL + 128 + (16 * ct + 4 * q4) * 4); }
#pragma unroll
            for (int f = 0; f < 8; ++f) KDf[f] = *(const LAS bf16x8*)(fl + REC_KD + f * 1024);
#pragma unroll
            for (int f = 0; f < 2; ++f) INf[f] = *(const LAS bf16x8*)(fl + REC_IN + f * 1024);
            bf16x8 Sf[4];
#pragma unroll
            for (int kb = 0; kb < 4; ++kb) { const u32x4 w = (u32x4){cvtpk(S[2 * kb][0], S[2 * kb][1]), cvtpk(S[2 * kb][2], S[2 * kb][3]), cvtpk(S[2 * kb + 1][0], S[2 * kb + 1][1]), cvtpk(S[2 * kb + 1][2], S[2 * kb + 1][3])}; Sf[kb] = __builtin_bit_cast(bf16x8, w); }
            __builtin_amdgcn_sched_barrier(0);
#pragma unroll
            for (int dt = 0; dt < 8; ++dt) S[dt] *= gl;
            f32x4 vn[2] = {(f32x4){bflo(uu[0]), bfhi(uu[0]), bflo(uu[1]), bfhi(uu[1])}, (f32x4){bflo(uu[2]), bfhi(uu[2]), bflo(uu[3]), bfhi(uu[3])}};
            f32x4 o[2] = {(f32x4){0.f, 0.f, 0.f, 0.f}, (f32x4){0.f, 0.f, 0.f, 0.f}};
#pragma unroll
            for (int ct = 0; ct < 2; ++ct)
#pragma unroll
                for (int kb = 0; kb < 4; ++kb) { vn[ct] = __builtin_amdgcn_mfma_f32_16x16x32_bf16(Wf[ct * 4 + kb], Sf[kb], vn[ct], 0, 0, 0);
                                                 o[ct] = __builtin_amdgcn_mfma_f32_16x16x32_bf16(QGf[ct * 4 + kb], Sf[kb], o[ct], 0, 0, 0); }
            const f32x4 vs0 = vn[0] * ekv[0], vs1 = vn[1] * ekv[1];
            const u32x4 vsw = (u32x4){cvtpk(vs0[0], vs0[1]), cvtpk(vs0[2], vs0[3]), cvtpk(vs1[0], vs1[1]), cvtpk(vs1[2], vs1[3])}; const bf16x8 VNsf = __builtin_bit_cast(bf16x8, vsw);
#pragma unroll
            for (int dt = 0; dt < 8; ++dt) S[dt] = __builtin_amdgcn_mfma_f32_16x16x32_bf16(KDf[dt], VNsf, S[dt], 0, 0, 0);
            const u32x4 vw = (u32x4){cvtpk(vn[0][0], vn[0][1]), cvtpk(vn[0][2], vn[0][3]), cvtpk(vn[1][0], vn[1][1]), cvtpk(vn[1][2], vn[1][3])}; const bf16x8 VNf = __builtin_bit_cast(bf16x8, vw);
            LAS bf16_t* os = ost + (n & 1) * 2048;
#pragma unroll
            for (int ct = 0; ct < 2; ++ct) { o[ct] = __builtin_amdgcn_mfma_f32_16x16x32_bf16(INf[ct], VNf, o[ct] * eGv[ct]  , 0, 0, 0);
#pragma unroll
                for (int r = 0; r < 4; r += 2) { const unsigned w = pk2(o[ct][r], o[ct][r + 1]); os[(16 * ct + r) * 64] = (bf16_t)w; os[(16 * ct + r + 1) * 64] = (bf16_t)(w >> 16); } }
        }
        asm volatile("s_waitcnt lgkmcnt(0)" ::: "memory"); __builtin_amdgcn_s_barrier(); asm volatile("" ::: "memory");
        __builtin_amdgcn_s_setprio(0);
        float* so = p.out + O_DELTAP + (size_t)hv * 16384 + sl * 16 + el;
#pragma unroll
        for (int dt = 0; dt < 8; ++dt)
#pragma unroll
            for (int r = 0; r < 4; ++r) so[(size_t)(16 * dt + 4 * q4 + r) * 128] = S[dt][r];
    }
    __syncthreads();
}

__device__ __forceinline__ void attn_sample_task(const Params& p, int row, int h, int lane) {
    asm volatile("" : "+v"(lane));
    const bf16_t* P = (const bf16_t*)(p.ws + WS_P); const bf16_t* PS = (const bf16_t*)(p.ws + WS_PS); bf16_t* OB = (bf16_t*)(p.ws + WS_OB);
    const int sb = (row - SEQ) >> 2, st = (row - SEQ) & 3;
    float sc[3][3];
#pragma unroll
    for (int g = 0; g < 3; ++g) {
        const int dil = g == 0 ? 1 : (g == 1 ? 4 : 16), win = g == 0 ? 128 : (g == 1 ? 512 : 2048);
        const float* cache = g == 0 ? p.c128 : (g == 1 ? p.c512 : p.c2048);
        const bf16_t* qp = PS + (size_t)(row - SEQ) * 9216 + g * 1024 + h * 128;
#pragma unroll
        for (int sl = 0; sl < 3; ++sl) {
            const int j = lane + 64 * sl; float s = -1e30f;
            if (j <= 128) {
                const int idx = win + st - j * dil; float d = 0.f;
                if (idx >= win) { const bf16_t* kb = PS + (size_t)(4 * sb + idx - win) * 9216 + 3072 + g * 1024 + h * 128;
#pragma unroll 1
                    for (int i0 = 0; i0 < 16; i0 += 4) {
#pragma unroll
                        for (int i = i0; i < i0 + 4; ++i) { const u32x4 k = *(const u32x4*)(kb + 8 * i), q = *(const u32x4*)(qp + 8 * i);
#pragma unroll
                            for (int w = 0; w < 4; ++w) d += bflo(q[w]) * bflo(k[w]) + bfhi(q[w]) * bfhi(k[w]); } }
                } else { const float* kf = cache + (((size_t)sb * win + idx) * 2 + 0) * 1024 + h * 128;
#pragma unroll 1
                    for (int i0 = 0; i0 < 16; i0 += 8) {
#pragma unroll
                        for (int i = i0; i < i0 + 8; ++i) { const f32x4 k0 = *(const f32x4*)(kf + 8 * i), k1 = *(const f32x4*)(kf + 8 * i + 4); const u32x4 q = *(const u32x4*)(qp + 8 * i);
                            d += bflo(q[0]) * k0[0] + bfhi(q[0]) * k0[1] + bflo(q[1]) * k0[2] + bfhi(q[1]) * k0[3] + bflo(q[2]) * k1[0] + bfhi(q[2]) * k1[1] + bflo(q[3]) * k1[2] + bfhi(q[3]) * k1[3]; } }
                }
                s = d * 0.08838834764831845f;
            }
            sc[g][sl] = s;
        }
        __builtin_amdgcn_sched_barrier(0);
    }
    float mx = -1e30f;
#pragma unroll
    for (int g = 0; g < 3; ++g)
#pragma unroll
        for (int sl = 0; sl < 3; ++sl) mx = fmaxf(mx, sc[g][sl]);
    mx = wave_max(mx);
    float ls = 0.f;
#pragma unroll
    for (int g = 0; g < 3; ++g)
#pragma unroll
        for (int sl = 0; sl < 3; ++sl) { const float pj = (sc[g][sl] > -1e29f) ? __expf(sc[g][sl] - mx) : 0.f; sc[g][sl] = pj; ls += pj; }
    ls = wave_sum(ls);
    float a0 = 0.f, a1 = 0.f;
#pragma unroll
    for (int g = 0; g < 3; ++g) {
        const int dil = g == 0 ? 1 : (g == 1 ? 4 : 16), win = g == 0 ? 128 : (g == 1 ? 512 : 2048);
        const float* cache = g == 0 ? p.c128 : (g == 1 ? p.c512 : p.c2048);
#pragma unroll
        for (int hf = 0; hf < 2; ++hf) { const float scv = sc[g][hf];
#pragma unroll 1
            for (int j0 = 64 * hf; j0 < 64 * hf + 64; j0 += 32) {
                f32x2 v[32];
#pragma unroll
                for (int k = 0; k < 32; ++k) { const int j = j0 + k, idx = win + st - j * dil;
                    if (idx >= win) { const unsigned u = *(const unsigned*)(PS + (size_t)(4 * sb + idx - win) * 9216 + 6144 + g * 1024 + h * 128 + 2 * lane); v[k] = (f32x2){bflo(u), bfhi(u)}; }
                    else v[k] = *(const f32x2*)(cache + (((size_t)sb * win + idx) * 2 + 1) * 1024 + h * 128 + 2 * lane); }
#pragma unroll
                for (int k = 0; k < 32; ++k) { const float pj = __shfl(scv, (j0 + k) & 63); a0 += pj * v[k][0]; a1 += pj * v[k][1]; }
            } }
        { const int idx = win + st - 128 * dil; const f32x2 v = *(const f32x2*)(cache + (((size_t)sb * win + idx) * 2 + 1) * 1024 + h * 128 + 2 * lane); const float pj = __shfl(sc[g][2], 0); a0 += pj * v[0]; a1 += pj * v[1]; }
        __builtin_amdgcn_sched_barrier(0);
    }
    const float inv = 1.f / ls; const unsigned z = *(const unsigned*)(P + (size_t)row * NP + C_ZB + h * 128 + 2 * lane);
    *(unsigned*)(OB + (size_t)row * 1024 + h * 128 + 2 * lane) = pk2(a0 * inv * siluf_(bflo(z)), a1 * inv * siluf_(bfhi(z)));
}

constexpr int KVC_NR0 = 32 * 124, KVC_NR1 = 32 * 508, KVC_NR2 = 32 * 2044, KVC_ROWS = KVC_NR0 + KVC_NR1 + KVC_NR2, KVC_TASKS = KVC_ROWS / 2;
static_assert(KVC_ROWS % 16 == 0, "copy tasks come in groups of 8");
template <int WIN> __device__ __forceinline__ void kvc_rp(const float* c, float* o, int r, const float*& src, float*& dst) { const int b = r / (WIN - 4), j = r - b * (WIN - 4); src = c + (size_t)(b * WIN + j + 4) * 2048; dst = o + (size_t)(b * WIN + j) * 2048; }
__device__ __forceinline__ void kvcopy_task(const Params& p, int t, int lane) {
    asm volatile("" : "+v"(lane));
    const float *c128 = p.c128, *c512 = p.c512, *c2048 = p.c2048;
    asm volatile("" : "+s"(c128), "+s"(c512), "+s"(c2048));
    f32x4 v[16]; float* d[2];
#pragma unroll
    for (int r = 0; r < 2; ++r) { const int R = 2 * t + r; const float* s;
        if (R < KVC_NR0) kvc_rp<128>(c128, p.out + O_KV128S, R, s, d[r]); else if (R < KVC_NR0 + KVC_NR1) kvc_rp<512>(c512, p.out + O_KV512S, R - KVC_NR0, s, d[r]); else kvc_rp<2048>(c2048, p.out + O_KV2048S, R - KVC_NR0 - KVC_NR1, s, d[r]);
#pragma unroll
        for (int k = 0; k < 8; ++k) v[r * 8 + k] = *(const f32x4*)(s + k * 256 + lane * 4); }
#pragma unroll
    for (int r = 0; r < 2; ++r)
#pragma unroll
        for (int k = 0; k < 8; ++k) *(f32x4*)(d[r] + k * 256 + lane * 4) = v[r * 8 + k];
}
__device__ __forceinline__ void kvcopy_companion(const Params& p, int pullA, int cw, int lane) {
    asm volatile("" : "+v"(lane));
    const float *c128 = p.c128, *c512 = p.c512, *c2048 = p.c2048;
    asm volatile("" : "+s"(c128), "+s"(c512), "+s"(c2048));
#pragma unroll 1
    for (int k = 0; k < 4; ++k) {
        const int t = (pullA * 4 + cw) * 4 + k; const bool on = t < KVC_TASKS;
        f32x4 v[16]; float* d[2];
        asm volatile("s_waitcnt lgkmcnt(0)" ::: "memory"); __builtin_amdgcn_s_barrier(); asm volatile("" ::: "memory");
        if (on) {
#pragma unroll
            for (int r = 0; r < 2; ++r) { const int R = 2 * t + r; const float* s;
                if (R < KVC_NR0) kvc_rp<128>(c128, p.out + O_KV128S, R, s, d[r]); else if (R < KVC_NR0 + KVC_NR1) kvc_rp<512>(c512, p.out + O_KV512S, R - KVC_NR0, s, d[r]); else kvc_rp<2048>(c2048, p.out + O_KV2048S, R - KVC_NR0 - KVC_NR1, s, d[r]);
#pragma unroll
                for (int q = 0; q < 8; ++q) v[r * 8 + q] = *(const f32x4*)(s + q * 256 + lane * 4); } }
        asm volatile("s_waitcnt lgkmcnt(0)" ::: "memory"); __builtin_amdgcn_s_barrier(); asm volatile("" ::: "memory");
        if (on) {
#pragma unroll
            for (int r = 0; r < 2; ++r)
#pragma unroll
                for (int q = 0; q < 8; ++q) *(f32x4*)(d[r] + q * 256 + lane * 4) = v[r * 8 + q]; }
    }
}
constexpr int ATT_PULL_R = 32 * 32 * 2 / 8  , ATT_PULL_S = NSAMP * 8 / 8, ATT_PULL_A = 3 * 8 * (SEQ / 128)  , ATT_PULL_C = 0,
              ATT_PULLS = ATT_PULL_R + ATT_PULL_S + ATT_PULL_A + ATT_PULL_C, WQ_ATT = 3600;
static_assert(KVC_TASKS <= 3 * 8 * (SEQ / 128) * 16, "every copy task has a companion slot");
constexpr int ATT_LDS_PULL = 98304;
__device__ __forceinline__ void attn_quad_task(const Params& p, int qt, LAS unsigned char* ldsq, int wq, int lane) {
    asm volatile("" : "+v"(lane));
    const int g = qt >> 10, rem = qt & 1023, h = rem >> 7, rem2 = rem & 127, nq = 128 >> (2 * g), r = rem2 / nq, qq = rem2 % nq;
    const int ql = lane & 31, hi = lane >> 5, m0 = 128 * qq + 32 * wq, dil = 1 << (2 * g), jstart = qq == 0 ? 4 : 0;
    const size_t tokq = (size_t)r + (size_t)dil * (m0 + ql);
    const bf16_t* Qs = (const bf16_t*)(p.ws + WS_QKVC) + qkvc_row(0, g, h, r); const bf16_t* Ks = (const bf16_t*)(p.ws + WS_QKVC) + qkvc_row(1, g, h, r); const bf16_t* Vs = (const bf16_t*)(p.ws + WS_QKVC) + qkvc_row(2, g, h, r);
    const int kb0 = 128 * qq - 128;
    const bf16_t* tsrc[4];
#pragma unroll
    for (int i = 0; i < 4; ++i) { const int c = i * 256 + wq * 64 + lane, cc = c & 511, row = cc >> 4, ch = (cc & 15) ^ (((row & 3) << 2) | ((row >> 2) & 3));
        tsrc[i] = (i < 2 ? Ks : Vs) + (size_t)(kb0 + row) * 128 + ch * 8; }
#define ATT_DMA(j_, b_) do { _Pragma("unroll") for (int i = 0; i < 4; ++i) __builtin_amdgcn_global_load_lds((const unsigned*)(tsrc[i] + (size_t)(j_) * 32 * 128), (LAS unsigned*)(ldsq + (b_) * 16384 + i * 4096 + wq * 1024), 16, 0, 0); } while (0)
    ATT_DMA(jstart, jstart % 3); ATT_DMA(jstart + 1, (jstart + 1) % 3);
    bf16x8 qf[8];
    { const bf16_t* qp = Qs + (size_t)(m0 + ql) * 128 + 8 * hi;
#pragma unroll
      for (int s = 0; s < 8; ++s) qf[s] = *(const bf16x8*)(qp + 16 * s); }
    f32x16 O[4];
#pragma unroll
    for (int dm = 0; dm < 4; ++dm)
#pragma unroll
        for (int x = 0; x < 16; ++x) O[dm][x] = 0.f;
    float mrun = -1e30f, lrun = 0.f;
    constexpr float C2 = 0.08838834764831845f * 1.4426950408889634f;
    const unsigned qq4 = (lane & 15) >> 2, pp = lane & 3, blk = (lane >> 4) & 1;
    int bj = 0, bn = 2;
#pragma unroll 1
    for (int j = 0; j < 8; ++j) {
        if (j == 7) asm volatile("s_waitcnt vmcnt(0) lgkmcnt(0)" ::: "memory"); else asm volatile("s_waitcnt vmcnt(4) lgkmcnt(0)" ::: "memory");
        __builtin_amdgcn_s_barrier(); asm volatile("" ::: "memory");
        if (j + 2 <= 7 && j + 2 > jstart + 1) ATT_DMA(j + 2, bn);
        const int kt = j - wq;
        if (j >= jstart && kt >= 0 && kt <= 4) {
            const LAS unsigned char* kb = ldsq + bj * 16384; const LAS unsigned char* vb = kb + 8192;
            f32x16 S;
#pragma unroll
            for (int x = 0; x < 16; ++x) S[x] = 0.f;
#pragma unroll
            for (int s = 0; s < 8; ++s) S = __builtin_amdgcn_mfma_f32_32x32x16_bf16(*(const LAS bf16x8*)(kb + off_b(ql, 2 * s + hi)), qf[s], S, 0, 0, 0);
            const float NEG = -__builtin_inff();
            if (kt == 0) {
#pragma unroll
                for (int x = 0; x < 16; ++x) { const int kl = (x & 3) + 8 * (x >> 2) + 4 * hi; if (kl < ql) S[x] = NEG; }
            } else if (kt == 4) {
#pragma unroll
                for (int x = 0; x < 16; ++x) { const int kl = (x & 3) + 8 * (x >> 2) + 4 * hi; if (kl > ql) S[x] = NEG; }
            }
            float tmax = S[0];
#pragma unroll
            for (int x = 1; x < 16; ++x) tmax = fmaxf(tmax, S[x]);
            tmax = fmaxf(tmax, __shfl_xor(tmax, 32));
            if (!__all((tmax - mrun) * 0.08838834764831845f <= 8.f)) {
                const float mnew = fmaxf(mrun, tmax), alpha = __builtin_amdgcn_exp2f((mrun - mnew) * C2); mrun = mnew; lrun *= alpha;
#pragma unroll
                for (int dm = 0; dm < 4; ++dm)
#pragma unroll
                    for (int x = 0; x < 16; ++x) O[dm][x] *= alpha; }
            float ps = 0.f;
#pragma unroll
            for (int x = 0; x < 16; ++x) { S[x] = __builtin_amdgcn_exp2f((S[x] - mrun) * C2); ps += S[x]; }
            lrun += ps;
            bf16x8 pf[2];
#pragma unroll
            for (int t = 0; t < 2; ++t) { const u32x4 w = (u32x4){cvtpk(S[8 * t], S[8 * t + 1]), cvtpk(S[8 * t + 2], S[8 * t + 3]), cvtpk(S[8 * t + 4], S[8 * t + 5]), cvtpk(S[8 * t + 6], S[8 * t + 7])}; pf[t] = __builtin_bit_cast(bf16x8, w); }
#pragma unroll
            for (int dm = 0; dm < 4; ++dm)
#pragma unroll
                for (int t = 0; t < 2; ++t) {
                    const s16x4 a0 = lds_tr((LAS unsigned char*)vb + off_b(16 * t + 4 * hi + qq4, 4 * dm + 2 * blk + (pp >> 1)) + 8 * (pp & 1));
                    const s16x4 a1 = lds_tr((LAS unsigned char*)vb + off_b(16 * t + 8 + 4 * hi + qq4, 4 * dm + 2 * blk + (pp >> 1)) + 8 * (pp & 1));
                    O[dm] = __builtin_amdgcn_mfma_f32_32x32x16_bf16(cat8(a0, a1), pf[t], O[dm], 0, 0, 0); }
        }
        bj = bj == 2 ? 0 : bj + 1; bn = bn == 2 ? 0 : bn + 1;
    }
#undef ATT_DMA
    lrun += __shfl_xor(lrun, 32);
    const float inv = 1.f / lrun;
    bf16_t* og = (bf16_t*)(p.ws + WS_OG) + ((size_t)g * SEQ + tokq) * 1024 + h * 128;
#pragma unroll
    for (int dm = 0; dm < 4; ++dm)
#pragma unroll
        for (int a = 0; a < 2; ++a) {
            const unsigned e0 = cvtpk(O[dm][8 * a] * inv, O[dm][8 * a + 1] * inv), e1 = cvtpk(O[dm][8 * a + 2] * inv, O[dm][8 * a + 3] * inv);
            const unsigned f0 = cvtpk(O[dm][8 * a + 4] * inv, O[dm][8 * a + 5] * inv), f1 = cvtpk(O[dm][8 * a + 6] * inv, O[dm][8 * a + 7] * inv);
            const auto s0 = __builtin_amdgcn_permlane32_swap(e0, f0, false, false), s1 = __builtin_amdgcn_permlane32_swap(e1, f1, false, false);
            *(u32x4*)(og + 32 * dm + 16 * a + 8 * hi) = (u32x4){s0[0], s1[0], s0[1], s1[1]}; }
    if (hi == 0) ((float*)(p.ws + WS_LSE))[((size_t)g * SEQ + tokq) * 8 + h] = mrun * 0.08838834764831845f + logf(lrun);
}
constexpr int WQ_QX = 3648  , QX_S = ATT_PULL_S / 8  , QX_N = QX_S + ATT_PULL_A / 8;
static_assert(ATT_PULL_A % 8 == 0 && ATT_PULL_S % 8 == 0 && WQ_QX + 8 * 16 <= 4096, "per-XCD counters");
__device__ __forceinline__ void ph_attn(const Params& p, LAS unsigned char* lds) {
    const int tid = tidx(), lane = tid & 63, wid = __builtin_amdgcn_readfirstlane(tid >> 6);
    unsigned* ctr = (unsigned*)(p.ws + WS_BAR) + WQ_ATT; unsigned* ctrq = (unsigned*)(p.ws + WS_BAR) + WQ_QX;
    LAS int* slot = (LAS int*)(lds + ATT_LDS_PULL);
    bool main_done = false; int qcur = (int)(xb_xcc_id() & 7u);
    for (;;) {
        __syncthreads();
        if (wid == 0) {
            int v = -1;
            if (!main_done) { unsigned m = 0; if (lane == 0) m = __hip_atomic_fetch_add(ctr, 1u, __ATOMIC_RELAXED, __HIP_MEMORY_SCOPE_AGENT); m = __builtin_amdgcn_readfirstlane(m);
                if (m < (unsigned)ATT_PULL_R) v = (int)m; else main_done = true; }
            if (v < 0) {
                for (;;) {
                    unsigned a = 0; if (lane == 0) a = __hip_atomic_fetch_add(ctrq + 16 * qcur, 1u, __ATOMIC_RELAXED, __HIP_MEMORY_SCOPE_AGENT); a = __builtin_amdgcn_readfirstlane(a);
                    if (a < (unsigned)QX_N) { v = (int)a < QX_S ? ATT_PULL_R + qcur * QX_S + (int)a : ATT_PULL_R + ATT_PULL_S + qcur * (QX_N - QX_S) + (int)a - QX_S; break; }
                    unsigned c = (unsigned)QX_N; if (lane < 8) c = __hip_atomic_load(ctrq + 16 * lane, __ATOMIC_RELAXED, __HIP_MEMORY_SCOPE_AGENT);
                    const unsigned ne = (unsigned)__ballot(c < (unsigned)QX_N) & 0xffu;
                    if (ne == 0u) { v = ATT_PULLS; break; }
                    const unsigned rot = ((ne >> qcur) | (ne << (8 - qcur))) & 0xffu; qcur = (qcur + __builtin_ctz(rot)) & 7;
                }
            }
            if (lane == 0) *slot = v;
        }
        __syncthreads();
        const int pull = __builtin_amdgcn_readfirstlane(*slot);
        if (pull >= ATT_PULLS) break;
        if (pull < ATT_PULL_R) delta_rec_sample_task(p, pull * 8 + wid, lane);
        else if (pull < ATT_PULL_R + ATT_PULL_S) { const int task = (pull - ATT_PULL_R) * 8 + wid; attn_sample_task(p, SEQ + (task >> 3), task & 7, lane); }
        else { const int pa = pull - ATT_PULL_R - ATT_PULL_S;
            if (wid < 4) attn_quad_task(p, pa, lds, wid, lane); else kvcopy_companion(p, pa, wid - 4, lane); }
    }
}
__device__ __forceinline__ void ph_mix(const Params& p, int bid, int nb) {
    const bf16_t* P = (const bf16_t*)(p.ws + WS_P); const bf16_t* OG = (const bf16_t*)(p.ws + WS_OG); const float* LSE = (const float*)(p.ws + WS_LSE); bf16_t* OB = (bf16_t*)(p.ws + WS_OB);
    const int tid = tidx(), lane = tid & 63, gw = __builtin_amdgcn_readfirstlane(tid >> 6) * nb + bid, nw = nb * 8, h = lane >> 3;
    for (int tok = gw; tok < SEQ; tok += nw) {
        const size_t o = (size_t)tok * 1024 + lane * 16;
        u32x4 a[3][2];
#pragma unroll
        for (int g = 0; g < 3; ++g) { a[g][0] = *(const u32x4*)(OG + (size_t)g * SEQ * 1024 + o); a[g][1] = *(const u32x4*)(OG + (size_t)g * SEQ * 1024 + o + 8); }
        const u32x4 z0 = *(const u32x4*)(P + (size_t)tok * NP + C_ZB + lane * 16), z1 = *(const u32x4*)(P + (size_t)tok * NP + C_ZB + lane * 16 + 8);
        const float l0 = LSE[((size_t)0 * SEQ + tok) * 8 + h], l1 = LSE[((size_t)1 * SEQ + tok) * 8 + h], l2 = LSE[((size_t)2 * SEQ + tok) * 8 + h];
        const float mx = fmaxf(l0, fmaxf(l1, l2)); float w0 = __expf(l0 - mx), w1 = __expf(l1 - mx), w2 = __expf(l2 - mx); const float inv = 1.f / (w0 + w1 + w2); w0 *= inv; w1 *= inv; w2 *= inv;
        u32x4 r[2];
#pragma unroll
        for (int q = 0; q < 2; ++q) { const u32x4 z = q ? z1 : z0;
#pragma unroll
            for (int i = 0; i < 4; ++i) r[q][i] = pk2((w0 * bflo(a[0][q][i]) + w1 * bflo(a[1][q][i]) + w2 * bflo(a[2][q][i])) * siluf_(bflo(z[i])), (w0 * bfhi(a[0][q][i]) + w1 * bfhi(a[1][q][i]) + w2 * bfhi(a[2][q][i])) * siluf_(bfhi(z[i]))); }
        *(u32x4*)(OB + o) = r[0]; *(u32x4*)(OB + o + 8) = r[1];
    }
}

__device__ __forceinline__ void ph_gnorm(const Params& p, int bid, int nb) {
    const bf16_t* P = (const bf16_t*)(p.ws + WS_P); bf16_t* OA = (bf16_t*)(p.ws + WS_OA);
    const int tid = tidx(), lane = tid & 63, gw = __builtin_amdgcn_readfirstlane(tid >> 6) * nb + bid, nw = nb * 8;
    const f32x4 nwa = *(const f32x4*)(p.norm_a + 8 * (lane & 15)), nwb = *(const f32x4*)(p.norm_a + 8 * (lane & 15) + 4);
    for (int task = gw; task < MR * 4; task += nw) { const int row = task >> 2, c0 = (task & 3) * 1024 + 8 * lane;
        bf16_t* op = OA + (size_t)row * 4096 + c0; const bf16_t* zp = P + (size_t)row * NP + C_ZA + c0;
        u32x4 u[2], z[2]; float ss[2];
#pragma unroll
        for (int i = 0; i < 2; ++i) { u[i] = *(const u32x4*)(op + i * 512); z[i] = *(const u32x4*)(zp + i * 512); }
#pragma unroll
        for (int i = 0; i < 2; ++i) { ss[i] = 0.f;
#pragma unroll
            for (int q = 0; q < 4; ++q) ss[i] += bflo(u[i][q]) * bflo(u[i][q]) + bfhi(u[i][q]) * bfhi(u[i][q]); }
#pragma unroll
        for (int o = 1; o <= 8; o <<= 1)
#pragma unroll
            for (int i = 0; i < 2; ++i) ss[i] += __shfl_xor(ss[i], o);
#pragma unroll
        for (int i = 0; i < 2; ++i) { const float r = rsqrtf(ss[i] * (1.f / 128.f) + EPS); u32x4 o;
#pragma unroll
            for (int q = 0; q < 4; ++q) { const f32x4 nv = q < 2 ? nwa : nwb;
                o[q] = pk2(bflo(u[i][q]) * r * nv[(2 * q) & 3] * siluf_(bflo(z[i][q])), bfhi(u[i][q]) * r * nv[(2 * q + 1) & 3] * siluf_(bfhi(z[i][q]))); }
            *(u32x4*)(op + i * 512) = o; } }
}

__device__ __forceinline__ void ph_final(const Params& p, int bid, int nb) {
    const int lane = tidx() & 63, gw = __builtin_amdgcn_readfirstlane(tidx() >> 6) * nb + bid, nw = nb * 8;
    const bf16_t* H = (const bf16_t*)(p.ws + WS_T);
    for (int row = gw; row < MR; row += nw) { float* hr = p.out + (size_t)row * DM; f32x4 v[8]; float ss = 0.f;
        if (row < SEQ) {
#pragma unroll
            for (int i = 0; i < 8; ++i) { const u32x2 q = *(const u32x2*)(H + (size_t)row * DM + i * 256 + lane * 4); v[i] = (f32x4){bflo(q[0]), bfhi(q[0]), bflo(q[1]), bfhi(q[1])}; }
        } else {
#pragma unroll
            for (int i = 0; i < 8; ++i) v[i] = *(const f32x4*)(hr + i * 256 + lane * 4); }
#pragma unroll
        for (int i = 0; i < 8; ++i) ss += v[i][0] * v[i][0] + v[i][1] * v[i][1] + v[i][2] * v[i][2] + v[i][3] * v[i][3];
        ss = wave_sum(ss); const float r = rsqrtf(ss * (1.f / DM) + EPS);
#pragma unroll
        for (int i = 0; i < 8; ++i) { const f32x4 w = *(const f32x4*)(p.ln_f + i * 256 + lane * 4); *(f32x4*)(hr + i * 256 + lane * 4) = (f32x4){v[i][0] * r * w[0], v[i][1] * r * w[1], v[i][2] * r * w[2], v[i][3] * r * w[3]}; } }
}

__device__ __forceinline__ void ph_gemm1(const Params& p, LAS unsigned char* lds, int bid, int nb) {
    pg8::StaticOrder S; S.init(MP, NPAD, nb, bid);
    pg8::gemm_phase(lds, pg8::Gemm{(const bf16_t*)(p.ws + WS_XN), (const bf16_t*)(p.ws + WS_BT1), MP, NPAD, 2048}, S, pg8::EpiProj{(bf16_t*)(p.ws + WS_P), (float*)(p.ws + WS_BA), (bf16_t*)(p.ws + WS_QKVC), (bf16_t*)(p.ws + WS_PS)});
    static_assert((MP / 256) * (NPAD / 256) == 26 * 256 + 169, "the idle workgroups of GEMM 1's last round");
    if (nb == 256 && bid >= 169) {
        const float *w_in = p.w_in, *w_pa = p.w_proj_a, *w_pb = p.w_proj_b, *w_o = p.w_out;
        asm volatile("" : "+s"(w_in), "+s"(w_pa), "+s"(w_pb), "+s"(w_o));
        const int tid = tidx();
        for (int u0 = PRO_TILES1 + (bid - 169) * 4; u0 < PRO_TILES; u0 += 87 * 4) pro_tiles4(p, lds, u0, tid, w_in, w_pa, w_pb, w_o);
    }
}
__device__ __forceinline__ void ph_gemm2a(const Params& p, LAS unsigned char* lds, int bid, int nb) {
    pg8::StaticOrder S; S.init(SEQ, DM, nb, bid);
    pg8::gemm_phase(lds, pg8::Gemm{(const bf16_t*)(p.ws + WS_OB), (const bf16_t*)(p.ws + WS_BT2B), MP, DM, 1024}, S, pg8::EpiGateB{(const bf16_t*)(p.ws + WS_P), (bf16_t*)(p.ws + WS_T)});
}
__device__ __forceinline__ void ph_gemm2b(const Params& p, LAS unsigned char* lds, int bid, int nb) {
    pg8::StaticOrder S; S.init(SEQ, DM, nb, bid);
    pg8::gemm_phase(lds, pg8::Gemm{(const bf16_t*)(p.ws + WS_OA), (const bf16_t*)(p.ws + WS_BT2A), MP, DM, 4096}, S, pg8::EpiMerge{(const bf16_t*)(p.ws + WS_P), (const bf16_t*)(p.ws + WS_T), (bf16_t*)(p.ws + WS_MG)});
}
__device__ __forceinline__ void ph_gemm3(const Params& p, LAS unsigned char* lds, int bid, int nb) {
    pg8::StaticOrder S; S.init(SEQ, DM, nb, bid);
    pg8::gemm_phase(lds, pg8::Gemm{(const bf16_t*)(p.ws + WS_MG), (const bf16_t*)(p.ws + WS_BT3), MP, DM, 2048}, S, pg8::EpiOut{p.x_prompt, (bf16_t*)(p.ws + WS_T)});
}

template <int K> __device__ __forceinline__ f32x4 skinny_acc(const bf16_t* a, const bf16_t* b, f32x4 acc) {
    static_assert(K % 512 == 0, "K step");
#pragma unroll 1
    for (int k0 = 0; k0 < K; k0 += 512) {
        bf16x8 af[16], bfr[16];
#pragma unroll
        for (int i = 0; i < 16; ++i) { af[i] = *(const bf16x8*)(a + k0 + 32 * i); bfr[i] = *(const bf16x8*)(b + k0 + 32 * i); }
#pragma unroll
        for (int i = 0; i < 16; ++i) acc = __builtin_amdgcn_mfma_f32_16x16x32_bf16(af[i], bfr[i], acc, 0, 0, 0);
    }
    return acc;
}
__device__ __forceinline__ void ph_gemm2_sample(const Params& p, LAS unsigned char* lds, int bid) {
    if (bid >= 256) return;
    const int tid = tidx(), lane = tid & 63, wv = __builtin_amdgcn_readfirstlane(tid >> 6), fr = lane & 15, fq = lane >> 4, rt = (bid & 1) * 4 + (wv & 3), kh = wv >> 2, cb = bid >> 1;
    const bf16_t* P = (const bf16_t*)(p.ws + WS_P);
    const int arow = SEQ + 16 * rt + fr, bcol = 16 * cb + fr;
    f32x4 aa = (f32x4){0.f, 0.f, 0.f, 0.f}, ab = aa;
    aa = skinny_acc<2048>((const bf16_t*)(p.ws + WS_OA) + (size_t)arow * 4096 + kh * 2048 + 8 * fq, (const bf16_t*)(p.ws + WS_BT2A) + (size_t)bcol * 4096 + kh * 2048 + 8 * fq, aa);
    ab = skinny_acc<512>((const bf16_t*)(p.ws + WS_OB) + (size_t)arow * 1024 + kh * 512 + 8 * fq, (const bf16_t*)(p.ws + WS_BT2B) + (size_t)bcol * 1024 + kh * 512 + 8 * fq, ab);
    LAS f32x4* red = (LAS f32x4*)lds + (wv & 3) * 128 + lane * 2;
    if (kh) { red[0] = aa; red[1] = ab; }
    __syncthreads();
    if (!kh) { aa += red[0]; ab += red[1];
        bf16_t* MG = (bf16_t*)(p.ws + WS_MG);
#pragma unroll
        for (int r = 0; r < 4; ++r) { const size_t row = (size_t)(SEQ + 16 * rt + 4 * fq + r); const int c = 16 * cb + fr;
            const float ga = sigmoidf_(bf2f(P[row * NP + C_GA + c])), gb = sigmoidf_(bf2f(P[row * NP + C_GB + c]));
            MG[row * DM + c] = f2bf(ga * aa[r] + gb * ab[r]); } }
    __syncthreads();
}
__device__ __forceinline__ void ph_gemm3_sample(const Params& p, LAS unsigned char* lds, int bid) {
    if (bid >= 256) return;
    const int tid = tidx(), lane = tid & 63, wv = __builtin_amdgcn_readfirstlane(tid >> 6), fr = lane & 15, fq = lane >> 4, rt = (bid & 1) * 4 + (wv & 3), kh = wv >> 2, cb = bid >> 1;
    const int arow = SEQ + 16 * rt + fr, bcol = 16 * cb + fr;
    f32x4 acc = (f32x4){0.f, 0.f, 0.f, 0.f};
    acc = skinny_acc<1024>((const bf16_t*)(p.ws + WS_MG) + (size_t)arow * 2048 + kh * 1024 + 8 * fq, (const bf16_t*)(p.ws + WS_BT3) + (size_t)bcol * 2048 + kh * 1024 + 8 * fq, acc);
    LAS f32x4* red = (LAS f32x4*)lds + (wv & 3) * 64 + lane;
    if (kh) red[0] = acc;
    __syncthreads();
    if (!kh) { acc += red[0];
#pragma unroll
        for (int r = 0; r < 4; ++r) { const int srow = 16 * rt + 4 * fq + r, c = 16 * cb + fr;
            p.out[(size_t)(SEQ + srow) * DM + c] = p.x_sample[(size_t)srow * DM + c] + acc[r]; } }
    __syncthreads();
}

constexpr int LDS_MAIN = 4 * REC_DMA + 8192;
constexpr int LDS_BYTES = LDS_MAIN + 16;
__global__ __launch_bounds__(512, 2) void k_fwd(Params p) {
    extern __shared__ __attribute__((aligned(16))) unsigned char shm[];
    LAS unsigned char* lds = (LAS unsigned char*)shm;
    const int bid = blockIdx.x, nb = gridDim.x;
    if (threadIdx.x < 4) ((LAS unsigned*)(lds + LDS_MAIN))[threadIdx.x] = 0u;
    __syncthreads();
    XcdBarrier bar = xcd_barrier_post((unsigned*)(p.ws + WS_BAR), (volatile LAS unsigned*)(lds + LDS_MAIN));
    ph_prologue(p, lds, bid, nb);
    xcd_barrier(bar);
    ph_gemm1(p, lds, bid, nb);
    xcd_barrier(bar);
    ph_prep(p, bid, nb);
    ph_stage_a(p, lds, bid, nb);
    xcd_barrier(bar);
    if (bid < SCAN_WGS) ph_scan(p, lds, bid);
    ph_attn(p, lds);
    xcd_barrier(bar);
    ph_gnorm(p, bid, nb);
    ph_mix(p, bid, nb);
    xcd_barrier(bar);
    ph_gemm2_sample(p, lds, bid);
    ph_gemm2a(p, lds, bid, nb);
    ph_gemm2b(p, lds, bid, nb);
    xcd_barrier(bar);
    ph_gemm3_sample(p, lds, bid);
    ph_gemm3(p, lds, bid, nb);
    xcd_barrier(bar);
    ph_final(p, bid, nb);
}

extern "C" void kernel_launch(void* const* d_in, const int* in_sizes, int n_in, void* d_out, int out_size, void* d_ws, size_t ws_size, hipStream_t stream) {
    if (n_in != 17 || (size_t)out_size != O_END || ws_size < WS_END) { fprintf(stderr, "kernel_launch: unexpected sizes n_in %d out %d ws %zu (need %zu)\n", n_in, out_size, ws_size, (size_t)WS_END); return; }
    static int grid = 0;
    if (!grid) {
        int dev = 0, cus = 0, per_cu = 0;
        if (hipGetDevice(&dev) != hipSuccess || hipDeviceGetAttribute(&cus, hipDeviceAttributeMultiprocessorCount, dev) != hipSuccess) { fprintf(stderr, "kernel_launch: device query failed\n"); return; }
        if (hipFuncSetAttribute((const void*)k_fwd, hipFuncAttributeMaxDynamicSharedMemorySize, LDS_BYTES) != hipSuccess) { fprintf(stderr, "kernel_launch: hipFuncSetAttribute failed\n"); return; }
        if (hipOccupancyMaxActiveBlocksPerMultiprocessor(&per_cu, (const void*)k_fwd, 512, LDS_BYTES) != hipSuccess || per_cu < 1) { fprintf(stderr, "kernel_launch: occupancy query says %d blocks per CU\n", per_cu); return; }
        grid = cus;
    }
    Params p{};
    p.x_prompt = (const float*)d_in[0]; p.x_sample = (const float*)d_in[1]; p.c128 = (const float*)d_in[2]; p.c512 = (const float*)d_in[3]; p.c2048 = (const float*)d_in[4];
    p.state_delta = (const float*)d_in[5]; p.state_conv = (const float*)d_in[6]; p.ln_in = (const float*)d_in[7]; p.w_in = (const float*)d_in[8]; p.conv_w = (const float*)d_in[9];
    p.a_log = (const float*)d_in[10]; p.dt_bias = (const float*)d_in[11]; p.norm_a = (const float*)d_in[12]; p.w_proj_a = (const float*)d_in[13]; p.w_proj_b = (const float*)d_in[14];
    p.w_out = (const float*)d_in[15]; p.ln_f = (const float*)d_in[16]; p.out = (float*)d_out; p.ws = (unsigned char*)d_ws;
    (void)hipMemsetAsync((char*)d_ws + WS_BAR, 0, 16384, stream);
    hipLaunchKernelGGL(k_fwd, dim3(grid), dim3(512), LDS_BYTES, stream, p);
}
```

```cpp
#include <hip/hip_runtime.h>
#include <stdint.h>
#include <stdio.h>

#define LAS __attribute__((address_space(3)))
typedef unsigned short bf16_t;
typedef short bf16x8 __attribute__((ext_vector_type(8)));
typedef float f32x4 __attribute__((ext_vector_type(4)));
typedef float f32x2 __attribute__((ext_vector_type(2)));
typedef unsigned u32x4 __attribute__((ext_vector_type(4)));
typedef unsigned u32x2 __attribute__((ext_vector_type(2)));

constexpr int DM = 2048, SEQ = 16384, NSAMP = 128, MR = SEQ + NSAMP  , MP = 16640  ;
constexpr int NPAD = 26880;
constexpr int NP = 17408;
constexpr int C_QA = 0, C_KA = 2048, C_VA = 4096, C_ZA = 8192, C_ZB = 12288, C_GA = 13312, C_GB = 15360;
constexpr float EPS = 1e-6f;
constexpr size_t O_Y = 0, O_YS = 33554432, O_KV128P = O_YS + 262144, O_KV512P = O_KV128P + 262144, O_KV2048P = O_KV512P + 1048576, O_DELTAP = O_KV2048P + 4194304,
                 O_CONVP = O_DELTAP + 524288, O_KV128S = O_CONVP + 24576, O_KV512S = O_KV128S + 8388608, O_KV2048S = O_KV512S + 33554432, O_DELTAS = O_KV2048S + 134217728,
                 O_CONVS = O_DELTAS + 16777216, O_END = O_CONVS + 786432;
constexpr int CH = 32, NCHUNK = SEQ / CH;
constexpr int REC_W = 0, REC_QG = 8192, REC_IN = 16384, REC_KD = 18432, REC_U = 26624, REC_GL = 34816, RECB = 35072, REC_DMA = 36864;
constexpr size_t WS_BAR = 0, WS_REC = 16384, REC_BYTES = (size_t)NCHUNK * 32 * RECB + 4096,
                 WS_XN = WS_REC, WS_BT1 = WS_XN + (size_t)MP * 2048 * 2, WS_T = WS_REC + ((size_t)200 << 20), WS_MG = WS_REC + ((size_t)300 << 20),
                 WS_BT2A = WS_REC + ((REC_BYTES + 255) & ~(size_t)255), WS_BT2B = WS_BT2A + (size_t)2048 * 4096 * 2,
                 WS_BT3 = WS_BT2B + (size_t)2048 * 1024 * 2, WS_P = WS_BT3 + (size_t)2048 * 2048 * 2, WS_BA = WS_P + (size_t)MP * NP * 2, WS_BG = WS_BA + (size_t)MP * 64 * 4,
                 WS_CV = WS_BG + (size_t)MP * 64 * 4, WS_OA = WS_CV + (size_t)MP * 8192 * 2, WS_OB = WS_OA + (size_t)MP * 4096 * 2, WS_QKVC = WS_OB + (size_t)MP * 1024 * 2, WS_PS = WS_QKVC + (size_t)3 * 3 * 8 * SEQ * 128 * 2, WS_END = WS_PS + (size_t)256 * 9216 * 2,
                 WS_OG = WS_CV  , WS_LSE = WS_CV + (size_t)3 * SEQ * 1024 * 2;
static_assert(WS_LSE + (size_t)3 * SEQ * 8 * 4 <= WS_OA, "OG/LSE inside CV");
static_assert(WS_BT1 + (size_t)NPAD * 2048 * 2 <= WS_T && WS_T + (size_t)MP * 2048 * 2 <= WS_MG && WS_MG + (size_t)MP * 2048 * 2 <= WS_BT2A, "aliases inside REC");

__host__ __device__ __forceinline__ size_t qkvc_row(int which, int g, int h, int tok) { const int sh = 2 * g, pos = (tok & ((1 << sh) - 1)) * (SEQ >> sh) + (tok >> sh); return ((size_t)((which * 3 + g) * 8 + h) * SEQ + pos) * 128; }
struct Params {
    const float *x_prompt, *x_sample, *c128, *c512, *c2048, *state_delta, *state_conv, *ln_in, *w_in, *conv_w, *a_log, *dt_bias, *norm_a, *w_proj_a, *w_proj_b, *w_out, *ln_f;
    float* out;
    unsigned char* ws;
};

__device__ __forceinline__ int tidx() { int t = threadIdx.x; asm volatile("" : "+v"(t)); return t; }
__device__ __forceinline__ float bf2f(bf16_t b) { return __uint_as_float(((unsigned)b) << 16); }
__device__ __forceinline__ float bflo(unsigned u) { return __uint_as_float(u << 16); }
__device__ __forceinline__ float bfhi(unsigned u) { return __uint_as_float(u & 0xffff0000u); }
__device__ __forceinline__ bf16_t f2bf(float f) { unsigned u = __float_as_uint(f); u += 0x7FFFu + ((u >> 16) & 1u); return (bf16_t)(u >> 16); }
typedef __bf16 bf16x2_t __attribute__((ext_vector_type(2)));
__device__ __forceinline__ unsigned pk2(float lo, float hi) { const f32x2 v = {lo, hi}; return __builtin_bit_cast(unsigned, __builtin_convertvector(v, bf16x2_t)); }
__device__ __forceinline__ float sigmoidf_(float x) { return __builtin_amdgcn_rcpf(1.f + __builtin_amdgcn_exp2f(-1.4426950408889634f * x)); }
__device__ __forceinline__ float siluf_(float x) { return x * __builtin_amdgcn_rcpf(1.f + __builtin_amdgcn_exp2f(-1.4426950408889634f * x)); }
__device__ __forceinline__ float wave_sum(float v) {
#pragma unroll
    for (int o = 32; o >= 1; o >>= 1) v += __shfl_xor(v, o);
    return v;
}
__device__ __forceinline__ float wave_max(float v) {
#pragma unroll
    for (int o = 32; o >= 1; o >>= 1) v = fmaxf(v, __shfl_xor(v, o));
    return v;
}


#define XB_TMO      128
#define XB_XCNT(j)  (256  + 64 * (j))
#define XB_XSUB(j)  (1280 + 64 * (j))
#define XB_XGEN(j)  (2304 + 64 * (j))
#define XB_TOP      3328
#define XB_TOPGEN   3392
#define XCD_BAR_WORDS 3456
#define XB_SPIN_CAP (1u << 18)
__device__ __forceinline__ unsigned xb_ld(unsigned* p)              { return __hip_atomic_load(p, __ATOMIC_RELAXED, __HIP_MEMORY_SCOPE_AGENT); }
__device__ __forceinline__ unsigned xb_add(unsigned* p, unsigned v) { return __hip_atomic_fetch_add(p, v, __ATOMIC_RELAXED, __HIP_MEMORY_SCOPE_AGENT); }
__device__ __forceinline__ unsigned xb_xcc_id() { return (unsigned)__builtin_amdgcn_s_getreg((3 << 11) | 20) & 0xFu; }
#define XB_SPIN(cond, bar) do { unsigned _sp = 0; while (cond) { __builtin_amdgcn_s_sleep(1); \
    if ((++_sp & 255u) == 0u) { if (xb_ld(&(bar)[XB_TMO])) break; if (_sp > XB_SPIN_CAP) { atomicAdd(&(bar)[XB_TMO], 1u); break; } } } } while (0)
struct XcdBarrier { unsigned* bar; unsigned x; volatile LAS unsigned* st; };
__device__ __forceinline__ XcdBarrier xcd_barrier_post(unsigned* bar, volatile LAS unsigned* st) {
    XcdBarrier b; b.bar = bar; b.x = xb_xcc_id(); b.st = st;
    if (threadIdx.x == 0) (void)xb_add(&bar[XB_XCNT(b.x)], 1u);
    return b;
}
__device__ __forceinline__ void xcd_barrier_complete(unsigned* bar, unsigned x, unsigned& nloc, unsigned& nx) {
    const unsigned G = gridDim.x * gridDim.y * gridDim.z;
    unsigned sum, cnt, mine, sp = 0u;
    for (;;) {
        sum = 0u; cnt = 0u; mine = 0u;
#pragma unroll
        for (unsigned j = 0; j < 16; ++j) { const unsigned c = xb_ld(&bar[XB_XCNT(j)]); sum += c; cnt += (c > 0u) ? 1u : 0u; mine = (j == x) ? c : mine; }
        if (sum == G) break;
        __builtin_amdgcn_s_sleep(1);
        if ((++sp & 255u) == 0u) { if (xb_ld(&bar[XB_TMO])) break; if (sp > XB_SPIN_CAP) { atomicAdd(&bar[XB_TMO], 1u); break; } }
    }
    nloc = mine > 0u ? mine : 1u; nx = cnt > 0u ? cnt : 1u;
}
__device__ __forceinline__ void xcd_barrier(const XcdBarrier& b) {
    asm volatile("s_waitcnt vmcnt(0)" ::: "memory");
    __syncthreads();
    if (threadIdx.x == 0) {
        unsigned* bar = b.bar;
        __builtin_amdgcn_s_waitcnt(0);
        unsigned nloc = b.st[0], nx = b.st[1];
        if (nloc == 0u) { xcd_barrier_complete(bar, b.x, nloc, nx); b.st[0] = nloc; b.st[1] = nx; }
        const unsigned old = xb_add(&bar[XB_XSUB(b.x)], 1u);
        const unsigned gen = old / nloc;
        if (old + 1u == (gen + 1u) * nloc) {
            __builtin_amdgcn_fence(__ATOMIC_RELEASE, "agent");
            asm volatile("s_waitcnt vmcnt(0)" ::: "memory");
            const unsigned og = xb_add(&bar[XB_TOP], 1u);
            const unsigned tg = og / nx;
            if (og + 1u == (tg + 1u) * nx) xb_add(&bar[XB_TOPGEN], 1u);
            else XB_SPIN(xb_ld(&bar[XB_TOPGEN]) == tg, bar);
            __builtin_amdgcn_fence(__ATOMIC_ACQUIRE, "agent");
            xb_add(&bar[XB_XGEN(b.x)], 1u);
            asm volatile("s_waitcnt vmcnt(0)" ::: "memory");
        } else {
            XB_SPIN(xb_ld(&bar[XB_XGEN(b.x)]) == gen, bar);
            __builtin_amdgcn_fence(__ATOMIC_ACQUIRE, "agent");
            asm volatile("s_waitcnt vmcnt(0)" ::: "memory");
        }
    }
    __syncthreads();
}

namespace pg8 {
constexpr int BM = 256, BK = 64, HALF = 128, HTB = HALF * BK * 2, STAGE_BYTES = 8 * HTB, NXCD = 8, WGM = 8;
__host__ __device__ __forceinline__ int lds_byte(int r, int c) { const int st = (r >> 4) * 2 + (c >> 5), rr = r & 15, cc = c & 31, ob = rr * 64 + cc * 2; return st * 1024 + (ob ^ (((ob >> 9) & 1) << 5)); }
__host__ __device__ __forceinline__ void stage_rc(int b, int& R, int& C) { const int st = b / 1024, sb = b % 1024, swz = sb ^ (((sb >> 9) & 1) << 5); R = (st >> 1) * 16 + swz / 64; C = (st & 1) * 32 + (swz % 64) / 2; }
__host__ __device__ __forceinline__ int perm32(int rho) { const int n = rho >> 4, i = rho & 15; return 8 * (i >> 2) + 4 * n + (i & 3); }
struct Unit { int pm, pn; };
struct Gemm { const bf16_t* A; const bf16_t* Bt; int M, N, K; };
struct StaticOrder {
    int nM, nN, nwg, G, c;
    __host__ __device__ void init(int M, int N, int G_, int c_) { nM = M / BM; nN = N / BM; nwg = nM * nN; G = G_; c = c_; }
    __host__ __device__ bool next(int i, Unit& u) const {
        const long L = (long)i * G + c; if (L >= nwg) return false;
        int wgid = (int)L; { const int q = nwg / NXCD, r = nwg % NXCD, xcd = wgid % NXCD, off = wgid / NXCD; wgid = (xcd < r ? xcd * (q + 1) : r * (q + 1) + (xcd - r) * q) + off; }
        const int nig = WGM * nN, gid = wgid / nig, fm = gid * WGM, gsz = (nM - fm) < WGM ? (nM - fm) : WGM;
        u.pm = fm + ((wgid % nig) % gsz); u.pn = (wgid % nig) / gsz; return true;
    }
    __device__ __forceinline__ void a_ready(const Unit&) const {}
    __device__ __forceinline__ void done(const Unit&) const {}
};
__device__ __forceinline__ unsigned cvt_pk_bf16(float lo, float hi) { return pk2(lo, hi); }

template <class Epi, class Sched>
__device__ __forceinline__ void gemm_phase(LAS unsigned char* lds, const Gemm g, const Sched& S, const Epi& E) {
    const int tid = tidx(), wid = __builtin_amdgcn_readfirstlane(tid >> 6), lane = tid & 63, wr = wid >> 2, wc = wid & 3, fr = lane & 15, fq = lane >> 4;
    const int K = g.K, nt = K / BK;
    unsigned voffA[2], voffB[2];
#pragma unroll
    for (int i = 0; i < 2; ++i) { int R, C; stage_rc(tid * 16 + i * 8192, R, C); const int Rb = Epi::PERM ? ((R & ~31) + perm32(R & 31)) : R;
        voffA[i] = (unsigned)(R * K + C) * 2u; voffB[i] = (unsigned)(Rb * K + C) * 2u; }
    const size_t kstep = (size_t)(BK * 2);
    const size_t hstep = (size_t)HALF * K * 2;
    const size_t tstep = 2 * hstep;
    const unsigned ldsw = (unsigned)wid * 1024u;
    const int aoff = lds_byte(wr * 64 + fr, fq * 8), boff = lds_byte(wc * 32 + fr, fq * 8);
#define PG8_SA(b, h) (((b) * 2 + (h)) * HTB)
#define PG8_SB(b, h) ((4 + (b) * 2 + (h)) * HTB)
#define PG8_STAGE(bufoff, gbase, voff) do { _Pragma("unroll") for (int _i = 0; _i < 2; ++_i) \
        __builtin_amdgcn_global_load_lds((const unsigned*)((const char*)(gbase) + (voff)[_i]), (LAS unsigned*)(lds + (bufoff) + ldsw + _i * 8192), 16, 0, 0); } while (0)
#define PG8_LDA(dst, b, h) do { _Pragma("unroll") for (int m = 0; m < 4; ++m) _Pragma("unroll") for (int k = 0; k < 2; ++k) dst[m][k] = *(const LAS bf16x8*)(lds + PG8_SA(b, h) + aoff + m * 2048 + k * 1024); } while (0)
#define PG8_LDB(dst, b, h) do { _Pragma("unroll") for (int n = 0; n < 2; ++n) _Pragma("unroll") for (int k = 0; k < 2; ++k) dst[n][k] = *(const LAS bf16x8*)(lds + PG8_SB(b, h) + boff + n * 2048 + k * 1024); } while (0)
#define PG8_MMA(ai, bj, At, Bt) do { __builtin_amdgcn_s_setprio(1); _Pragma("unroll") for (int m = 0; m < 4; ++m) _Pragma("unroll") for (int n = 0; n < 2; ++n) _Pragma("unroll") for (int k = 0; k < 2; ++k) \
        acc[ai][bj][m][n] = __builtin_amdgcn_mfma_f32_16x16x32_bf16(Bt[n][k], At[m][k], acc[ai][bj][m][n], 0, 0, 0); __builtin_amdgcn_s_setprio(0); } while (0)
#define PG8_WAIT_V(n) asm volatile("s_waitcnt vmcnt(" #n ")" ::: "memory")
#define PG8_WAIT_L(n) asm volatile("s_waitcnt lgkmcnt(" #n ")" ::: "memory")
#define PG8_BAR __builtin_amdgcn_s_barrier()
#define PG8_SCHED __builtin_amdgcn_sched_barrier(0)
    Unit cur, nxt; int ui = 0;
    if (!S.next(0, cur)) return;
    f32x4 acc[2][2][4][2];
#pragma unroll
    for (int a = 0; a < 2; ++a)
#pragma unroll
        for (int b = 0; b < 2; ++b)
#pragma unroll
            for (int m = 0; m < 4; ++m)
#pragma unroll
                for (int n = 0; n < 2; ++n) acc[a][b][m][n] = (f32x4){0.f, 0.f, 0.f, 0.f};
    bf16x8 At[4][2], B0[2][2], B1[2][2];
    const char* cA = (const char*)g.A + (size_t)cur.pm * tstep; const char* cB = (const char*)g.Bt + (size_t)cur.pn * tstep;
    S.a_ready(cur);
    PG8_STAGE(PG8_SB(0, 0), cB, voffB); PG8_STAGE(PG8_SA(0, 0), cA, voffA); PG8_STAGE(PG8_SB(0, 1), cB + hstep, voffB); PG8_STAGE(PG8_SA(0, 1), cA + hstep, voffA);
    if (wr == 1) PG8_BAR;
    PG8_WAIT_V(4); PG8_BAR;
    PG8_STAGE(PG8_SB(1, 0), cB + kstep, voffB); PG8_STAGE(PG8_SA(1, 0), cA + kstep, voffA); PG8_STAGE(PG8_SB(1, 1), cB + hstep + kstep, voffB);
    PG8_WAIT_V(6); PG8_BAR;
    for (;;) {
        const bool has_next = S.next(ui + 1, nxt);
        const char* nA = has_next ? (const char*)g.A + (size_t)nxt.pm * tstep : cA; const char* nB = has_next ? (const char*)g.Bt + (size_t)nxt.pn * tstep : cB;
        for (int t = 0; t < nt; t += 2) {
            const bool last = (t == nt - 2);
            const char* a1 = cA + (size_t)(t + 1) * kstep;
            const char* a2 = last ? nA : cA + (size_t)(t + 2) * kstep; const char* b2 = last ? nB : cB + (size_t)(t + 2) * kstep;
            const char* a3 = a2 + kstep; const char* b3 = b2 + kstep;
            if (last && has_next) S.a_ready(nxt);
            PG8_LDB(B0, 0, 0); PG8_SCHED; PG8_LDA(At, 0, 0); PG8_STAGE(PG8_SA(1, 1), a1 + hstep, voffA);
            PG8_WAIT_L(8); PG8_BAR; PG8_WAIT_L(0); PG8_MMA(0, 0, At, B0); PG8_BAR; PG8_SCHED;
            PG8_LDB(B1, 0, 1); PG8_STAGE(PG8_SB(0, 0), b2, voffB);
            PG8_BAR; PG8_WAIT_L(0); PG8_MMA(0, 1, At, B1); PG8_BAR;
            PG8_LDA(At, 0, 1); PG8_STAGE(PG8_SA(0, 0), a2, voffA);
            PG8_BAR; PG8_WAIT_L(0); PG8_MMA(1, 0, At, B0); PG8_BAR; PG8_SCHED;
            PG8_STAGE(PG8_SB(0, 1), b2 + hstep, voffB);
            PG8_WAIT_V(6); PG8_BAR; PG8_MMA(1, 1, At, B1); PG8_BAR;
            PG8_LDB(B0, 1, 0); PG8_SCHED; PG8_LDA(At, 1, 0); PG8_STAGE(PG8_SA(0, 1), a2 + hstep, voffA);
            PG8_WAIT_L(8); PG8_BAR; PG8_WAIT_L(0); PG8_MMA(0, 0, At, B0); PG8_BAR; PG8_SCHED;
            PG8_LDB(B1, 1, 1); PG8_STAGE(PG8_SB(1, 0), b3, voffB);
            PG8_BAR; PG8_WAIT_L(0); PG8_MMA(0, 1, At, B1); PG8_BAR;
            PG8_LDA(At, 1, 1); PG8_STAGE(PG8_SA(1, 0), a3, voffA);
            PG8_BAR; PG8_WAIT_L(0); PG8_MMA(1, 0, At, B0); PG8_BAR; PG8_SCHED;
            PG8_STAGE(PG8_SB(1, 1), b3 + hstep, voffB);
            PG8_WAIT_V(6); PG8_BAR; PG8_MMA(1, 1, At, B1); PG8_BAR;
        }
        E(acc, cur, wr, wc, fr, fq); S.done(cur);
        if (!has_next) break;
#pragma unroll
        for (int a = 0; a < 2; ++a)
#pragma unroll
            for (int b = 0; b < 2; ++b)
#pragma unroll
                for (int m = 0; m < 4; ++m)
#pragma unroll
                    for (int n = 0; n < 2; ++n) acc[a][b][m][n] = (f32x4){0.f, 0.f, 0.f, 0.f};
        cur = nxt; cA = nA; cB = nB; ++ui;
    }
    PG8_WAIT_V(0);
    if (wr == 0) PG8_BAR;
    PG8_BAR;
#undef PG8_SA
#undef PG8_SB
#undef PG8_STAGE
#undef PG8_LDA
#undef PG8_LDB
#undef PG8_MMA
#undef PG8_WAIT_V
#undef PG8_WAIT_L
#undef PG8_BAR
#undef PG8_SCHED
}

struct EpiProj {
    static constexpr bool PERM = true;
    bf16_t* P; float* BA; bf16_t* QKVC; bf16_t* PS;
    __device__ __forceinline__ void operator()(const f32x4 (&acc)[2][2][4][2], const Unit& u, int wr, int wc, int fr, int fq) const {
        const int row0 = u.pm * BM + wr * 64 + fr;
        if (u.pn >= 48 && u.pn < 84) {
#pragma unroll
            for (int bj = 0; bj < 2; ++bj) { const int hh = (u.pn - 48) * 2 + bj, which = hh / 24, g = (hh % 24) >> 3, h = hh & 7, d0 = wc * 32 + 8 * fq;
#pragma unroll
                for (int ai = 0; ai < 2; ++ai)
#pragma unroll
                    for (int m = 0; m < 4; ++m) { const int row = row0 + ai * HALF + m * 16; const f32x4 v0 = acc[ai][bj][m][0], v1 = acc[ai][bj][m][1];
                        bf16_t* dst = row < SEQ ? QKVC + qkvc_row(which, g, h, row) + d0 : PS + (size_t)(row - SEQ) * 9216 + hh * 128 + d0;
                        *(u32x4*)dst = (u32x4){cvt_pk_bf16(v0[0], v0[1]), cvt_pk_bf16(v0[2], v0[3]), cvt_pk_bf16(v1[0], v1[1]), cvt_pk_bf16(v1[2], v1[3])}; } }
        } else if (u.pn < 104) {
            const int col0 = (u.pn < 48 ? u.pn : u.pn - 36) * BM + wc * 32 + 8 * fq;
#pragma unroll
            for (int ai = 0; ai < 2; ++ai)
#pragma unroll
                for (int m = 0; m < 4; ++m) { bf16_t* rowp = P + (size_t)(row0 + ai * HALF + m * 16) * NP + col0;
#pragma unroll
                    for (int bj = 0; bj < 2; ++bj) { const f32x4 v0 = acc[ai][bj][m][0], v1 = acc[ai][bj][m][1];
                        *(u32x4*)(rowp + bj * HALF) = (u32x4){cvt_pk_bf16(v0[0], v0[1]), cvt_pk_bf16(v0[2], v0[3]), cvt_pk_bf16(v1[0], v1[1]), cvt_pk_bf16(v1[2], v1[3])}; } }
        } else if (wc < 2) {
#pragma unroll
            for (int ai = 0; ai < 2; ++ai)
#pragma unroll
                for (int m = 0; m < 4; ++m) { float* rp = BA + (size_t)(row0 + ai * HALF + m * 16) * 64 + wc * 32 + 8 * fq;
                    *(f32x4*)rp = acc[ai][0][m][0]; *(f32x4*)(rp + 4) = acc[ai][0][m][1]; }
        }
    }
};
__device__ __forceinline__ void sig8(const bf16_t* p, float (&s)[8]) {
    const u32x4 g = *(const u32x4*)p;
#pragma unroll
    for (int i = 0; i < 4; ++i) { s[2 * i] = sigmoidf_(bflo(g[i])); s[2 * i + 1] = sigmoidf_(bfhi(g[i])); }
}
struct EpiGateB {
    static constexpr bool PERM = true;
    const bf16_t* P; bf16_t* T;
    __device__ __forceinline__ void operator()(const f32x4 (&acc)[2][2][4][2], const Unit& u, int wr, int wc, int fr, int fq) const {
        const int row0 = u.pm * BM + wr * 64 + fr, col0 = u.pn * BM + wc * 32 + 8 * fq;
#pragma unroll
        for (int ai = 0; ai < 2; ++ai)
#pragma unroll
            for (int m = 0; m < 4; ++m) { const size_t row = (size_t)(row0 + ai * HALF + m * 16);
#pragma unroll
                for (int bj = 0; bj < 2; ++bj) { const f32x4 v0 = acc[ai][bj][m][0], v1 = acc[ai][bj][m][1]; const int c = col0 + bj * HALF;
                    float s[8]; sig8(P + row * NP + C_GB + c, s);
                    *(u32x4*)(T + row * DM + c) = (u32x4){cvt_pk_bf16(v0[0] * s[0], v0[1] * s[1]), cvt_pk_bf16(v0[2] * s[2], v0[3] * s[3]), cvt_pk_bf16(v1[0] * s[4], v1[1] * s[5]), cvt_pk_bf16(v1[2] * s[6], v1[3] * s[7])}; } }
    }
};
struct EpiMerge {
    static constexpr bool PERM = true;
    const bf16_t* P; const bf16_t* T; bf16_t* MG;
    __device__ __forceinline__ void operator()(const f32x4 (&acc)[2][2][4][2], const Unit& u, int wr, int wc, int fr, int fq) const {
        const int row0 = u.pm * BM + wr * 64 + fr, col0 = u.pn * BM + wc * 32 + 8 * fq;
#pragma unroll
        for (int ai = 0; ai < 2; ++ai)
#pragma unroll
            for (int m = 0; m < 4; ++m) { const size_t row = (size_t)(row0 + ai * HALF + m * 16);
#pragma unroll
                for (int bj = 0; bj < 2; ++bj) { const f32x4 v0 = acc[ai][bj][m][0], v1 = acc[ai][bj][m][1]; const int c = col0 + bj * HALF;
                    float s[8]; sig8(P + row * NP + C_GA + c, s);
                    const u32x4 t = *(const u32x4*)(T + row * DM + c);
                    *(u32x4*)(MG + row * DM + c) = (u32x4){cvt_pk_bf16(v0[0] * s[0] + bflo(t[0]), v0[1] * s[1] + bfhi(t[0])), cvt_pk_bf16(v0[2] * s[2] + bflo(t[1]), v0[3] * s[3] + bfhi(t[1])),
                                                           cvt_pk_bf16(v1[0] * s[4] + bflo(t[2]), v1[1] * s[5] + bfhi(t[2])), cvt_pk_bf16(v1[2] * s[6] + bflo(t[3]), v1[3] * s[7] + bfhi(t[3]))}; } }
    }
};
struct EpiOut {
    static constexpr bool PERM = true;
    const float* xp; bf16_t* H;
    __device__ __forceinline__ void operator()(const f32x4 (&acc)[2][2][4][2], const Unit& u, int wr, int wc, int fr, int fq) const {
        const int row0 = u.pm * BM + wr * 64 + fr, col0 = u.pn * BM + wc * 32 + 8 * fq;
#pragma unroll
        for (int ai = 0; ai < 2; ++ai)
#pragma unroll
            for (int m = 0; m < 4; ++m) { const int row = row0 + ai * HALF + m * 16;
                if (row < SEQ) { const float* xr = xp + (size_t)row * DM; bf16_t* hr = H + (size_t)row * DM;
#pragma unroll
                    for (int bj = 0; bj < 2; ++bj) { const int c = col0 + bj * HALF; const f32x4 v0 = acc[ai][bj][m][0] + *(const f32x4*)(xr + c), v1 = acc[ai][bj][m][1] + *(const f32x4*)(xr + c + 4);
                        *(u32x4*)(hr + c) = (u32x4){cvt_pk_bf16(v0[0], v0[1]), cvt_pk_bf16(v0[2], v0[3]), cvt_pk_bf16(v1[0], v1[1]), cvt_pk_bf16(v1[2], v1[3])}; } } }
    }
};
}

struct TileDesc { const float* src; bf16_t* dst; int ld_src, ld_dst, k0, n0src, n0dst; bool zero; };
__device__ __forceinline__ TileDesc tile_desc(const Params& p, const float* w_in, const float* w_pa, const float* w_pb, const float* w_o, int u) {
    constexpr int U0 = 32 * 420, U1 = U0 + 64 * 32, U2 = U1 + 16 * 32;
    TileDesc t; t.zero = false;
    if (u < U0) { const int kt = u & 31, nt = u >> 5, n0 = nt * 64; int ns;
        if (n0 < 12288) ns = n0; else if (n0 < 26624) ns = n0 + 64; else if (n0 < 26688) ns = 12288 + (n0 - 26624); else { ns = 0; t.zero = true; }
        t.src = w_in; t.ld_src = 26688; t.k0 = kt * 64; t.n0src = ns; t.dst = (bf16_t*)(p.ws + WS_BT1); t.ld_dst = 2048; t.n0dst = n0;
    } else if (u < U1) { const int v = u - U0, kt = v & 63, nt = v >> 6; t.src = w_pa; t.ld_src = 2048; t.k0 = kt * 64; t.n0src = nt * 64; t.dst = (bf16_t*)(p.ws + WS_BT2A); t.ld_dst = 4096; t.n0dst = nt * 64;
    } else if (u < U2) { const int v = u - U1, kt = v & 15, nt = v >> 4; t.src = w_pb; t.ld_src = 2048; t.k0 = kt * 64; t.n0src = nt * 64; t.dst = (bf16_t*)(p.ws + WS_BT2B); t.ld_dst = 1024; t.n0dst = nt * 64;
    } else { const int v = u - U2, kt = v & 31, nt = v >> 5; t.src = w_o; t.ld_src = 2048; t.k0 = kt * 64; t.n0src = nt * 64; t.dst = (bf16_t*)(p.ws + WS_BT3); t.ld_dst = 2048; t.n0dst = nt * 64; }
    return t;
}
constexpr int PRO_TILES = 32 * 420 + 64 * 32 + 16 * 32 + 32 * 32;
constexpr int PRO_TILES1 = 32 * 420;
static_assert(PRO_TILES1 % 4 == 0 && PRO_TILES % 4 == 0, "tile batches");
__device__ __forceinline__ void pro_tiles4(const Params& p, LAS unsigned char* lds, int u0, int tid, const float* w_in, const float* w_pa, const float* w_pb, const float* w_o) {
    const int r = tid >> 4, c4 = tid & 15, n = tid >> 3, k8 = tid & 7;
        f32x4 v[4][2];
#pragma unroll
        for (int j = 0; j < 4; ++j) { const int u = u0 + j;
#pragma unroll
            for (int h = 0; h < 2; ++h) v[j][h] = (f32x4){0.f, 0.f, 0.f, 0.f};
            if (u < PRO_TILES) { const TileDesc t = tile_desc(p, w_in, w_pa, w_pb, w_o, u);
                if (!t.zero) {
#pragma unroll
                    for (int h = 0; h < 2; ++h) v[j][h] = *(const f32x4*)(t.src + (size_t)(t.k0 + r + 32 * h) * t.ld_src + t.n0src + 4 * c4); } } }
#pragma unroll
        for (int j = 0; j < 4; ++j) { LAS float* tile = (LAS float*)(lds + j * 16640);
#pragma unroll
            for (int h = 0; h < 2; ++h)
#pragma unroll
                for (int i = 0; i < 4; ++i) tile[(r + 32 * h) * 65 + 4 * c4 + i] = v[j][h][i]; }
        __syncthreads();
#pragma unroll
        for (int j = 0; j < 4; ++j) { const int u = u0 + j;
            if (u < PRO_TILES) { const TileDesc t = tile_desc(p, w_in, w_pa, w_pb, w_o, u); const LAS float* tile = (const LAS float*)(lds + j * 16640); float f[8];
#pragma unroll
                for (int i = 0; i < 8; ++i) f[i] = tile[(8 * k8 + i) * 65 + n];
                *(u32x4*)(t.dst + (size_t)(t.n0dst + n) * t.ld_dst + t.k0 + 8 * k8) = (u32x4){pk2(f[0], f[1]), pk2(f[2], f[3]), pk2(f[4], f[5]), pk2(f[6], f[7])}; } }
        __syncthreads();
}
__device__ __forceinline__ void ph_prologue(const Params& p, LAS unsigned char* lds, int bid, int nb) {
    const int tid = tidx(), r = tid >> 4, c4 = tid & 15, n = tid >> 3, k8 = tid & 7;
    const float *w_in = p.w_in, *w_pa = p.w_proj_a, *w_pb = p.w_proj_b, *w_o = p.w_out;
    asm volatile("" : "+s"(w_in), "+s"(w_pa), "+s"(w_pb), "+s"(w_o));
    const int ulim = nb == 256 ? PRO_TILES1 : PRO_TILES;
    for (int u0 = bid * 4; u0 < ulim; u0 += nb * 4) pro_tiles4(p, lds, u0, tid, w_in, w_pa, w_pb, w_o);
    const int lane = tid & 63, gw = __builtin_amdgcn_readfirstlane(tid >> 6) * nb + bid, nw = nb * 8;
    for (int row = gw; row < MP; row += nw) {
        bf16_t* xn = (bf16_t*)(p.ws + WS_XN) + (size_t)row * DM;
        if (row < MR) { const float* xr = row < SEQ ? p.x_prompt + (size_t)row * DM : p.x_sample + (size_t)(row - SEQ) * DM;
            f32x4 v[8]; float ss = 0.f;
#pragma unroll
            for (int i = 0; i < 8; ++i) { v[i] = *(const f32x4*)(xr + i * 256 + lane * 4); ss += v[i][0] * v[i][0] + v[i][1] * v[i][1] + v[i][2] * v[i][2] + v[i][3] * v[i][3]; }
            ss = wave_sum(ss); const float rr = rsqrtf(ss * (1.f / DM) + EPS);
#pragma unroll
            for (int i = 0; i < 8; ++i) { const f32x4 w = *(const f32x4*)(p.ln_in + i * 256 + lane * 4);
                *(u32x2*)(xn + i * 256 + lane * 4) = (u32x2){pk2(v[i][0] * rr * w[0], v[i][1] * rr * w[1]), pk2(v[i][2] * rr * w[2], v[i][3] * rr * w[3])}; }
        } else {
#pragma unroll
            for (int i = 0; i < 8; ++i) *(u32x2*)(xn + i * 256 + lane * 4) = (u32x2){0u, 0u};
            bf16_t* oa = (bf16_t*)(p.ws + WS_OA) + (size_t)row * 4096; bf16_t* ob = (bf16_t*)(p.ws + WS_OB) + (size_t)row * 1024;
#pragma unroll
            for (int i = 0; i < 16; ++i) *(u32x2*)(oa + i * 256 + lane * 4) = (u32x2){0u, 0u};
#pragma unroll
            for (int i = 0; i < 4; ++i) *(u32x2*)(ob + i * 256 + lane * 4) = (u32x2){0u, 0u};
        }
    }
}

template <int WIN> __device__ __forceinline__ void kvcopy_one(const float* cache, float* dst, int cb, int ncb, int tid) {
    constexpr int NR = 32 * (WIN - 4);
    f32x4 va[12], vb[12];
#define KV_ROWS(R0_, src_, dst_) do { _Pragma("unroll") for (int k = 0; k < 12; ++k) { int R = (R0_) + k * ncb; R = R < NR ? R : NR - 1; const int b = R / (WIN - 4), j = R - b * (WIN - 4); \
        src_[k] = cache + ((size_t)(b * WIN + j + 4) * 512 + tid) * 4; dst_[k] = dst + ((size_t)(b * WIN + j) * 512 + tid) * 4; } } while (0)
    const float* sa[12]; float* da[12]; const float* sb[12]; float* db[12];
    int R0 = cb;
    KV_ROWS(R0, sa, da);
#pragma unroll
    for (int k = 0; k < 12; ++k) va[k] = *(const f32x4*)sa[k];
    for (; R0 < NR; R0 += 24 * ncb) {
        KV_ROWS(R0 + 12 * ncb, sb, db);
#pragma unroll
        for (int k = 0; k < 12; ++k) vb[k] = *(const f32x4*)sb[k];
#pragma unroll
        for (int k = 0; k < 12; ++k) *(f32x4*)da[k] = va[k];
        KV_ROWS(R0 + 24 * ncb, sa, da);
#pragma unroll
        for (int k = 0; k < 12; ++k) va[k] = *(const f32x4*)sa[k];
#pragma unroll
        for (int k = 0; k < 12; ++k) *(f32x4*)db[k] = vb[k];
    }
#undef KV_ROWS
}
__device__ __forceinline__ void ph_kvcopy(const Params& p, int cb, int ncb) {
    const int tid = tidx();
    kvcopy_one<128>(p.c128, p.out + O_KV128S, cb, ncb, tid);
    kvcopy_one<512>(p.c512, p.out + O_KV512S, cb, ncb, tid);
    kvcopy_one<2048>(p.c2048, p.out + O_KV2048S, cb, ncb, tid);
}

__device__ __forceinline__ void ph_prep(const Params& p, int bid, int nb) {
    const bf16_t* P = (const bf16_t*)(p.ws + WS_P); bf16_t* CV = (bf16_t*)(p.ws + WS_CV);
    const float* BA = (const float*)(p.ws + WS_BA); float* BG = (float*)(p.ws + WS_BG);
    const int tid = tidx(), lane = tid & 63, gw = __builtin_amdgcn_readfirstlane(tid >> 6) * nb + bid, nw = nb * 8;
    const float *pc128 = p.c128, *pc512 = p.c512, *pc2048 = p.c2048;
    asm volatile("" : "+s"(pc128), "+s"(pc512), "+s"(pc2048));
    for (int task0 = gw; task0 < NSAMP * 64; task0 += 4 * nw) {
        float x0[4][4], x1[4][4]; f32x2 w[4][4];
#pragma unroll
        for (int u = 0; u < 4; ++u) { const int task = task0 + u * nw;
            if (task < NSAMP * 64) { const int row = SEQ + (task >> 6), seg = task & 63, c = seg * 128 + 2 * lane, b = (row - SEQ) >> 2, t = (row - SEQ) & 3;
#pragma unroll
                for (int i = 0; i < 4; ++i) { w[u][i] = *(const f32x2*)(p.conv_w + i * 8192 + c); const int j = t + i;
                    if (j < 3) { const f32x2 sv = *(const f32x2*)(p.state_conv + ((size_t)b * 3 + j) * 8192 + c); x0[u][i] = sv[0]; x1[u][i] = sv[1]; }
                    else { const unsigned q = *(const unsigned*)(P + (size_t)(SEQ + 4 * b + j - 3) * NP + c); x0[u][i] = bflo(q); x1[u][i] = bfhi(q); } } } }
#pragma unroll
        for (int u = 0; u < 4; ++u) { const int task = task0 + u * nw;
            if (task < NSAMP * 64) { const int row = SEQ + (task >> 6), seg = task & 63, c = seg * 128 + 2 * lane;
                float y0 = 0.f, y1 = 0.f;
#pragma unroll
                for (int i = 0; i < 4; ++i) { y0 += x0[u][i] * w[u][i][0]; y1 += x1[u][i] * w[u][i][1]; }
                y0 = siluf_(y0); y1 = siluf_(y1);
                if (seg < 32) { const float ss = wave_sum(y0 * y0 + y1 * y1); float r = rsqrtf(ss + EPS); if (seg < 16) r *= 0.08838834764831845f; y0 *= r; y1 *= r; }
                *(unsigned*)(CV + (size_t)row * 8192 + c) = pk2(y0, y1); } }
    }
    for (int i = SEQ * 32 + bid * 512 + tid; i < MR * 32; i += nb * 512) { const int row = i >> 5, h = i & 31;
        const float b = BA[(size_t)row * 64 + h], a = BA[(size_t)row * 64 + 32 + h] + p.dt_bias[h];
        const float sp = a > 20.f ? a : log1pf(expf(a));
        BG[(size_t)row * 64 + h] = 1.f / (1.f + expf(-b)); BG[(size_t)row * 64 + 32 + h] = -expf(p.a_log[h]) * sp; }
    for (int i = bid * 512 + tid; i < 3 * 8192; i += nb * 512) { const int r = i >> 13, c = i & 8191; p.out[O_CONVP + i] = bf2f(P[(size_t)(SEQ - 3 + r) * NP + c]); }
    for (int i = bid * 512 + tid; i < 32 * 3 * 8192; i += nb * 512) { const int c = i & 8191, r = (i >> 13) % 3, b = i / (3 * 8192); p.out[O_CONVS + i] = bf2f(P[(size_t)(SEQ + 4 * b + 1 + r) * NP + c]); }
    { const bf16_t* QKVC = (const bf16_t*)(p.ws + WS_QKVC); const bf16_t* PS = (const bf16_t*)(p.ws + WS_PS);
      constexpr int RP = 128 + 512 + 2048, NT = 2 * RP + 2 * 32 * 12;
      for (int task = gw; task < NT; task += nw) {
        const int half = task & 1; int r = task >> 1; float* dst;
        if (r < RP) { int g, win, j; size_t ob; if (r < 128) { g = 0; win = 128; j = r; ob = O_KV128P; } else if (r < 640) { g = 1; win = 512; j = r - 128; ob = O_KV512P; } else { g = 2; win = 2048; j = r - 640; ob = O_KV2048P; }
            dst = p.out + ob + (size_t)j * 2048 + half * 1024; const int tok = SEQ - win + j;
#pragma unroll
            for (int i = 0; i < 4; ++i) { const int e = i * 256 + lane * 4, h = e >> 7; const u32x2 u = *(const u32x2*)(QKVC + qkvc_row(1 + half, g, h, tok) + (e & 127)); *(f32x4*)(dst + e) = (f32x4){bflo(u[0]), bfhi(u[0]), bflo(u[1]), bfhi(u[1])}; }
        } else { r -= RP; const int b = r / 12, q = r % 12, g = q >> 2, t = q & 3, win = g == 0 ? 128 : (g == 1 ? 512 : 2048); const size_t ob = g == 0 ? O_KV128S : (g == 1 ? O_KV512S : O_KV2048S);
            dst = p.out + ob + ((size_t)b * win + (win - 4 + t)) * 2048 + half * 1024; const bf16_t* srcb = PS + (size_t)(4 * b + t) * 9216 + (1 + half) * 3072 + g * 1024;
#pragma unroll
            for (int i = 0; i < 4; ++i) { const u32x2 u = *(const u32x2*)(srcb + i * 256 + lane * 4); *(f32x4*)(dst + i * 256 + lane * 4) = (f32x4){bflo(u[0]), bfhi(u[0]), bflo(u[1]), bfhi(u[1])}; }
        }
      } }
}

__device__ __forceinline__ float dq_sum(float v) { v += __shfl_xor(v, 16); v += __shfl_xor(v, 32); return v; }
__device__ __forceinline__ void delta_rec_sample_task(const Params& p, int task, int lane) {
    asm volatile("" : "+v"(lane));
    const bf16_t* CV = (const bf16_t*)(p.ws + WS_CV); const float* BG = (const float*)(p.ws + WS_BG); bf16_t* OA = (bf16_t*)(p.ws + WS_OA);
    const int b = task >> 6, hv = (task >> 1) & 31, half = task & 1, cg = lane & 15, dq = lane >> 4, hk = hv >> 1, e0 = 64 * half + 4 * cg;
    const float* sin = p.state_delta + ((size_t)b * 32 + hv) * 16384 + (size_t)(dq * 32) * 128 + e0;
    float* sout = p.out + O_DELTAS + ((size_t)b * 32 + hv) * 16384 + (size_t)(dq * 32) * 128 + e0;
    f32x4 s[32];
#pragma unroll
    for (int i = 0; i < 32; ++i) s[i] = *(const f32x4*)(sin + (size_t)i * 128);
#pragma unroll 1
    for (int t = 0; t < 4; ++t) {
        const size_t row = (size_t)(SEQ + 4 * b + t);
        const bf16_t* kp = CV + row * 8192 + C_KA + hk * 128 + dq * 32; const bf16_t* qp = CV + row * 8192 + C_QA + hk * 128 + dq * 32;
        u32x4 kk[4], qq[4];
#pragma unroll
        for (int i = 0; i < 4; ++i) { kk[i] = *(const u32x4*)(kp + 8 * i); qq[i] = *(const u32x4*)(qp + 8 * i); }
        const u32x2 vv = *(const u32x2*)(CV + row * 8192 + C_VA + hv * 128 + e0);
        const float beta = BG[row * 64 + hv], eg = expf(BG[row * 64 + 32 + hv]);
        f32x4 dot = (f32x4){0.f, 0.f, 0.f, 0.f};
#pragma unroll
        for (int i = 0; i < 16; ++i) { const float k0 = bflo(kk[i >> 2][i & 3]), k1 = bfhi(kk[i >> 2][i & 3]); s[2 * i] *= eg; s[2 * i + 1] *= eg; dot += s[2 * i] * k0 + s[2 * i + 1] * k1; }
#pragma unroll
        for (int c = 0; c < 4; ++c) dot[c] = dq_sum(dot[c]);
        const f32x4 vn = ((f32x4){bflo(vv[0]), bfhi(vv[0]), bflo(vv[1]), bfhi(vv[1])} - dot) * beta;
        f32x4 o = (f32x4){0.f, 0.f, 0.f, 0.f};
#pragma unroll
        for (int i = 0; i < 16; ++i) { const float k0 = bflo(kk[i >> 2][i & 3]), k1 = bfhi(kk[i >> 2][i & 3]), q0 = bflo(qq[i >> 2][i & 3]), q1 = bfhi(qq[i >> 2][i & 3]);
            s[2 * i] += vn * k0; s[2 * i + 1] += vn * k1; o += s[2 * i] * q0 + s[2 * i + 1] * q1; }
#pragma unroll
        for (int c = 0; c < 4; ++c) o[c] = dq_sum(o[c]);
        if (dq == 0) *(u32x2*)(OA + row * 4096 + hv * 128 + e0) = (u32x2){pk2(o[0], o[1]), pk2(o[2], o[3])};
    }
#pragma unroll
    for (int i = 0; i < 32; ++i) *(f32x4*)(sout + (size_t)i * 128) = s[i];
}
__device__ __forceinline__ void ph_delta_rec_sample(const Params& p, int bid, int nb) {
    const int tid = tidx(), lane = tid & 63, gw = __builtin_amdgcn_readfirstlane(tid >> 6) * nb + bid, nw = nb * 8;
    for (int task = gw; task < 32 * 32 * 2; task += nw) delta_rec_sample_task(p, task, lane);
}

typedef short s16x4 __attribute__((ext_vector_type(4)));
typedef float f32x16 __attribute__((ext_vector_type(16)));
__device__ __forceinline__ unsigned off_b(unsigned row, unsigned ch) { return 256u * row + 16u * (ch ^ (((row & 3) << 2) | ((row >> 2) & 3))); }
__device__ __forceinline__ unsigned tr_read_addr(unsigned lane, unsigned c, unsigned ks, unsigned t) {
    const unsigned h = lane >> 5, blk = (lane >> 4) & 1, q = (lane & 15) >> 2, p = lane & 3;
    return off_b(16 * ks + 8 * h + 4 * t + q, 4 * c + 2 * blk + (p >> 1)) + 8 * (p & 1);
}
__device__ __forceinline__ s16x4 lds_tr(LAS unsigned char* p) { return __builtin_bit_cast(s16x4, __builtin_amdgcn_ds_read_tr16_b64_v4i16((LAS s16x4*)p)); }
__device__ __forceinline__ bf16x8 cat8(s16x4 a, s16x4 b) { return (bf16x8){a[0], a[1], a[2], a[3], b[0], b[1], b[2], b[3]}; }
__device__ __forceinline__ unsigned cvtpk(float lo, float hi) { return pk2(lo, hi); }
__device__ __forceinline__ int afrag_off(int row, int col, int nkb) { return ((row >> 4) * nkb + (col >> 5)) * 512 + (16 * ((col >> 2) & 3) + (row & 15)) * 8 + 4 * ((col >> 4) & 1) + (col & 3); }
__device__ __forceinline__ int u_off(int c, int e) { return ((e >> 4) * 64 + 16 * ((c >> 2) & 3) + (e & 15)) * 8 + (c >> 4) * 4 + (c & 3); }
__device__ __forceinline__ float rdlane(float v, int l) { return __int_as_float(__builtin_amdgcn_readlane(__float_as_int(v), l)); }
#define LDS_WAIT() asm volatile("s_waitcnt lgkmcnt(0)" ::: "memory")

#define DPPF(v, ctrl) __int_as_float(__builtin_amdgcn_update_dpp(0, __float_as_int(v), (ctrl), 0xF, 0xF, true))
__device__ __forceinline__ float row16_sum(float v) {
    v += DPPF(v, 0xB1);
    v += DPPF(v, 0x4E);
    v += DPPF(v, 0x141);
    v += DPPF(v, 0x140);
    return v;
}
__device__ __forceinline__ float scan32_incl(float v) {
    v += DPPF(v, 0x111); v += DPPF(v, 0x112); v += DPPF(v, 0x114); v += DPPF(v, 0x118);
    v += __int_as_float(__builtin_amdgcn_update_dpp(0, __float_as_int(v), 0x142, 0xA, 0xF, true));
    return v;
}
__device__ __forceinline__ void conv_load(const Params& p, size_t row0, int col0, int lane, u32x4 (&x)[11]) {
    asm volatile("" : "+v"(lane));
    const bf16_t* P = (const bf16_t*)(p.ws + WS_P); const int cg = lane & 15, rg = lane >> 4, cv = col0 + 8 * cg;
#pragma unroll
    for (int i = 0; i < 11; ++i) { const long r = (long)row0 + 8 * rg - 3 + i; x[i] = r >= 0 ? *(const u32x4*)(P + (size_t)r * NP + cv) : (u32x4){0u, 0u, 0u, 0u}; }
}
template <int MODE> __device__ __forceinline__ void conv_comp(const Params& p, int col0, const u32x4 (&x)[11], LAS unsigned char* ldst, int lane) {
    asm volatile("" : "+v"(lane));
    const int cg = lane & 15, rg = lane >> 4, cv = col0 + 8 * cg;
    f32x4 w[4][2];
#pragma unroll
    for (int i = 0; i < 4; ++i) { w[i][0] = *(const f32x4*)(p.conv_w + i * 8192 + cv); w[i][1] = *(const f32x4*)(p.conv_w + i * 8192 + cv + 4); }
#pragma unroll
    for (int r = 0; r < 8; ++r) { float y[8];
#pragma unroll
        for (int e = 0; e < 8; ++e) y[e] = 0.f;
#pragma unroll
        for (int t = 0; t < 4; ++t)
#pragma unroll
            for (int q = 0; q < 4; ++q) { y[2 * q] += bflo(x[r + t][q]) * w[t][q >> 1][(2 * q) & 3]; y[2 * q + 1] += bfhi(x[r + t][q]) * w[t][q >> 1][(2 * q + 1) & 3]; }
        float ss = 0.f;
#pragma unroll
        for (int e = 0; e < 8; ++e) { y[e] = siluf_(y[e]); ss += y[e] * y[e]; }
        if (MODE != 0) { ss = row16_sum(ss);
            const float rs = rsqrtf(ss + EPS) * (MODE == 2 ? 0.08838834764831845f : 1.f);
#pragma unroll
            for (int e = 0; e < 8; ++e) y[e] *= rs; }
        *(LAS u32x4*)(ldst + off_b(8 * rg + r, cg)) = (u32x4){pk2(y[0], y[1]), pk2(y[2], y[3]), pk2(y[4], y[5]), pk2(y[6], y[7])}; }
}
struct HeadSc { float beta, G, eG, ekd; };
__device__ __forceinline__ void sa_head1(const Params& p, int n, int hv, float braw, float araw0, const LAS unsigned char* ldq, LAS float* sc, const f32x16& KKr, const f32x16& QKr, f32x16& L, HeadSc& hs, int lane) {
    asm volatile("" : "+v"(lane));
    unsigned char* rec = p.ws + WS_REC + ((size_t)hv * NCHUNK + n) * RECB;
    const int t = lane & 31, hi = lane >> 5;
    const float araw = araw0 + p.dt_bias[hv];
    const float beta = 1.f / (1.f + expf(-braw)); float G = -expf(p.a_log[hv]) * (araw > 20.f ? araw : log1pf(expf(araw)));
    G = scan32_incl(G);
    const float Glast = rdlane(G, 31), eG = expf(G), ekd = expf(Glast - G);
    if (lane < 32) { sc[t] = G; sc[32 + t] = beta; sc[64 + t] = eG; sc[96 + t] = ekd;
        *(float*)(rec + REC_GL + 4 * t) = eG; *(float*)(rec + REC_GL + 128 + 4 * t) = ekd; }
    hs.beta = beta; hs.G = G; hs.eG = eG; hs.ekd = ekd;
    {
        bf16_t* INf = (bf16_t*)(rec + REC_IN);
        unsigned ipk[4][2];
#pragma unroll
        for (int xg = 0; xg < 4; ++xg) { const f32x4 Gr = *(const LAS f32x4*)(sc + 8 * xg + 4 * hi), Br = *(const LAS f32x4*)(sc + 32 + 8 * xg + 4 * hi); float iv[4];
#pragma unroll
            for (int b = 0; b < 4; ++b) { const int r = 8 * xg + 4 * hi + b;
                L[4 * xg + b] = (t < r) ? Br[b] * KKr[4 * xg + b] * __expf(Gr[b] - G) : 0.f;
                iv[b] = (r <= t) ? QKr[4 * xg + b] * __expf(G - Gr[b]) : 0.f; }
            ipk[xg][0] = cvtpk(iv[0], iv[1]); ipk[xg][1] = cvtpk(iv[2], iv[3]); }
#pragma unroll
        for (int xg = 0; xg < 2; ++xg) *(u32x4*)(INf + afrag_off(t, 8 * xg + 4 * hi, 1)) = (u32x4){ipk[xg][0], ipk[xg][1], ipk[xg + 2][0], ipk[xg + 2][1]};
    }
}
__device__ __forceinline__ void sa_head2(const Params& p, int n, int hv, LAS unsigned char* ldk, LAS unsigned char* lds2, const LAS float* sc, const f32x16& Lacc, const HeadSc& hs, int lane) {
    asm volatile("" : "+v"(lane));
    unsigned char* rec = p.ws + WS_REC + ((size_t)hv * NCHUNK + n) * RECB;
    const int t = lane & 31, hi = lane >> 5; const size_t row0 = (size_t)n * CH;
    u32x4 xv[11]; conv_load(p, row0, C_VA + hv * 128, lane, xv);
    __builtin_amdgcn_sched_barrier(0);
    float T[32];
#pragma unroll
    for (int j = 31; j >= 0; --j) { float a = (t == j) ? 1.f : 0.f;
#pragma unroll
        for (int kk = j + 1; kk < 32; ++kk) a -= T[kk] * rdlane(Lacc[(kk & 3) + 4 * (kk >> 3)], j + 32 * ((kk >> 2) & 1));
        T[j] = a; }
    unsigned P2[16], P3[16];
#pragma unroll
    for (int m = 0; m < 16; ++m) { const float b0 = rdlane(hs.beta, 2 * m), b1 = rdlane(hs.beta, 2 * m + 1), e0 = rdlane(hs.eG, 2 * m), e1 = rdlane(hs.eG, 2 * m + 1);
        P3[m] = cvtpk(T[2 * m] * b0, T[2 * m + 1] * b1); P2[m] = cvtpk(T[2 * m] * b0 * e0, T[2 * m + 1] * b1 * e1); }
    bf16x8 F2[2], F3[2];
#pragma unroll
    for (int ks = 0; ks < 2; ++ks) { u32x4 a, b;
#pragma unroll
        for (int i = 0; i < 4; ++i) { a[i] = hi ? P2[8 * ks + 4 + i] : P2[8 * ks + i]; b[i] = hi ? P3[8 * ks + 4 + i] : P3[8 * ks + i]; }
        F2[ks] = __builtin_bit_cast(bf16x8, a); F3[ks] = __builtin_bit_cast(bf16x8, b); }
    { bf16_t* Wf = (bf16_t*)(rec + REC_W);
#pragma unroll
      for (int mt = 0; mt < 4; ++mt) { f32x16 acc;
#pragma unroll
          for (int x = 0; x < 16; ++x) acc[x] = 0.f;
#pragma unroll
          for (int ks = 0; ks < 2; ++ks) acc = __builtin_amdgcn_mfma_f32_32x32x16_bf16(cat8(lds_tr(ldk + tr_read_addr(lane, mt, ks, 0)), lds_tr(ldk + tr_read_addr(lane, mt, ks, 1))), F2[ks], acc, 0, 0, 0);
#pragma unroll
          for (int xg = 0; xg < 2; ++xg) *(u32x4*)(Wf + afrag_off(t, 32 * mt + 8 * xg + 4 * hi, 4)) = (u32x4){cvtpk(-acc[4 * xg], -acc[4 * xg + 1]), cvtpk(-acc[4 * xg + 2], -acc[4 * xg + 3]), cvtpk(-acc[4 * xg + 8], -acc[4 * xg + 9]), cvtpk(-acc[4 * xg + 10], -acc[4 * xg + 11])}; } }
    LDS_WAIT();
    conv_comp<0>(p, C_VA + hv * 128, xv, lds2, lane);
    LDS_WAIT();
    { bf16_t* Uf = (bf16_t*)(rec + REC_U);
#pragma unroll
      for (int nt = 0; nt < 4; ++nt) { f32x16 acc;
#pragma unroll
          for (int x = 0; x < 16; ++x) acc[x] = 0.f;
#pragma unroll
          for (int ks = 0; ks < 2; ++ks) acc = __builtin_amdgcn_mfma_f32_32x32x16_bf16(F3[ks], cat8(lds_tr(lds2 + tr_read_addr(lane, nt, ks, 0)), lds_tr(lds2 + tr_read_addr(lane, nt, ks, 1))), acc, 0, 0, 0);
#pragma unroll
          for (int xg = 0; xg < 2; ++xg) *(u32x4*)(Uf + u_off(8 * xg + 4 * hi, 32 * nt + t)) = (u32x4){cvtpk(acc[4 * xg], acc[4 * xg + 1]), cvtpk(acc[4 * xg + 2], acc[4 * xg + 3]), cvtpk(acc[4 * xg + 8], acc[4 * xg + 9]), cvtpk(acc[4 * xg + 10], acc[4 * xg + 11])}; } }
    LDS_WAIT();
}
__device__ __forceinline__ void stage_a_unit(const Params& p, int n, int hk, LAS unsigned char* ldsw, int lane) {
    asm volatile("" : "+v"(lane));
    LAS unsigned char* ldk = ldsw; LAS float* sc0 = (LAS float*)(ldsw + 8192); LAS float* sc1 = (LAS float*)(ldsw + 8704); LAS unsigned char* ldq = ldsw + 9216;
    const int t = lane & 31, hi = lane >> 5; const size_t row0 = (size_t)n * CH;
    float braw[2], araw[2];
    { u32x4 xk[11], xq[11]; conv_load(p, row0, C_KA + hk * 128, lane, xk); conv_load(p, row0, C_QA + hk * 128, lane, xq);
      const float* BA = (const float*)(p.ws + WS_BA) + (row0 + t) * 64 + 2 * hk;
      braw[0] = BA[0]; braw[1] = BA[1]; araw[0] = BA[32]; araw[1] = BA[33];
      __builtin_amdgcn_sched_barrier(0);
      conv_comp<1>(p, C_KA + hk * 128, xk, ldk, lane);
      conv_comp<2>(p, C_QA + hk * 128, xq, ldq, lane); }
    LDS_WAIT();
    f32x16 KKr, QKr;
#pragma unroll
    for (int x = 0; x < 16; ++x) { KKr[x] = 0.f; QKr[x] = 0.f; }
#pragma unroll
    for (int s = 0; s < 8; ++s) { const bf16x8 kf = *(const LAS bf16x8*)(ldk + off_b(t, 2 * s + hi)), qf = *(const LAS bf16x8*)(ldq + off_b(t, 2 * s + hi));
        KKr = __builtin_amdgcn_mfma_f32_32x32x16_bf16(kf, kf, KKr, 0, 0, 0); QKr = __builtin_amdgcn_mfma_f32_32x32x16_bf16(kf, qf, QKr, 0, 0, 0); }
    { unsigned char* reck = p.ws + WS_REC + ((size_t)(2 * hk) * NCHUNK + n) * RECB;
      { const int rr = lane & 15, qq = lane >> 4;
#pragma unroll
        for (int ct = 0; ct < 2; ++ct) { const int c = 16 * ct + rr;
#pragma unroll
            for (int kb = 0; kb < 4; ++kb) { const u32x2 a = *(const LAS u32x2*)(ldq + off_b(c, 4 * kb + (qq >> 1)) + 8 * (qq & 1)), b = *(const LAS u32x2*)(ldq + off_b(c, 4 * kb + 2 + (qq >> 1)) + 8 * (qq & 1));
                *(u32x4*)(reck + REC_QG + (ct * 4 + kb) * 1024 + lane * 16) = (u32x4){a[0], a[1], b[0], b[1]}; } } }
      { const unsigned qg = lane >> 4, qq = (lane & 15) >> 2, pp = lane & 3;
#pragma unroll
        for (int dt = 0; dt < 8; ++dt) { const s16x4 a0 = lds_tr(ldk + off_b(4 * qg + qq, 2 * dt + (pp >> 1)) + 8 * (pp & 1)), a1 = lds_tr(ldk + off_b(16 + 4 * qg + qq, 2 * dt + (pp >> 1)) + 8 * (pp & 1));
            *(bf16x8*)(reck + REC_KD + dt * 1024 + lane * 16) = cat8(a0, a1); } } }
    f32x16 L0, L1; HeadSc h0, h1;
    sa_head1(p, n, 2 * hk, braw[0], araw[0], ldq, sc0, KKr, QKr, L0, h0, lane);
    sa_head1(p, n, 2 * hk + 1, braw[1], araw[1], ldq, sc1, KKr, QKr, L1, h1, lane);
    sa_head2(p, n, 2 * hk, ldk, ldq, sc0, L0, h0, lane);
    sa_head2(p, n, 2 * hk + 1, ldk, ldq, sc1, L1, h1, lane);
}
__device__ __forceinline__ void ph_stage_a(const Params& p, LAS unsigned char* lds, int bid, int nb) {
    const int lane = tidx() & 63, wid = __builtin_amdgcn_readfirstlane(tidx() >> 6), gw = wid * nb + bid, nw = nb * 8;
    LAS unsigned char* ldsw = lds + wid * 17408;
    for (int task = gw; task < NCHUNK * 16; task += nw) stage_a_unit(p, NCHUNK - 1 - (task >> 4), task & 15, ldsw, lane);
}

constexpr int SCAN_WGS = 64, SCAN_OST = 4 * REC_DMA;
__device__ __forceinline__ void ph_scan(const Params& p, LAS unsigned char* lds, int bid) {
    const int tid = tidx(), lane = tid & 63, wid = __builtin_amdgcn_readfirstlane(tid >> 6), hv = 4 * (bid & 7) + ((bid >> 4) & 2) + ((bid >> 4) & 1), half = (bid >> 3) & 1;
    const unsigned char* rec0 = p.ws + WS_REC + (size_t)hv * NCHUNK * RECB; constexpr size_t RSTR = (size_t)RECB;
    if (wid >= 4) {
        const int lw = wid - 4;
        bf16_t* OA = (bf16_t*)(p.ws + WS_OA) + (size_t)(8 * lw + (lane >> 3)) * 4096 + hv * 128 + half * 64 + (lane & 7) * 8;
        const LAS unsigned char* ost = lds + SCAN_OST + (8 * lw + (lane >> 3)) * 128 + (lane & 7) * 16;
        int poff[8], loff[8];
        const int kdelta = -(hv & 1) * (int)(NCHUNK * RECB);
#pragma unroll
        for (int i = 0; i < 8; ++i) { const int idx = lw * 8 + i; loff[i] = idx < 26 ? idx * 1024 : (idx < 30 ? REC_U + (4 * half + idx - 26) * 1024 : REC_GL);
            poff[i] = loff[i] + (((idx >= 8 && idx < 16) || (idx >= 18 && idx < 26)) ? kdelta : 0); }
#define SCAN_DMA(n_) do { const int nn_ = (n_) < NCHUNK ? (n_) : NCHUNK - 1; const unsigned char* src_ = rec0 + (size_t)nn_ * RSTR + lane * 16; LAS unsigned char* dst_ = lds + ((n_) & 3) * REC_DMA; \
        _Pragma("unroll") for (int i_ = 0; i_ < 8; ++i_) __builtin_amdgcn_global_load_lds((const unsigned*)(src_ + poff[i_]), (LAS unsigned*)(dst_ + loff[i_]), 16, 0, 0); } while (0)
        SCAN_DMA(0); SCAN_DMA(1); SCAN_DMA(2);
        asm volatile("s_waitcnt vmcnt(16)" ::: "memory");
        __builtin_amdgcn_s_barrier();
        asm volatile("" ::: "memory");
        SCAN_DMA(3);
#define SCAN_STEP(n_, W_) do { asm volatile("s_waitcnt vmcnt(" #W_ ")" ::: "memory"); __builtin_amdgcn_s_barrier(); asm volatile("" ::: "memory"); \
        const u32x4 ov_ = *(const LAS u32x4*)(ost + (((n_) - 1) & 1) * 4096); *(u32x4*)(OA + (size_t)((n_) - 1) * CH * 4096) = ov_; SCAN_DMA((n_) + 3); } while (0)
        SCAN_STEP(1, 16); SCAN_STEP(2, 17);
        for (int n = 3; n < NCHUNK; ++n) SCAN_STEP(n, 18);
#undef SCAN_STEP
        asm volatile("" ::: "memory"); __builtin_amdgcn_s_barrier(); asm volatile("" ::: "memory");
        { const u32x4 ov = *(const LAS u32x4*)(ost + ((NCHUNK - 1) & 1) * 4096); *(u32x4*)(OA + (size_t)(NCHUNK - 1) * CH * 4096) = ov; }
        asm volatile("s_waitcnt vmcnt(0)" ::: "memory");
#undef SCAN_DMA
    } else {
        const int sl = half * 4 + wid, el = lane & 15, q4 = lane >> 4;
        LAS bf16_t* ost = (LAS bf16_t*)(lds + SCAN_OST) + (4 * q4) * 64 + wid * 16 + el;
        f32x4 S[8];
#pragma unroll
        for (int dt = 0; dt < 8; ++dt) S[dt] = (f32x4){0.f, 0.f, 0.f, 0.f};
        for (int n = 0; n < NCHUNK; ++n) {
            asm volatile("s_waitcnt lgkmcnt(0)" ::: "memory"); __builtin_amdgcn_s_barrier(); asm volatile("" ::: "memory");
            LAS unsigned char* buf = lds + (n & 3) * REC_DMA;
            const LAS unsigned char* fl = buf + lane * 16;
            bf16x8 Wf[8], QGf[8], KDf[8], INf[2];
#pragma unroll
            for (int f = 0; f < 8; ++f) { Wf[f] = *(const LAS bf16x8*)(fl + REC_W + f * 1024); QGf[f] = *(const LAS bf16x8*)(fl + REC_QG + f * 1024); }
            const u32x4 uu = *(const LAS u32x4*)(buf + REC_U + sl * 1024 + lane * 16);
            const float gl = *(const LAS float*)(buf + REC_GL + 124);
            f32x4 eGv[2], ekv[2];
#pragma unroll
            for (int ct = 0; ct < 2; ++ct) { eGv[ct] = *(const LAS f32x4*)(buf + REC_GL + (16 * ct + 4 * q4) * 4); ekv[ct] = *(const LAS f32x4*)(buf + REC_GL + 128 + (16 * ct + 4 * q4) * 4); }
#pragma unroll
            for (int f = 0; f < 8; ++f) KDf[f] = *(const LAS bf16x8*)(fl + REC_KD + f * 1024);
#pragma unroll
            for (int f = 0; f < 2; ++f) INf[f] = *(const LAS bf16x8*)(fl + REC_IN + f * 1024);
            bf16x8 Sf[4];
#pragma unroll
            for (int kb = 0; kb < 4; ++kb) { const u32x4 w = (u32x4){cvtpk(S[2 * kb][0], S[2 * kb][1]), cvtpk(S[2 * kb][2], S[2 * kb][3]), cvtpk(S[2 * kb + 1][0], S[2 * kb + 1][1]), cvtpk(S[2 * kb + 1][2], S[2 * kb + 1][3])}; Sf[kb] = __builtin_bit_cast(bf16x8, w); }
            __builtin_amdgcn_sched_barrier(0);
#pragma unroll
            for (int dt = 0; dt < 8; ++dt) S[dt] *= gl;
            f32x4 vn[2] = {(f32x4){bflo(uu[0]), bfhi(uu[0]), bflo(uu[1]), bfhi(uu[1])}, (f32x4){bflo(uu[2]), bfhi(uu[2]), bflo(uu[3]), bfhi(uu[3])}};
            f32x4 o[2] = {(f32x4){0.f, 0.f, 0.f, 0.f}, (f32x4){0.f, 0.f, 0.f, 0.f}};
#pragma unroll
            for (int ct = 0; ct < 2; ++ct)
#pragma unroll
                for (int kb = 0; kb < 4; ++kb) { vn[ct] = __builtin_amdgcn_mfma_f32_16x16x32_bf16(Wf[ct * 4 + kb], Sf[kb], vn[ct], 0, 0, 0);
                                                 o[ct] = __builtin_amdgcn_mfma_f32_16x16x32_bf16(QGf[ct * 4 + kb], Sf[kb], o[ct], 0, 0, 0); }
            const f32x4 vs0 = vn[0] * ekv[0], vs1 = vn[1] * ekv[1];
            const u32x4 vsw = (u32x4){cvtpk(vs0[0], vs0[1]), cvtpk(vs0[2], vs0[3]), cvtpk(vs1[0], vs1[1]), cvtpk(vs1[2], vs1[3])}; const bf16x8 VNsf = __builtin_bit_cast(bf16x8, vsw);
#pragma unroll
            for (int dt = 0; dt < 8; ++dt) S[dt] = __builtin_amdgcn_mfma_f32_16x16x32_bf16(KDf[dt], VNsf, S[dt], 0, 0, 0);
            const u32x4 vw = (u32x4){cvtpk(vn[0][0], vn[0][1]), cvtpk(vn[0][2], vn[0][3]), cvtpk(vn[1][0], vn[1][1]), cvtpk(vn[1][2], vn[1][3])}; const bf16x8 VNf = __builtin_bit_cast(bf16x8, vw);
            LAS bf16_t* os = ost + (n & 1) * 2048;
#pragma unroll
            for (int ct = 0; ct < 2; ++ct) { o[ct] = __builtin_amdgcn_mfma_f32_16x16x32_bf16(INf[ct], VNf, o[ct] * eGv[ct]  , 0, 0, 0);
#pragma unroll
                for (int r = 0; r < 4; r += 2) { const unsigned w = pk2(o[ct][r], o[ct][r + 1]); os[(16 * ct + r) * 64] = (bf16_t)w; os[(16 * ct + r + 1) * 64] = (bf16_t)(w >> 16); } }
        }
        asm volatile("s_waitcnt lgkmcnt(0)" ::: "memory"); __builtin_amdgcn_s_barrier(); asm volatile("" ::: "memory");
        float* so = p.out + O_DELTAP + (size_t)hv * 16384 + sl * 16 + el;
#pragma unroll
        for (int dt = 0; dt < 8; ++dt)
#pragma unroll
            for (int r = 0; r < 4; ++r) so[(size_t)(16 * dt + 4 * q4 + r) * 128] = S[dt][r];
    }
    __syncthreads();
}

__device__ __forceinline__ void attn_sample_task(const Params& p, int row, int h, int lane) {
    asm volatile("" : "+v"(lane));
    const bf16_t* P = (const bf16_t*)(p.ws + WS_P); const bf16_t* PS = (const bf16_t*)(p.ws + WS_PS); bf16_t* OB = (bf16_t*)(p.ws + WS_OB);
    const int sb = (row - SEQ) >> 2, st = (row - SEQ) & 3;
    float sc[3][3];
#pragma unroll
    for (int g = 0; g < 3; ++g) {
        const int dil = g == 0 ? 1 : (g == 1 ? 4 : 16), win = g == 0 ? 128 : (g == 1 ? 512 : 2048);
        const float* cache = g == 0 ? p.c128 : (g == 1 ? p.c512 : p.c2048);
        const bf16_t* qp = PS + (size_t)(row - SEQ) * 9216 + g * 1024 + h * 128;
#pragma unroll
        for (int sl = 0; sl < 3; ++sl) {
            const int j = lane + 64 * sl; float s = -1e30f;
            if (j <= 128) {
                const int idx = win + st - j * dil; float d = 0.f;
                if (idx >= win) { const bf16_t* kb = PS + (size_t)(4 * sb + idx - win) * 9216 + 3072 + g * 1024 + h * 128;
#pragma unroll 1
                    for (int i0 = 0; i0 < 16; i0 += 4) {
#pragma unroll
                        for (int i = i0; i < i0 + 4; ++i) { const u32x4 k = *(const u32x4*)(kb + 8 * i), q = *(const u32x4*)(qp + 8 * i);
#pragma unroll
                            for (int w = 0; w < 4; ++w) d += bflo(q[w]) * bflo(k[w]) + bfhi(q[w]) * bfhi(k[w]); } }
                } else { const float* kf = cache + (((size_t)sb * win + idx) * 2 + 0) * 1024 + h * 128;
#pragma unroll 1
                    for (int i0 = 0; i0 < 16; i0 += 8) {
#pragma unroll
                        for (int i = i0; i < i0 + 8; ++i) { const f32x4 k0 = *(const f32x4*)(kf + 8 * i), k1 = *(const f32x4*)(kf + 8 * i + 4); const u32x4 q = *(const u32x4*)(qp + 8 * i);
                            d += bflo(q[0]) * k0[0] + bfhi(q[0]) * k0[1] + bflo(q[1]) * k0[2] + bfhi(q[1]) * k0[3] + bflo(q[2]) * k1[0] + bfhi(q[2]) * k1[1] + bflo(q[3]) * k1[2] + bfhi(q[3]) * k1[3]; } }
                }
                s = d * 0.08838834764831845f;
            }
            sc[g][sl] = s;
        }
        __builtin_amdgcn_sched_barrier(0);
    }
    float mx = -1e30f;
#pragma unroll
    for (int g = 0; g < 3; ++g)
#pragma unroll
        for (int sl = 0; sl < 3; ++sl) mx = fmaxf(mx, sc[g][sl]);
    mx = wave_max(mx);
    float ls = 0.f;
#pragma unroll
    for (int g = 0; g < 3; ++g)
#pragma unroll
        for (int sl = 0; sl < 3; ++sl) { const float pj = (sc[g][sl] > -1e29f) ? __expf(sc[g][sl] - mx) : 0.f; sc[g][sl] = pj; ls += pj; }
    ls = wave_sum(ls);
    float a0 = 0.f, a1 = 0.f;
#pragma unroll
    for (int g = 0; g < 3; ++g) {
        const int dil = g == 0 ? 1 : (g == 1 ? 4 : 16), win = g == 0 ? 128 : (g == 1 ? 512 : 2048);
        const float* cache = g == 0 ? p.c128 : (g == 1 ? p.c512 : p.c2048);
#pragma unroll
        for (int hf = 0; hf < 2; ++hf) { const float scv = sc[g][hf];
#pragma unroll 1
            for (int j0 = 64 * hf; j0 < 64 * hf + 64; j0 += 32) {
                f32x2 v[32];
#pragma unroll
                for (int k = 0; k < 32; ++k) { const int j = j0 + k, idx = win + st - j * dil;
                    if (idx >= win) { const unsigned u = *(const unsigned*)(PS + (size_t)(4 * sb + idx - win) * 9216 + 6144 + g * 1024 + h * 128 + 2 * lane); v[k] = (f32x2){bflo(u), bfhi(u)}; }
                    else v[k] = *(const f32x2*)(cache + (((size_t)sb * win + idx) * 2 + 1) * 1024 + h * 128 + 2 * lane); }
#pragma unroll
                for (int k = 0; k < 32; ++k) { const float pj = __shfl(scv, (j0 + k) & 63); a0 += pj * v[k][0]; a1 += pj * v[k][1]; }
            } }
        { const int idx = win + st - 128 * dil; const f32x2 v = *(const f32x2*)(cache + (((size_t)sb * win + idx) * 2 + 1) * 1024 + h * 128 + 2 * lane); const float pj = __shfl(sc[g][2], 0); a0 += pj * v[0]; a1 += pj * v[1]; }
        __builtin_amdgcn_sched_barrier(0);
    }
    const float inv = 1.f / ls; const unsigned z = *(const unsigned*)(P + (size_t)row * NP + C_ZB + h * 128 + 2 * lane);
    *(unsigned*)(OB + (size_t)row * 1024 + h * 128 + 2 * lane) = pk2(a0 * inv * siluf_(bflo(z)), a1 * inv * siluf_(bfhi(z)));
}

constexpr int KVC_NR0 = 32 * 124, KVC_NR1 = 32 * 508, KVC_NR2 = 32 * 2044, KVC_ROWS = KVC_NR0 + KVC_NR1 + KVC_NR2, KVC_TASKS = KVC_ROWS / 2;
static_assert(KVC_ROWS % 16 == 0, "copy tasks come in groups of 8");
constexpr int KVC_IDLE_PER_WAVE = 6, KVC_IDLE_TASKS = 87 * 8 * KVC_IDLE_PER_WAVE;
template <int WIN> __device__ __forceinline__ void kvc_rp(const float* c, float* o, int r, const float*& src, float*& dst) { const int b = r / (WIN - 4), j = r - b * (WIN - 4); src = c + (size_t)(b * WIN + j + 4) * 2048; dst = o + (size_t)(b * WIN + j) * 2048; }
__device__ __forceinline__ void kvcopy_task(const Params& p, int t, int lane) {
    asm volatile("" : "+v"(lane));
    const float *c128 = p.c128, *c512 = p.c512, *c2048 = p.c2048;
    asm volatile("" : "+s"(c128), "+s"(c512), "+s"(c2048));
    f32x4 v[16]; float* d[2];
#pragma unroll
    for (int r = 0; r < 2; ++r) { const int R = 2 * t + r; const float* s;
        if (R < KVC_NR0) kvc_rp<128>(c128, p.out + O_KV128S, R, s, d[r]); else if (R < KVC_NR0 + KVC_NR1) kvc_rp<512>(c512, p.out + O_KV512S, R - KVC_NR0, s, d[r]); else kvc_rp<2048>(c2048, p.out + O_KV2048S, R - KVC_NR0 - KVC_NR1, s, d[r]);
#pragma unroll
        for (int k = 0; k < 8; ++k) v[r * 8 + k] = *(const f32x4*)(s + k * 256 + lane * 4); }
#pragma unroll
    for (int r = 0; r < 2; ++r)
#pragma unroll
        for (int k = 0; k < 8; ++k) *(f32x4*)(d[r] + k * 256 + lane * 4) = v[r * 8 + k];
}
__device__ __forceinline__ void kvcopy_companion(const Params& p, int pullA, int cw, int lane) {
    asm volatile("" : "+v"(lane));
    const float *c128 = p.c128, *c512 = p.c512, *c2048 = p.c2048;
    asm volatile("" : "+s"(c128), "+s"(c512), "+s"(c2048));
#pragma unroll 1
    for (int k = 0; k < 4; ++k) {
        const int t = (gridDim.x == 256 ? KVC_IDLE_TASKS : 0) + (pullA * 4 + cw) * 4 + k; const bool on = t < KVC_TASKS;
        f32x4 v[16]; float* d[2];
        asm volatile("s_waitcnt lgkmcnt(0)" ::: "memory"); __builtin_amdgcn_s_barrier(); asm volatile("" ::: "memory");
        if (on) {
#pragma unroll
            for (int r = 0; r < 2; ++r) { const int R = 2 * t + r; const float* s;
                if (R < KVC_NR0) kvc_rp<128>(c128, p.out + O_KV128S, R, s, d[r]); else if (R < KVC_NR0 + KVC_NR1) kvc_rp<512>(c512, p.out + O_KV512S, R - KVC_NR0, s, d[r]); else kvc_rp<2048>(c2048, p.out + O_KV2048S, R - KVC_NR0 - KVC_NR1, s, d[r]);
#pragma unroll
                for (int q = 0; q < 8; ++q) v[r * 8 + q] = *(const f32x4*)(s + q * 256 + lane * 4); } }
        asm volatile("s_waitcnt lgkmcnt(0)" ::: "memory"); __builtin_amdgcn_s_barrier(); asm volatile("" ::: "memory");
        if (on) {
#pragma unroll
            for (int r = 0; r < 2; ++r)
#pragma unroll
                for (int q = 0; q < 8; ++q) *(f32x4*)(d[r] + q * 256 + lane * 4) = v[r * 8 + q]; }
    }
}
constexpr int ATT_PULL_R = 32 * 32 * 2 / 8  , ATT_PULL_S = NSAMP * 8 / 8, ATT_PULL_A = 3 * 8 * (SEQ / 128)  , ATT_PULL_C = 0,
              ATT_PULLS = ATT_PULL_R + ATT_PULL_S + ATT_PULL_A + ATT_PULL_C, WQ_ATT = 3600;
static_assert(KVC_TASKS <= 3 * 8 * (SEQ / 128) * 16, "every copy task has a companion slot");
constexpr int ATT_LDS_PULL = 98304;
__device__ __forceinline__ void attn_quad_task(const Params& p, int qt, LAS unsigned char* ldsq, int wq, int lane) {
    asm volatile("" : "+v"(lane));
    const int g = qt >> 10, rem = qt & 1023, h = rem >> 7, rem2 = rem & 127, nq = 128 >> (2 * g), r = rem2 / nq, qq = rem2 % nq;
    const int ql = lane & 31, hi = lane >> 5, m0 = 128 * qq + 32 * wq, dil = 1 << (2 * g), jstart = qq == 0 ? 4 : 0;
    const size_t tokq = (size_t)r + (size_t)dil * (m0 + ql);
    const bf16_t* Qs = (const bf16_t*)(p.ws + WS_QKVC) + qkvc_row(0, g, h, r); const bf16_t* Ks = (const bf16_t*)(p.ws + WS_QKVC) + qkvc_row(1, g, h, r); const bf16_t* Vs = (const bf16_t*)(p.ws + WS_QKVC) + qkvc_row(2, g, h, r);
    const int kb0 = 128 * qq - 128;
    const bf16_t* tsrc[4];
#pragma unroll
    for (int i = 0; i < 4; ++i) { const int c = i * 256 + wq * 64 + lane, cc = c & 511, row = cc >> 4, ch = (cc & 15) ^ (((row & 3) << 2) | ((row >> 2) & 3));
        tsrc[i] = (i < 2 ? Ks : Vs) + (size_t)(kb0 + row) * 128 + ch * 8; }
#define ATT_DMA(j_, b_) do { _Pragma("unroll") for (int i = 0; i < 4; ++i) __builtin_amdgcn_global_load_lds((const unsigned*)(tsrc[i] + (size_t)(j_) * 32 * 128), (LAS unsigned*)(ldsq + (b_) * 16384 + i * 4096 + wq * 1024), 16, 0, 0); } while (0)
    ATT_DMA(jstart, jstart % 3); ATT_DMA(jstart + 1, (jstart + 1) % 3);
    bf16x8 qf[8];
    { const bf16_t* qp = Qs + (size_t)(m0 + ql) * 128 + 8 * hi;
#pragma unroll
      for (int s = 0; s < 8; ++s) qf[s] = *(const bf16x8*)(qp + 16 * s); }
    f32x16 O[4];
#pragma unroll
    for (int dm = 0; dm < 4; ++dm)
#pragma unroll
        for (int x = 0; x < 16; ++x) O[dm][x] = 0.f;
    float mrun = -1e30f, lrun = 0.f;
    constexpr float C2 = 0.08838834764831845f * 1.4426950408889634f;
    const unsigned qq4 = (lane & 15) >> 2, pp = lane & 3, blk = (lane >> 4) & 1;
    int bj = 0, bn = 2;
#pragma unroll 1
    for (int j = 0; j < 8; ++j) {
        if (j == 7) asm volatile("s_waitcnt vmcnt(0) lgkmcnt(0)" ::: "memory"); else asm volatile("s_waitcnt vmcnt(4) lgkmcnt(0)" ::: "memory");
        __builtin_amdgcn_s_barrier(); asm volatile("" ::: "memory");
        if (j + 2 <= 7 && j + 2 > jstart + 1) ATT_DMA(j + 2, bn);
        const int kt = j - wq;
        if (j >= jstart && kt >= 0 && kt <= 4) {
            const LAS unsigned char* kb = ldsq + bj * 16384; const LAS unsigned char* vb = kb + 8192;
            f32x16 S;
#pragma unroll
            for (int x = 0; x < 16; ++x) S[x] = 0.f;
#pragma unroll
            for (int s = 0; s < 8; ++s) S = __builtin_amdgcn_mfma_f32_32x32x16_bf16(*(const LAS bf16x8*)(kb + off_b(ql, 2 * s + hi)), qf[s], S, 0, 0, 0);
            const float NEG = -__builtin_inff();
            if (kt == 0) {
#pragma unroll
                for (int x = 0; x < 16; ++x) { const int kl = (x & 3) + 8 * (x >> 2) + 4 * hi; if (kl < ql) S[x] = NEG; }
            } else if (kt == 4) {
#pragma unroll
                for (int x = 0; x < 16; ++x) { const int kl = (x & 3) + 8 * (x >> 2) + 4 * hi; if (kl > ql) S[x] = NEG; }
            }
            float tmax = S[0];
#pragma unroll
            for (int x = 1; x < 16; ++x) tmax = fmaxf(tmax, S[x]);
            tmax = fmaxf(tmax, __shfl_xor(tmax, 32));
            if (!__all((tmax - mrun) * 0.08838834764831845f <= 8.f)) {
                const float mnew = fmaxf(mrun, tmax), alpha = __builtin_amdgcn_exp2f((mrun - mnew) * C2); mrun = mnew; lrun *= alpha;
#pragma unroll
                for (int dm = 0; dm < 4; ++dm)
#pragma unroll
                    for (int x = 0; x < 16; ++x) O[dm][x] *= alpha; }
            float ps = 0.f;
#pragma unroll
            for (int x = 0; x < 16; ++x) { S[x] = __builtin_amdgcn_exp2f((S[x] - mrun) * C2); ps += S[x]; }
            lrun += ps;
            bf16x8 pf[2];
#pragma unroll
            for (int t = 0; t < 2; ++t) { const u32x4 w = (u32x4){cvtpk(S[8 * t], S[8 * t + 1]), cvtpk(S[8 * t + 2], S[8 * t + 3]), cvtpk(S[8 * t + 4], S[8 * t + 5]), cvtpk(S[8 * t + 6], S[8 * t + 7])}; pf[t] = __builtin_bit_cast(bf16x8, w); }
#pragma unroll
            for (int dm = 0; dm < 4; ++dm)
#pragma unroll
                for (int t = 0; t < 2; ++t) {
                    const s16x4 a0 = lds_tr((LAS unsigned char*)vb + off_b(16 * t + 4 * hi + qq4, 4 * dm + 2 * blk + (pp >> 1)) + 8 * (pp & 1));
                    const s16x4 a1 = lds_tr((LAS unsigned char*)vb + off_b(16 * t + 8 + 4 * hi + qq4, 4 * dm + 2 * blk + (pp >> 1)) + 8 * (pp & 1));
                    O[dm] = __builtin_amdgcn_mfma_f32_32x32x16_bf16(cat8(a0, a1), pf[t], O[dm], 0, 0, 0); }
        }
        bj = bj == 2 ? 0 : bj + 1; bn = bn == 2 ? 0 : bn + 1;
    }
#undef ATT_DMA
    lrun += __shfl_xor(lrun, 32);
    const float inv = 1.f / lrun;
    bf16_t* og = (bf16_t*)(p.ws + WS_OG) + ((size_t)g * SEQ + tokq) * 1024 + h * 128;
#pragma unroll
    for (int dm = 0; dm < 4; ++dm)
#pragma unroll
        for (int a = 0; a < 2; ++a) {
            const unsigned e0 = cvtpk(O[dm][8 * a] * inv, O[dm][8 * a + 1] * inv), e1 = cvtpk(O[dm][8 * a + 2] * inv, O[dm][8 * a + 3] * inv);
            const unsigned f0 = cvtpk(O[dm][8 * a + 4] * inv, O[dm][8 * a + 5] * inv), f1 = cvtpk(O[dm][8 * a + 6] * inv, O[dm][8 * a + 7] * inv);
            const auto s0 = __builtin_amdgcn_permlane32_swap(e0, f0, false, false), s1 = __builtin_amdgcn_permlane32_swap(e1, f1, false, false);
            *(u32x4*)(og + 32 * dm + 16 * a + 8 * hi) = (u32x4){s0[0], s1[0], s0[1], s1[1]}; }
    if (hi == 0) ((float*)(p.ws + WS_LSE))[((size_t)g * SEQ + tokq) * 8 + h] = mrun * 0.08838834764831845f + logf(lrun);
}
constexpr int WQ_QX = 3648  , QX_S = ATT_PULL_S / 8  , QX_N = QX_S + ATT_PULL_A / 8;
static_assert(ATT_PULL_A % 8 == 0 && ATT_PULL_S % 8 == 0 && WQ_QX + 8 * 16 <= 4096, "per-XCD counters");
__device__ __forceinline__ void ph_attn(const Params& p, LAS unsigned char* lds) {
    const int tid = tidx(), lane = tid & 63, wid = __builtin_amdgcn_readfirstlane(tid >> 6);
    unsigned* ctr = (unsigned*)(p.ws + WS_BAR) + WQ_ATT; unsigned* ctrq = (unsigned*)(p.ws + WS_BAR) + WQ_QX;
    LAS int* slot = (LAS int*)(lds + ATT_LDS_PULL);
    bool main_done = false; int qcur = (int)(xb_xcc_id() & 7u);
    for (;;) {
        __syncthreads();
        if (wid == 0) {
            int v = -1;
            if (!main_done) { unsigned m = 0; if (lane == 0) m = __hip_atomic_fetch_add(ctr, 1u, __ATOMIC_RELAXED, __HIP_MEMORY_SCOPE_AGENT); m = __builtin_amdgcn_readfirstlane(m);
                if (m < (unsigned)ATT_PULL_R) v = (int)m; else main_done = true; }
            if (v < 0) {
                for (;;) {
                    unsigned a = 0; if (lane == 0) a = __hip_atomic_fetch_add(ctrq + 16 * qcur, 1u, __ATOMIC_RELAXED, __HIP_MEMORY_SCOPE_AGENT); a = __builtin_amdgcn_readfirstlane(a);
                    if (a < (unsigned)QX_N) { v = (int)a < QX_S ? ATT_PULL_R + qcur * QX_S + (int)a : ATT_PULL_R + ATT_PULL_S + qcur * (QX_N - QX_S) + (int)a - QX_S; break; }
                    unsigned c = (unsigned)QX_N; if (lane < 8) c = __hip_atomic_load(ctrq + 16 * lane, __ATOMIC_RELAXED, __HIP_MEMORY_SCOPE_AGENT);
                    const unsigned ne = (unsigned)__ballot(c < (unsigned)QX_N) & 0xffu;
                    if (ne == 0u) { v = ATT_PULLS; break; }
                    const unsigned rot = ((ne >> qcur) | (ne << (8 - qcur))) & 0xffu; qcur = (qcur + __builtin_ctz(rot)) & 7;
                }
            }
            if (lane == 0) *slot = v;
        }
        __syncthreads();
        const int pull = __builtin_amdgcn_readfirstlane(*slot);
        if (pull >= ATT_PULLS) break;
        if (pull < ATT_PULL_R) delta_rec_sample_task(p, pull * 8 + wid, lane);
        else if (pull < ATT_PULL_R + ATT_PULL_S) { const int task = (pull - ATT_PULL_R) * 8 + wid; attn_sample_task(p, SEQ + (task >> 3), task & 7, lane); }
        else { const int pa = pull - ATT_PULL_R - ATT_PULL_S;
            if (wid < 4) attn_quad_task(p, pa, lds, wid, lane); else kvcopy_companion(p, pa, wid - 4, lane); }
    }
}
__device__ __forceinline__ void ph_mix(const Params& p, int bid, int nb) {
    const bf16_t* P = (const bf16_t*)(p.ws + WS_P); const bf16_t* OG = (const bf16_t*)(p.ws + WS_OG); const float* LSE = (const float*)(p.ws + WS_LSE); bf16_t* OB = (bf16_t*)(p.ws + WS_OB);
    const int tid = tidx(), lane = tid & 63, gw = __builtin_amdgcn_readfirstlane(tid >> 6) * nb + bid, nw = nb * 8, h = lane >> 3;
    for (int tok = gw; tok < SEQ; tok += nw) {
        const size_t o = (size_t)tok * 1024 + lane * 16;
        u32x4 a[3][2];
#pragma unroll
        for (int g = 0; g < 3; ++g) { a[g][0] = *(const u32x4*)(OG + (size_t)g * SEQ * 1024 + o); a[g][1] = *(const u32x4*)(OG + (size_t)g * SEQ * 1024 + o + 8); }
        const u32x4 z0 = *(const u32x4*)(P + (size_t)tok * NP + C_ZB + lane * 16), z1 = *(const u32x4*)(P + (size_t)tok * NP + C_ZB + lane * 16 + 8);
        const float l0 = LSE[((size_t)0 * SEQ + tok) * 8 + h], l1 = LSE[((size_t)1 * SEQ + tok) * 8 + h], l2 = LSE[((size_t)2 * SEQ + tok) * 8 + h];
        const float mx = fmaxf(l0, fmaxf(l1, l2)); float w0 = __expf(l0 - mx), w1 = __expf(l1 - mx), w2 = __expf(l2 - mx); const float inv = 1.f / (w0 + w1 + w2); w0 *= inv; w1 *= inv; w2 *= inv;
        u32x4 r[2];
#pragma unroll
        for (int q = 0; q < 2; ++q) { const u32x4 z = q ? z1 : z0;
#pragma unroll
            for (int i = 0; i < 4; ++i) r[q][i] = pk2((w0 * bflo(a[0][q][i]) + w1 * bflo(a[1][q][i]) + w2 * bflo(a[2][q][i])) * siluf_(bflo(z[i])), (w0 * bfhi(a[0][q][i]) + w1 * bfhi(a[1][q][i]) + w2 * bfhi(a[2][q][i])) * siluf_(bfhi(z[i]))); }
        *(u32x4*)(OB + o) = r[0]; *(u32x4*)(OB + o + 8) = r[1];
    }
}

__device__ __forceinline__ void ph_gnorm(const Params& p, int bid, int nb) {
    const bf16_t* P = (const bf16_t*)(p.ws + WS_P); bf16_t* OA = (bf16_t*)(p.ws + WS_OA);
    const int tid = tidx(), lane = tid & 63, gw = __builtin_amdgcn_readfirstlane(tid >> 6) * nb + bid, nw = nb * 8;
    const f32x4 nwa = *(const f32x4*)(p.norm_a + 8 * (lane & 15)), nwb = *(const f32x4*)(p.norm_a + 8 * (lane & 15) + 4);
    for (int task = gw; task < MR * 4; task += nw) { const int row = task >> 2, c0 = (task & 3) * 1024 + 8 * lane;
        bf16_t* op = OA + (size_t)row * 4096 + c0; const bf16_t* zp = P + (size_t)row * NP + C_ZA + c0;
        u32x4 u[2], z[2]; float ss[2];
#pragma unroll
        for (int i = 0; i < 2; ++i) { u[i] = *(const u32x4*)(op + i * 512); z[i] = *(const u32x4*)(zp + i * 512); }
#pragma unroll
        for (int i = 0; i < 2; ++i) { ss[i] = 0.f;
#pragma unroll
            for (int q = 0; q < 4; ++q) ss[i] += bflo(u[i][q]) * bflo(u[i][q]) + bfhi(u[i][q]) * bfhi(u[i][q]); }
#pragma unroll
        for (int o = 1; o <= 8; o <<= 1)
#pragma unroll
            for (int i = 0; i < 2; ++i) ss[i] += __shfl_xor(ss[i], o);
#pragma unroll
        for (int i = 0; i < 2; ++i) { const float r = rsqrtf(ss[i] * (1.f / 128.f) + EPS); u32x4 o;
#pragma unroll
            for (int q = 0; q < 4; ++q) { const f32x4 nv = q < 2 ? nwa : nwb;
                o[q] = pk2(bflo(u[i][q]) * r * nv[(2 * q) & 3] * siluf_(bflo(z[i][q])), bfhi(u[i][q]) * r * nv[(2 * q + 1) & 3] * siluf_(bfhi(z[i][q]))); }
            *(u32x4*)(op + i * 512) = o; } }
}

__device__ __forceinline__ void ph_final(const Params& p, int bid, int nb) {
    const int lane = tidx() & 63, gw = __builtin_amdgcn_readfirstlane(tidx() >> 6) * nb + bid, nw = nb * 8;
    const bf16_t* H = (const bf16_t*)(p.ws + WS_T);
    for (int row = gw; row < MR; row += nw) { float* hr = p.out + (size_t)row * DM; f32x4 v[8]; float ss = 0.f;
        if (row < SEQ) {
#pragma unroll
            for (int i = 0; i < 8; ++i) { const u32x2 q = *(const u32x2*)(H + (size_t)row * DM + i * 256 + lane * 4); v[i] = (f32x4){bflo(q[0]), bfhi(q[0]), bflo(q[1]), bfhi(q[1])}; }
        } else {
#pragma unroll
            for (int i = 0; i < 8; ++i) v[i] = *(const f32x4*)(hr + i * 256 + lane * 4); }
#pragma unroll
        for (int i = 0; i < 8; ++i) ss += v[i][0] * v[i][0] + v[i][1] * v[i][1] + v[i][2] * v[i][2] + v[i][3] * v[i][3];
        ss = wave_sum(ss); const float r = rsqrtf(ss * (1.f / DM) + EPS);
#pragma unroll
        for (int i = 0; i < 8; ++i) { const f32x4 w = *(const f32x4*)(p.ln_f + i * 256 + lane * 4); *(f32x4*)(hr + i * 256 + lane * 4) = (f32x4){v[i][0] * r * w[0], v[i][1] * r * w[1], v[i][2] * r * w[2], v[i][3] * r * w[3]}; } }
}

__device__ __forceinline__ void ph_gemm1(const Params& p, LAS unsigned char* lds, int bid, int nb) {
    pg8::StaticOrder S; S.init(MP, NPAD, nb, bid);
    pg8::gemm_phase(lds, pg8::Gemm{(const bf16_t*)(p.ws + WS_XN), (const bf16_t*)(p.ws + WS_BT1), MP, NPAD, 2048}, S, pg8::EpiProj{(bf16_t*)(p.ws + WS_P), (float*)(p.ws + WS_BA), (bf16_t*)(p.ws + WS_QKVC), (bf16_t*)(p.ws + WS_PS)});
    static_assert((MP / 256) * (NPAD / 256) == 26 * 256 + 169, "the idle workgroups of GEMM 1's last round");
    if (nb == 256 && bid >= 169) {
        const float *w_in = p.w_in, *w_pa = p.w_proj_a, *w_pb = p.w_proj_b, *w_o = p.w_out;
        asm volatile("" : "+s"(w_in), "+s"(w_pa), "+s"(w_pb), "+s"(w_o));
        const int tid = tidx();
        for (int u0 = PRO_TILES1 + (bid - 169) * 4; u0 < PRO_TILES; u0 += 87 * 4) pro_tiles4(p, lds, u0, tid, w_in, w_pa, w_pb, w_o);
        { const int lane = tid & 63, w = __builtin_amdgcn_readfirstlane(tid >> 6);
          for (int k = 0; k < KVC_IDLE_PER_WAVE; ++k) kvcopy_task(p, ((bid - 169) * 8 + w) * KVC_IDLE_PER_WAVE + k, lane); }
    }
}
__device__ __forceinline__ void ph_gemm2a(const Params& p, LAS unsigned char* lds, int bid, int nb) {
    pg8::StaticOrder S; S.init(SEQ, DM, nb, bid);
    pg8::gemm_phase(lds, pg8::Gemm{(const bf16_t*)(p.ws + WS_OB), (const bf16_t*)(p.ws + WS_BT2B), MP, DM, 1024}, S, pg8::EpiGateB{(const bf16_t*)(p.ws + WS_P), (bf16_t*)(p.ws + WS_T)});
}
__device__ __forceinline__ void ph_gemm2b(const Params& p, LAS unsigned char* lds, int bid, int nb) {
    pg8::StaticOrder S; S.init(SEQ, DM, nb, bid);
    pg8::gemm_phase(lds, pg8::Gemm{(const bf16_t*)(p.ws + WS_OA), (const bf16_t*)(p.ws + WS_BT2A), MP, DM, 4096}, S, pg8::EpiMerge{(const bf16_t*)(p.ws + WS_P), (const bf16_t*)(p.ws + WS_T), (bf16_t*)(p.ws + WS_MG)});
}
__device__ __forceinline__ void ph_gemm3(const Params& p, LAS unsigned char* lds, int bid, int nb) {
    pg8::StaticOrder S; S.init(SEQ, DM, nb, bid);
    pg8::gemm_phase(lds, pg8::Gemm{(const bf16_t*)(p.ws + WS_MG), (const bf16_t*)(p.ws + WS_BT3), MP, DM, 2048}, S, pg8::EpiOut{p.x_prompt, (bf16_t*)(p.ws + WS_T)});
}

template <int K> __device__ __forceinline__ f32x4 skinny_acc(const bf16_t* a, const bf16_t* b, f32x4 acc) {
    static_assert(K % 512 == 0, "K step");
#pragma unroll 1
    for (int k0 = 0; k0 < K; k0 += 512) {
        bf16x8 af[16], bfr[16];
#pragma unroll
        for (int i = 0; i < 16; ++i) { af[i] = *(const bf16x8*)(a + k0 + 32 * i); bfr[i] = *(const bf16x8*)(b + k0 + 32 * i); }
#pragma unroll
        for (int i = 0; i < 16; ++i) acc = __builtin_amdgcn_mfma_f32_16x16x32_bf16(af[i], bfr[i], acc, 0, 0, 0);
    }
    return acc;
}
__device__ __forceinline__ void ph_gemm2_sample(const Params& p, LAS unsigned char* lds, int bid) {
    if (bid >= 256) return;
    const int tid = tidx(), lane = tid & 63, wv = __builtin_amdgcn_readfirstlane(tid >> 6), fr = lane & 15, fq = lane >> 4, rt = (bid & 1) * 4 + (wv & 3), kh = wv >> 2, cb = bid >> 1;
    const bf16_t* P = (const bf16_t*)(p.ws + WS_P);
    const int arow = SEQ + 16 * rt + fr, bcol = 16 * cb + fr;
    f32x4 aa = (f32x4){0.f, 0.f, 0.f, 0.f}, ab = aa;
    aa = skinny_acc<2048>((const bf16_t*)(p.ws + WS_OA) + (size_t)arow * 4096 + kh * 2048 + 8 * fq, (const bf16_t*)(p.ws + WS_BT2A) + (size_t)bcol * 4096 + kh * 2048 + 8 * fq, aa);
    ab = skinny_acc<512>((const bf16_t*)(p.ws + WS_OB) + (size_t)arow * 1024 + kh * 512 + 8 * fq, (const bf16_t*)(p.ws + WS_BT2B) + (size_t)bcol * 1024 + kh * 512 + 8 * fq, ab);
    LAS f32x4* red = (LAS f32x4*)lds + (wv & 3) * 128 + lane * 2;
    if (kh) { red[0] = aa; red[1] = ab; }
    __syncthreads();
    if (!kh) { aa += red[0]; ab += red[1];
        bf16_t* MG = (bf16_t*)(p.ws + WS_MG);
#pragma unroll
        for (int r = 0; r < 4; ++r) { const size_t row = (size_t)(SEQ + 16 * rt + 4 * fq + r); const int c = 16 * cb + fr;
            const float ga = sigmoidf_(bf2f(P[row * NP + C_GA + c])), gb = sigmoidf_(bf2f(P[row * NP + C_GB + c]));
            MG[row * DM + c] = f2bf(ga * aa[r] + gb * ab[r]); } }
    __syncthreads();
}
__device__ __forceinline__ void ph_gemm3_sample(const Params& p, LAS unsigned char* lds, int bid) {
    if (bid >= 256) return;
    const int tid = tidx(), lane = tid & 63, wv = __builtin_amdgcn_readfirstlane(tid >> 6), fr = lane & 15, fq = lane >> 4, rt = (bid & 1) * 4 + (wv & 3), kh = wv >> 2, cb = bid >> 1;
    const int arow = SEQ + 16 * rt + fr, bcol = 16 * cb + fr;
    f32x4 acc = (f32x4){0.f, 0.f, 0.f, 0.f};
    acc = skinny_acc<1024>((const bf16_t*)(p.ws + WS_MG) + (size_t)arow * 2048 + kh * 1024 + 8 * fq, (const bf16_t*)(p.ws + WS_BT3) + (size_t)bcol * 2048 + kh * 1024 + 8 * fq, acc);
    LAS f32x4* red = (LAS f32x4*)lds + (wv & 3) * 64 + lane;
    if (kh) red[0] = acc;
    __syncthreads();
    if (!kh) { acc += red[0];
#pragma unroll
        for (int r = 0; r < 4; ++r) { const int srow = 16 * rt + 4 * fq + r, c = 16 * cb + fr;
            p.out[(size_t)(SEQ + srow) * DM + c] = p.x_sample[(size_t)srow * DM + c] + acc[r]; } }
    __syncthreads();
}

constexpr int LDS_MAIN = 4 * REC_DMA + 8192;
constexpr int LDS_BYTES = LDS_MAIN + 16;
__global__ __launch_bounds__(512, 2) void k_fwd(Params p) {
    extern __shared__ __attribute__((aligned(16))) unsigned char shm[];
    LAS unsigned char* lds = (LAS unsigned char*)shm;
    const int bid = blockIdx.x, nb = gridDim.x;
    if (threadIdx.x < 4) ((LAS unsigned*)(lds + LDS_MAIN))[threadIdx.x] = 0u;
    __syncthreads();
    XcdBarrier bar = xcd_barrier_post((unsigned*)(p.ws + WS_BAR), (volatile LAS unsigned*)(lds + LDS_MAIN));
    ph_prologue(p, lds, bid, nb);
    xcd_barrier(bar);
    ph_gemm1(p, lds, bid, nb);
    xcd_barrier(bar);
    ph_prep(p, bid, nb);
    ph_stage_a(p, lds, bid, nb);
    xcd_barrier(bar);
    if (bid < SCAN_WGS) ph_scan(p, lds, bid);
    ph_attn(p, lds);
    xcd_barrier(bar);
    ph_gnorm(p, bid, nb);
    ph_mix(p, bid, nb);
    xcd_barrier(bar);
    ph_gemm2_sample(p, lds, bid);
    ph_gemm2a(p, lds, bid, nb);
    ph_gemm2b(p, lds, bid, nb);
    xcd_barrier(bar);
    ph_gemm3_sample(p, lds, bid);
    ph_gemm3(p, lds, bid, nb);
    xcd_barrier(bar);
    ph_final(p, bid, nb);
}

extern "C" void kernel_launch(void* const* d_in, const int* in_sizes, int n_in, void* d_out, int out_size, void* d_ws, size_t ws_size, hipStream_t stream) {
    if (n_in != 17 || (size_t)out_size != O_END || ws_size < WS_END) { fprintf(stderr, "kernel_launch: unexpected sizes n_in %d out %d ws %zu (need %zu)\n", n_in, out_size, ws_size, (size_t)WS_END); return; }
    static int grid = 0;
    if (!grid) {
        int dev = 0, cus = 0, per_cu = 0;
        if (hipGetDevice(&dev) != hipSuccess || hipDeviceGetAttribute(&cus, hipDeviceAttributeMultiprocessorCount, dev) != hipSuccess) { fprintf(stderr, "kernel_launch: device query failed\n"); return; }
        if (hipFuncSetAttribute((const void*)k_fwd, hipFuncAttributeMaxDynamicSharedMemorySize, LDS_BYTES) != hipSuccess) { fprintf(stderr, "kernel_launch: hipFuncSetAttribute failed\n"); return; }
        if (hipOccupancyMaxActiveBlocksPerMultiprocessor(&per_cu, (const void*)k_fwd, 512, LDS_BYTES) != hipSuccess || per_cu < 1) { fprintf(stderr, "kernel_launch: occupancy query says %d blocks per CU\n", per_cu); return; }
        grid = cus;
    }
    Params p{};
    p.x_prompt = (const float*)d_in[0]; p.x_sample = (const float*)d_in[1]; p.c128 = (const float*)d_in[2]; p.c512 = (const float*)d_in[3]; p.c2048 = (const float*)d_in[4];
    p.state_delta = (const float*)d_in[5]; p.state_conv = (const float*)d_in[6]; p.ln_in = (const float*)d_in[7]; p.w_in = (const float*)d_in[8]; p.conv_w = (const float*)d_in[9];
    p.a_log = (const float*)d_in[10]; p.dt_bias = (const float*)d_in[11]; p.norm_a = (const float*)d_in[12]; p.w_proj_a = (const float*)d_in[13]; p.w_proj_b = (const float*)d_in[14];
    p.w_out = (const float*)d_in[15]; p.ln_f = (const float*)d_in[16]; p.out = (float*)d_out; p.ws = (unsigned char*)d_ws;
    (void)hipMemsetAsync((char*)d_ws + WS_BAR, 0, 16384, stream);
    hipLaunchKernelGGL(k_fwd, dim3(grid), dim3(512), LDS_BYTES, stream, p);
}
```
